# Optimizing an MI355X kernel written in HIP

```python
import math
import jax, jax.numpy as jnp
from jax import lax
import numpy as np

D_MODEL = 2048
BATCH = 4
SEQ = 2048
DEPTH = 4
DEC_BATCH = 128
DEC_SEQ = 1
PAST_LEN = 16384
PAGE_SIZE = 128

N_MIXERS = 2
N_SG_LAYERS = (DEPTH + 1) // 2
N_SSM_LAYERS = DEPTH // 2
MIX_WIDTH = D_MODEL
XA_HEADS = 4
XA_HEAD_DIM = D_MODEL // 16
XA_WIDTH = XA_HEADS * XA_HEAD_DIM
N_MEM = 256
TOK_WIDTH = MIX_WIDTH - XA_WIDTH
CHUNK = 128
SG_WIDTH = TOK_WIDTH
SG_GROUP_DIM = 128
SG_GROUPS = SG_WIDTH // SG_GROUP_DIM
SSM_WIDTH = TOK_WIDTH
SSM_GROUP_DIM = 16
SSM_GROUPS = SSM_WIDTH // SSM_GROUP_DIM
SSM_STATE = 64
DT_MIN = 1e-3
DT_MAX = 1e-1
D_FF = ((8 * D_MODEL // 3 + 127) // 128) * 128
CONV_W = 3
EPS = 1e-6

kernel_name = "hybrid_sgmlp_s5_memxattn_convffn_step"


def rmsnorm(x, g):
    x32 = x.astype(jnp.float32)
    y = x32 * lax.rsqrt(jnp.mean(x32 * x32, axis=-1, keepdims=True) + EPS)
    return y.astype(x.dtype) * g


def mem_kv(mem, g, w):
    k, v = jnp.split(rmsnorm(mem, g) @ w, 2, axis=-1)
    b, m = mem.shape[0], mem.shape[1]
    return (k.reshape(b, m, XA_HEADS, XA_HEAD_DIM), v.reshape(b, m, XA_HEADS, XA_HEAD_DIM))


def cross_attend(q, k, v):
    b, l = q.shape[0], q.shape[1]
    qh = q.reshape(b, l, XA_HEADS, XA_HEAD_DIM)
    s = jnp.einsum('blhd,bmhd->bhlm', qh, k).astype(jnp.float32) * (XA_HEAD_DIM ** -0.5)
    p = jax.nn.softmax(s, axis=-1).astype(v.dtype)
    o = jnp.einsum('bhlm,bmhd->blhd', p, v)
    return o.reshape(b, l, XA_WIDTH)


def spatial_gate(v, w_s, b_s):
    b, l, w = v.shape
    pad = (-l) % CHUNK
    vp = jnp.pad(v, ((0, 0), (0, pad), (0, 0)))
    n = vp.shape[1] // CHUNK
    vc = vp.reshape(b, n, CHUNK, SG_GROUPS, SG_GROUP_DIM)
    mask = jnp.tril(jnp.ones((CHUNK, CHUNK), dtype=bool))
    wm = jnp.where(mask, w_s, 0)
    s = jnp.einsum('gts,bnsgd->bntgd', wm, vc) + b_s.T[:, :, None]
    return s.reshape(b, n * CHUNK, w)[:, :l]


def sg_mixer(h, w_in, w_out, g_v, w_s, b_s, mk, mv):
    z = h @ w_in
    uv, q = z[..., :2 * SG_WIDTH], z[..., 2 * SG_WIDTH:]
    u, v = jnp.split(jax.nn.gelu(uv), 2, axis=-1)
    v = rmsnorm(v, g_v)
    tok = u * spatial_gate(v, w_s, b_s)
    out = jnp.concatenate([tok, cross_attend(q, mk, mv)], axis=-1) @ w_out
    return out, v


def s5_scan(u, s_re, s_im, lam_re, lam_im, log_dt, b_re, b_im, c_re, c_im, d):
    f = jnp.float32
    dtype = u.dtype
    bsz, l = u.shape[0], u.shape[1]
    lam_re, lam_im = lam_re.astype(f), lam_im.astype(f)
    dt = jnp.exp(log_dt.astype(f))[:, None]
    ar, ai = lam_re * dt, lam_im * dt
    mag = jnp.exp(ar)
    lb_re, lb_im = mag * jnp.cos(ai), mag * jnp.sin(ai)
    nr, ni = lb_re - 1.0, lb_im
    den = lam_re * lam_re + lam_im * lam_im
    k_re = (nr * lam_re + ni * lam_im) / den
    k_im = (ni * lam_re - nr * lam_im) / den
    ug = u.astype(f).reshape(bsz, l, SSM_GROUPS, SSM_GROUP_DIM)
    bu_re = jnp.einsum('blhc,hpc->blhp', ug, b_re.astype(f))
    bu_im = jnp.einsum('blhc,hpc->blhp', ug, b_im.astype(f))
    x_re = k_re * bu_re - k_im * bu_im
    x_im = k_re * bu_im + k_im * bu_re
    a_re = jnp.broadcast_to(lb_re, x_re.shape)
    a_im = jnp.broadcast_to(lb_im, x_im.shape)

    def combine(e1, e2):
        a1r, a1i, b1r, b1i = e1
        a2r, a2i, b2r, b2i = e2
        return (a2r * a1r - a2i * a1i, a2r * a1i + a2i * a1r,
                a2r * b1r - a2i * b1i + b2r, a2r * b1i + a2i * b1r + b2i)

    _, _, h_re, h_im = lax.associative_scan(combine, (a_re, a_im, x_re, x_im), axis=1)
    steps = jnp.arange(1, l + 1, dtype=f)[:, None, None]
    pmag = jnp.exp(ar * steps)
    p_re, p_im = pmag * jnp.cos(ai * steps), pmag * jnp.sin(ai * steps)
    s0r, s0i = s_re.astype(f)[:, None], s_im.astype(f)[:, None]
    h_re = h_re + p_re * s0r - p_im * s0i
    h_im = h_im + p_re * s0i + p_im * s0r
    y = (jnp.einsum('blhp,hcp->blhc', h_re, c_re.astype(f))
         - jnp.einsum('blhp,hcp->blhc', h_im, c_im.astype(f)))
    y = y.reshape(bsz, l, SSM_WIDTH) + d.astype(f) * u.astype(f)
    return y.astype(dtype), h_re[:, -1].astype(s_re.dtype), h_im[:, -1].astype(s_im.dtype)


def ssm_mixer(h, w_in, w_out, lam_re, lam_im, log_dt, b_re, b_im, c_re, c_im, d,
              w_glu, b_glu, mk, mv, s_re, s_im):
    z = h @ w_in
    u, q = z[..., :SSM_WIDTH], z[..., SSM_WIDTH:]
    y, n_re, n_im = s5_scan(u, s_re, s_im, lam_re, lam_im, log_dt, b_re, b_im, c_re, c_im, d)
    y = jax.nn.gelu(y)
    y = y * jax.nn.sigmoid(y @ w_glu + b_glu)
    out = jnp.concatenate([y, cross_attend(q, mk, mv)], axis=-1) @ w_out
    return out, n_re, n_im


def conv_ffn(h, w_up, conv_w, conv_b, w_down, prev):
    a, g = jnp.split(h @ w_up, 2, axis=-1)
    l = a.shape[1]
    full = jnp.concatenate([prev.astype(a.dtype), a], axis=1)
    c = conv_b
    for j in range(CONV_W):
        c = c + conv_w[j] * full[:, j:j + l]
    y = jax.nn.silu(c) * g
    return y @ w_down, full[:, l:]


def trunk(x, mem_k, mem_v, ssm_re, ssm_im, conv_prev, p):
    sg_v, s_re, s_im, conv_new = [], [], [], []
    for i in range(DEPTH):
        j = i // N_MIXERS
        h = rmsnorm(x, p['g_mix'][i])
        if i % N_MIXERS == 0:
            out, v = sg_mixer(h, p['sg_w_in'][j], p['sg_w_out'][j], p['sg_g_v'][j],
                              p['sg_w_s'][j], p['sg_b_s'][j], mem_k[i], mem_v[i])
            sg_v.append(v)
        else:
            out, r, im = ssm_mixer(h, p['ssm_w_in'][j], p['ssm_w_out'][j], p['ssm_lam_re'][j],
                                   p['ssm_lam_im'][j], p['ssm_log_dt'][j], p['ssm_b_re'][j],
                                   p['ssm_b_im'][j], p['ssm_c_re'][j], p['ssm_c_im'][j],
                                   p['ssm_d'][j], p['ssm_w_glu'][j], p['ssm_b_glu'][j],
                                   mem_k[i], mem_v[i], ssm_re[j], ssm_im[j])
            s_re.append(r)
            s_im.append(im)
        x = x + out
        h = rmsnorm(x, p['g_ffn'][i])
        out, c = conv_ffn(h, p['ffn_w_up'][i], p['ffn_conv_w'][i], p['ffn_conv_b'][i],
                          p['ffn_w_down'][i], conv_prev[i])
        conv_new.append(c)
        x = x + out
    return (rmsnorm(x, p['g_final']), jnp.stack(sg_v), jnp.stack(s_re), jnp.stack(s_im),
            jnp.stack(conv_new))


def setup_inputs(seed: int = 0) -> dict:
    key = jax.random.key(seed)
    ks = iter(jax.random.split(key, 48))
    f = jnp.float32

    def nrm(shape, scale):
        return jax.random.normal(next(ks), shape, f) * scale

    def gain(shape):
        return 1.0 + nrm(shape, 0.01)

    lam_im = (jnp.broadcast_to(jnp.pi * jnp.arange(SSM_STATE, dtype=f), (N_SSM_LAYERS, SSM_GROUPS, SSM_STATE))
              + nrm((N_SSM_LAYERS, SSM_GROUPS, SSM_STATE), 0.01))
    return {
        'x_prompt': nrm((BATCH, SEQ, D_MODEL), 1.0),
        'x_sample': nrm((DEC_BATCH, DEC_SEQ, D_MODEL), 1.0),
        'mem_prompt': nrm((BATCH, N_MEM, D_MODEL), 1.0),
        'cache_mem_k': nrm((DEPTH, DEC_BATCH, N_MEM, XA_HEADS, XA_HEAD_DIM), 1.0),
        'cache_mem_v': nrm((DEPTH, DEC_BATCH, N_MEM, XA_HEADS, XA_HEAD_DIM), 1.0),
        'state_ssm_re': nrm((N_SSM_LAYERS, DEC_BATCH, SSM_GROUPS, SSM_STATE), 0.1),
        'state_ssm_im': nrm((N_SSM_LAYERS, DEC_BATCH, SSM_GROUPS, SSM_STATE), 0.1),
        'state_conv': nrm((DEPTH, DEC_BATCH, CONV_W - 1, D_FF), 1.0),
        'g_mix': gain((DEPTH, D_MODEL)),
        'g_ffn': gain((DEPTH, D_MODEL)),
        'g_mem': gain((DEPTH, D_MODEL)),
        'g_final': gain((D_MODEL,)),
        'w_mem_kv': nrm((DEPTH, D_MODEL, 2 * XA_WIDTH), D_MODEL ** -0.5),
        'sg_w_in': nrm((N_SG_LAYERS, D_MODEL, 2 * SG_WIDTH + XA_WIDTH), D_MODEL ** -0.5),
        'sg_w_out': nrm((N_SG_LAYERS, SG_WIDTH + XA_WIDTH, D_MODEL), (SG_WIDTH + XA_WIDTH) ** -0.5),
        'sg_g_v': gain((N_SG_LAYERS, SG_WIDTH)),
        'sg_w_s': nrm((N_SG_LAYERS, SG_GROUPS, CHUNK, CHUNK), CHUNK ** -0.5),
        'sg_b_s': gain((N_SG_LAYERS, SG_GROUPS, CHUNK)),
        'ssm_w_in': nrm((N_SSM_LAYERS, D_MODEL, SSM_WIDTH + XA_WIDTH), D_MODEL ** -0.5),
        'ssm_w_out': nrm((N_SSM_LAYERS, SSM_WIDTH + XA_WIDTH, D_MODEL), (SSM_WIDTH + XA_WIDTH) ** -0.5),
        'ssm_lam_re': -0.5 + nrm((N_SSM_LAYERS, SSM_GROUPS, SSM_STATE), 0.01),
        'ssm_lam_im': lam_im,
        'ssm_log_dt': jax.random.uniform(next(ks), (N_SSM_LAYERS, SSM_GROUPS), f,
                                         math.log(DT_MIN), math.log(DT_MAX)),
        'ssm_b_re': nrm((N_SSM_LAYERS, SSM_GROUPS, SSM_STATE, SSM_GROUP_DIM), (2 * SSM_GROUP_DIM) ** -0.5),
        'ssm_b_im': nrm((N_SSM_LAYERS, SSM_GROUPS, SSM_STATE, SSM_GROUP_DIM), (2 * SSM_GROUP_DIM) ** -0.5),
        'ssm_c_re': nrm((N_SSM_LAYERS, SSM_GROUPS, SSM_GROUP_DIM, SSM_STATE), SSM_STATE ** -0.5),
        'ssm_c_im': nrm((N_SSM_LAYERS, SSM_GROUPS, SSM_GROUP_DIM, SSM_STATE), SSM_STATE ** -0.5),
        'ssm_d': nrm((N_SSM_LAYERS, SSM_WIDTH), 1.0),
        'ssm_w_glu': nrm((N_SSM_LAYERS, SSM_WIDTH, SSM_WIDTH), SSM_WIDTH ** -0.5),
        'ssm_b_glu': nrm((N_SSM_LAYERS, SSM_WIDTH), 0.01),
        'ffn_w_up': nrm((DEPTH, D_MODEL, 2 * D_FF), D_MODEL ** -0.5),
        'ffn_conv_w': nrm((DEPTH, CONV_W, D_FF), CONV_W ** -0.5),
        'ffn_conv_b': nrm((DEPTH, D_FF), 0.01),
        'ffn_w_down': nrm((DEPTH, D_FF, D_MODEL), D_FF ** -0.5),
    }


def reference(x_prompt, x_sample, mem_prompt, cache_mem_k, cache_mem_v, state_ssm_re, state_ssm_im,
              state_conv, g_mix, g_ffn, g_mem, g_final, w_mem_kv, sg_w_in, sg_w_out, sg_g_v, sg_w_s,
              sg_b_s, ssm_w_in, ssm_w_out, ssm_lam_re, ssm_lam_im, ssm_log_dt, ssm_b_re, ssm_b_im,
              ssm_c_re, ssm_c_im, ssm_d, ssm_w_glu, ssm_b_glu, ffn_w_up, ffn_conv_w, ffn_conv_b,
              ffn_w_down):
    p = {'g_mix': g_mix, 'g_ffn': g_ffn, 'g_final': g_final,
         'sg_w_in': sg_w_in, 'sg_w_out': sg_w_out, 'sg_g_v': sg_g_v, 'sg_w_s': sg_w_s, 'sg_b_s': sg_b_s,
         'ssm_w_in': ssm_w_in, 'ssm_w_out': ssm_w_out, 'ssm_lam_re': ssm_lam_re, 'ssm_lam_im': ssm_lam_im,
         'ssm_log_dt': ssm_log_dt, 'ssm_b_re': ssm_b_re, 'ssm_b_im': ssm_b_im, 'ssm_c_re': ssm_c_re,
         'ssm_c_im': ssm_c_im, 'ssm_d': ssm_d, 'ssm_w_glu': ssm_w_glu, 'ssm_b_glu': ssm_b_glu,
         'ffn_w_up': ffn_w_up, 'ffn_conv_w': ffn_conv_w, 'ffn_conv_b': ffn_conv_b, 'ffn_w_down': ffn_w_down}
    bsz = x_prompt.shape[0]
    dt = x_prompt.dtype
    kv = [mem_kv(mem_prompt, g_mem[i], w_mem_kv[i]) for i in range(DEPTH)]
    mem_k_prompt = jnp.stack([k for k, _ in kv])
    mem_v_prompt = jnp.stack([v for _, v in kv])
    zero_re = jnp.zeros((N_SSM_LAYERS, bsz, SSM_GROUPS, SSM_STATE), dt)
    zero_im = jnp.zeros((N_SSM_LAYERS, bsz, SSM_GROUPS, SSM_STATE), dt)
    zero_conv = jnp.zeros((DEPTH, bsz, CONV_W - 1, D_FF), dt)
    y_prompt, _, ssm_re_prompt, ssm_im_prompt, conv_prompt = trunk(
        x_prompt, mem_k_prompt, mem_v_prompt, zero_re, zero_im, zero_conv, p)
    y_sample, sg_v_sample, ssm_re_sample, ssm_im_sample, conv_sample = trunk(
        x_sample, cache_mem_k, cache_mem_v, state_ssm_re, state_ssm_im, state_conv, p)
    return (y_prompt, y_sample, mem_k_prompt, mem_v_prompt, ssm_re_prompt, ssm_im_prompt, conv_prompt,
            ssm_re_sample, ssm_im_sample, conv_sample, sg_v_sample)
```

```cpp
#include <hip/hip_runtime.h>
#include <cstdio>
#include <cstdint>
namespace pg8 {
#define PG8_LAS __attribute__((address_space(3)))
typedef unsigned short bf16_t;
typedef short bf16x8 __attribute__((ext_vector_type(8)));
typedef float f32x4 __attribute__((ext_vector_type(4)));
typedef unsigned u32x4 __attribute__((ext_vector_type(4)));
constexpr int BM = 256, BK = 64, HALF = 128, HTB = HALF * BK * 2  , STAGE_BYTES = 8 * HTB, NXCD = 8, WGM = 8;

__host__ __device__ __forceinline__ int lds_byte(int r, int c) { const int st = (r >> 4) * 2 + (c >> 5), rr = r & 15, cc = c & 31, ob = rr * 64 + cc * 2; return st * 1024 + (ob ^ (((ob >> 9) & 1) << 5)); }
__host__ __device__ __forceinline__ void stage_rc(int b, int& R, int& C) { const int st = b / 1024, sb = b % 1024, swz = sb ^ (((sb >> 9) & 1) << 5); R = (st >> 1) * 16 + swz / 64; C = (st & 1) * 32 + (swz % 64) / 2; }
__host__ __device__ __forceinline__ int perm32(int rho) { const int n = rho >> 4, i = rho & 15; return 8 * (i >> 2) + 4 * n + (i & 3); }

struct Unit { int pm, pn; };
struct Gemm { const bf16_t* A; const bf16_t* Bt; int M, N, K; };

struct StaticOrder {
    int nM, nN, nwg, G, c;
    __host__ __device__ void init(int M, int N, int G_, int c_) { nM = M / BM; nN = N / BM; nwg = nM * nN; G = G_; c = c_; }
    __host__ __device__ bool next(int i, Unit& u) const {
        const long L = (long)i * G + c; if (L >= nwg) return false;
        int wgid = (int)L; { const int q = nwg / NXCD, r = nwg % NXCD, xcd = wgid % NXCD, off = wgid / NXCD; wgid = (xcd < r ? xcd * (q + 1) : r * (q + 1) + (xcd - r) * q) + off; }
        const int nig = WGM * nN, gid = wgid / nig, fm = gid * WGM, gsz = (nM - fm) < WGM ? (nM - fm) : WGM;
        u.pm = fm + ((wgid % nig) % gsz); u.pn = (wgid % nig) / gsz; return true;
    }
    __device__ __forceinline__ void a_ready(const Unit&) const {}
    __device__ __forceinline__ void done(const Unit&) const {}
};
__device__ __forceinline__ unsigned cvt_pk_bf16(float lo, float hi) { unsigned r; asm volatile("v_cvt_pk_bf16_f32 %0, %1, %2" : "=v"(r) : "v"(lo), "v"(hi)); return r; }
typedef float f32x2 __attribute__((ext_vector_type(2)));
template <class Epi, class Sched, bool ALIGN_EPI = false, bool SP2 = false>
__device__ __forceinline__ void gemm_phase(PG8_LAS unsigned char* lds, const Gemm g, const Sched& S, const Epi& E) {
    int tid = threadIdx.x; asm volatile("" : "+v"(tid)); const int wid = __builtin_amdgcn_readfirstlane(tid >> 6), lane = tid & 63, wr = wid >> 2, wc = wid & 3, fr = lane & 15, fq = lane >> 4;
    const int K = g.K, nt = K / BK;
    unsigned voffA[2], voffB[2];
#pragma unroll
    for (int i = 0; i < 2; ++i) { int R, C; stage_rc(tid * 16 + i * 8192, R, C); const int Rb = Epi::PERM ? ((R & ~31) + perm32(R & 31)) : R;
        voffA[i] = (unsigned)(R * K + C) * 2u; voffB[i] = (unsigned)(Rb * K + C) * 2u; }
    const size_t kstep = (size_t)(BK * 2);
    const size_t hstep = (size_t)HALF * K * 2;
    const size_t tstep = 2 * hstep;
    const unsigned ldsw = (unsigned)wid * 1024u;
    const int aoff = lds_byte(wr * 64 + fr, fq * 8), boff = lds_byte(wc * 32 + fr, fq * 8);
#define PG8_SA(b, h) (((b) * 2 + (h)) * HTB)
#define PG8_SB(b, h) ((4 + (b) * 2 + (h)) * HTB)
#define PG8_STAGE(bufoff, gbase, voff) do { _Pragma("unroll") for (int _i = 0; _i < 2; ++_i) \
        __builtin_amdgcn_global_load_lds((const unsigned*)((const char*)(gbase) + (voff)[_i]), (PG8_LAS unsigned*)(lds + (bufoff) + ldsw + _i * 8192), 16, 0, 0); } while (0)
#define PG8_LDA(dst, b, h) do { _Pragma("unroll") for (int m = 0; m < 4; ++m) _Pragma("unroll") for (int k = 0; k < 2; ++k) dst[m][k] = *(const PG8_LAS bf16x8*)(lds + PG8_SA(b, h) + aoff + m * 2048 + k * 1024); } while (0)
#define PG8_LDB(dst, b, h) do { _Pragma("unroll") for (int n = 0; n < 2; ++n) _Pragma("unroll") for (int k = 0; k < 2; ++k) dst[n][k] = *(const PG8_LAS bf16x8*)(lds + PG8_SB(b, h) + boff + n * 2048 + k * 1024); } while (0)
#define PG8_MMA(ai, bj, At, Bt) do { __builtin_amdgcn_s_setprio(1); _Pragma("unroll") for (int m = 0; m < 4; ++m) _Pragma("unroll") for (int n = 0; n < 2; ++n) _Pragma("unroll") for (int k = 0; k < 2; ++k) \
        acc[ai][bj][m][n] = __builtin_amdgcn_mfma_f32_16x16x32_bf16(Bt[n][k], At[m][k], acc[ai][bj][m][n], 0, 0, 0); __builtin_amdgcn_s_setprio(0); } while (0)
#define PG8_WAIT_V(n) asm volatile("s_waitcnt vmcnt(" #n ")" ::: "memory")
#define PG8_WAIT_L(n) asm volatile("s_waitcnt lgkmcnt(" #n ")" ::: "memory")
#define PG8_BAR __builtin_amdgcn_s_barrier()
#define PG8_SCHED __builtin_amdgcn_sched_barrier(0)
    Unit cur, nxt; int ui = 0;
    if (!S.next(0, cur)) return;
    f32x4 acc[2][2][4][2];
#pragma unroll
    for (int a = 0; a < 2; ++a)
#pragma unroll
        for (int b = 0; b < 2; ++b)
#pragma unroll
            for (int m = 0; m < 4; ++m)
#pragma unroll
                for (int n = 0; n < 2; ++n) acc[a][b][m][n] = (f32x4){0.f, 0.f, 0.f, 0.f};
    bf16x8 At[4][2], B0[2][2], B1[2][2];
    const char* cA = (const char*)g.A + (size_t)cur.pm * tstep; const char* cB = (const char*)g.Bt + (size_t)cur.pn * tstep;
    S.a_ready(cur);
    if constexpr (SP2) {
        PG8_STAGE(PG8_SB(0, 0), cB, voffB); PG8_STAGE(PG8_SB(0, 1), cB + hstep, voffB); PG8_STAGE(PG8_SA(0, 0), cA, voffA); PG8_STAGE(PG8_SA(0, 1), cA + hstep, voffA);
        if (wr == 1) PG8_BAR;
        PG8_WAIT_V(2); PG8_BAR;
        PG8_STAGE(PG8_SB(1, 0), cB + kstep, voffB); PG8_STAGE(PG8_SA(1, 0), cA + kstep, voffA); PG8_STAGE(PG8_SB(1, 1), cB + hstep + kstep, voffB);
        PG8_WAIT_V(6); PG8_BAR;
    } else {
        PG8_STAGE(PG8_SB(0, 0), cB, voffB); PG8_STAGE(PG8_SA(0, 0), cA, voffA); PG8_STAGE(PG8_SB(0, 1), cB + hstep, voffB); PG8_STAGE(PG8_SA(0, 1), cA + hstep, voffA);
        if (wr == 1) PG8_BAR;
        PG8_WAIT_V(4); PG8_BAR;
        PG8_STAGE(PG8_SB(1, 0), cB + kstep, voffB); PG8_STAGE(PG8_SA(1, 0), cA + kstep, voffA); PG8_STAGE(PG8_SB(1, 1), cB + hstep + kstep, voffB);
        PG8_WAIT_V(6); PG8_BAR;
    }
    for (;;) {
        const bool has_next = S.next(ui + 1, nxt);
        const char* nA = has_next ? (const char*)g.A + (size_t)nxt.pm * tstep : cA; const char* nB = has_next ? (const char*)g.Bt + (size_t)nxt.pn * tstep : cB;
        for (int t = 0; t < nt; t += 2) {
            const bool last = (t == nt - 2);
            const char* a1 = cA + (size_t)(t + 1) * kstep;
            const char* a2 = last ? nA : cA + (size_t)(t + 2) * kstep; const char* b2 = last ? nB : cB + (size_t)(t + 2) * kstep;
            const char* a3 = a2 + kstep; const char* b3 = b2 + kstep;
            if (last && has_next) S.a_ready(nxt);
            if constexpr (SP2) {
            PG8_LDB(B0, 0, 0); PG8_LDB(B1, 0, 1); PG8_SCHED; PG8_LDA(At, 0, 0); PG8_STAGE(PG8_SA(1, 1), a1 + hstep, voffA);
            PG8_WAIT_V(8); PG8_WAIT_L(0); PG8_BAR; PG8_MMA(0, 0, At, B0); PG8_MMA(0, 1, At, B1); PG8_BAR; PG8_SCHED;
            PG8_LDA(At, 0, 1); PG8_STAGE(PG8_SB(0, 0), b2, voffB); PG8_STAGE(PG8_SB(0, 1), b2 + hstep, voffB); PG8_STAGE(PG8_SA(0, 0), a2, voffA);
            PG8_WAIT_V(8); PG8_WAIT_L(0); PG8_BAR; PG8_MMA(1, 0, At, B0); PG8_MMA(1, 1, At, B1); PG8_BAR; PG8_SCHED;
            PG8_LDB(B0, 1, 0); PG8_LDB(B1, 1, 1); PG8_SCHED; PG8_LDA(At, 1, 0); PG8_STAGE(PG8_SA(0, 1), a2 + hstep, voffA);
            PG8_WAIT_V(8); PG8_WAIT_L(0); PG8_BAR; PG8_MMA(0, 0, At, B0); PG8_MMA(0, 1, At, B1); PG8_BAR; PG8_SCHED;
            PG8_LDA(At, 1, 1); PG8_STAGE(PG8_SB(1, 0), b3, voffB); PG8_STAGE(PG8_SB(1, 1), b3 + hstep, voffB); PG8_STAGE(PG8_SA(1, 0), a3, voffA);
            PG8_WAIT_V(8); PG8_WAIT_L(0); PG8_BAR; PG8_MMA(1, 0, At, B0); PG8_MMA(1, 1, At, B1); PG8_BAR; PG8_SCHED;
            } else {
            PG8_LDB(B0, 0, 0); PG8_SCHED; PG8_LDA(At, 0, 0); PG8_STAGE(PG8_SA(1, 1), a1 + hstep, voffA);
            PG8_WAIT_L(8); PG8_BAR; PG8_WAIT_L(0); PG8_MMA(0, 0, At, B0); PG8_BAR; PG8_SCHED;
            PG8_LDB(B1, 0, 1); PG8_STAGE(PG8_SB(0, 0), b2, voffB);
            PG8_BAR; PG8_WAIT_L(0); PG8_MMA(0, 1, At, B1); PG8_BAR;
            PG8_LDA(At, 0, 1); PG8_STAGE(PG8_SA(0, 0), a2, voffA);
            PG8_BAR; PG8_WAIT_L(0); PG8_MMA(1, 0, At, B0); PG8_BAR; PG8_SCHED;
            PG8_STAGE(PG8_SB(0, 1), b2 + hstep, voffB);
            PG8_WAIT_V(6); PG8_BAR; PG8_MMA(1, 1, At, B1); PG8_BAR;
            PG8_LDB(B0, 1, 0); PG8_SCHED; PG8_LDA(At, 1, 0); PG8_STAGE(PG8_SA(0, 1), a2 + hstep, voffA);
            PG8_WAIT_L(8); PG8_BAR; PG8_WAIT_L(0); PG8_MMA(0, 0, At, B0); PG8_BAR; PG8_SCHED;
            PG8_LDB(B1, 1, 1); PG8_STAGE(PG8_SB(1, 0), b3, voffB);
            PG8_BAR; PG8_WAIT_L(0); PG8_MMA(0, 1, At, B1); PG8_BAR;
            PG8_LDA(At, 1, 1); PG8_STAGE(PG8_SA(1, 0), a3, voffA);
            PG8_BAR; PG8_WAIT_L(0); PG8_MMA(1, 0, At, B0); PG8_BAR; PG8_SCHED;
            PG8_STAGE(PG8_SB(1, 1), b3 + hstep, voffB);
            PG8_WAIT_V(6); PG8_BAR; PG8_MMA(1, 1, At, B1); PG8_BAR;
            }
        }
        if constexpr (ALIGN_EPI) { if (wr == 0) PG8_BAR; }
        if constexpr (!Epi::AFTER_DRAIN) { E(acc, cur, wr, wc, fr, fq); S.done(cur); }
        if (!has_next) break;
#pragma unroll
        for (int a = 0; a < 2; ++a)
#pragma unroll
            for (int b = 0; b < 2; ++b)
#pragma unroll
                for (int m = 0; m < 4; ++m)
#pragma unroll
                    for (int n = 0; n < 2; ++n) acc[a][b][m][n] = (f32x4){0.f, 0.f, 0.f, 0.f};
        cur = nxt; cA = nA; cB = nB; ++ui;
        if constexpr (ALIGN_EPI) { if (wr == 1) PG8_BAR; }
    }
    PG8_WAIT_V(0);
    if constexpr (!ALIGN_EPI) { if (wr == 0) PG8_BAR; }
    PG8_BAR;
    if constexpr (Epi::AFTER_DRAIN) { E.fused(acc, cur, wr, wc, fr, fq, lds, wid, lane); S.done(cur); }
#undef PG8_SA
#undef PG8_SB
#undef PG8_STAGE
#undef PG8_LDA
#undef PG8_LDB
#undef PG8_MMA
#undef PG8_WAIT_V
#undef PG8_WAIT_L
#undef PG8_BAR
#undef PG8_SCHED
}
}
#define LAS_BAR __attribute__((address_space(3)))
#define XB_TMO      128
#define XB_XCNT(j)  (256  + 64 * (j))
#define XB_XSUB(j)  (1280 + 64 * (j))
#define XB_XGEN(j)  (2304 + 64 * (j))
#define XB_TOP      3328
#define XB_TOPGEN   3392
#define XCD_BAR_WORDS 3456
#define XB_SPIN_CAP (1u << 18)

__device__ __forceinline__ unsigned xb_ld(unsigned* p)              { return __hip_atomic_load(p, __ATOMIC_RELAXED, __HIP_MEMORY_SCOPE_AGENT); }
__device__ __forceinline__ unsigned xb_add(unsigned* p, unsigned v) { return __hip_atomic_fetch_add(p, v, __ATOMIC_RELAXED, __HIP_MEMORY_SCOPE_AGENT); }
__device__ __forceinline__ unsigned xb_xcc_id() { return (unsigned)__builtin_amdgcn_s_getreg((3 << 11) | 20) & 0xFu; }
#define XB_SPIN(cond, bar) do { unsigned _sp = 0; while (cond) { __builtin_amdgcn_s_sleep(1); \
    if ((++_sp & 255u) == 0u) { if (xb_ld(&(bar)[XB_TMO])) break; if (_sp > XB_SPIN_CAP) { atomicAdd(&(bar)[XB_TMO], 1u); break; } } } } while (0)

struct XcdBarrier {
    unsigned* bar; unsigned x;
    volatile LAS_BAR unsigned* st;
};

__device__ __forceinline__ XcdBarrier xcd_barrier_post(unsigned* bar, volatile LAS_BAR unsigned* st) {
    XcdBarrier b; b.bar = bar; b.x = xb_xcc_id(); b.st = st;
    if (threadIdx.x == 0) (void)xb_add(&bar[XB_XCNT(b.x)], 1u);
    return b;
}
__device__ __forceinline__ void xcd_barrier_complete(unsigned* bar, unsigned x, unsigned& nloc, unsigned& nx) {
    const unsigned G = gridDim.x * gridDim.y * gridDim.z;
    unsigned sum, cnt, mine, sp = 0u;
    for (;;) {
        sum = 0u; cnt = 0u; mine = 0u;
#pragma unroll
        for (unsigned j = 0; j < 16; ++j) { const unsigned c = xb_ld(&bar[XB_XCNT(j)]); sum += c; cnt += (c > 0u) ? 1u : 0u; mine = (j == x) ? c : mine; }
        if (sum == G) break;
        __builtin_amdgcn_s_sleep(1);
        if ((++sp & 255u) == 0u) { if (xb_ld(&bar[XB_TMO])) break; if (sp > XB_SPIN_CAP) { atomicAdd(&bar[XB_TMO], 1u); break; } }
    }
    nloc = mine > 0u ? mine : 1u; nx = cnt > 0u ? cnt : 1u;
}

__device__ __forceinline__ void xcd_barrier(const XcdBarrier& b) {
    asm volatile("s_waitcnt vmcnt(0)" ::: "memory");
    __syncthreads();
    if (threadIdx.x == 0) {
        unsigned* bar = b.bar;
        __builtin_amdgcn_s_waitcnt(0);
        unsigned nloc = b.st[0], nx = b.st[1];
        if (nloc == 0u) { xcd_barrier_complete(bar, b.x, nloc, nx); b.st[0] = nloc; b.st[1] = nx; }
        const unsigned old = xb_add(&bar[XB_XSUB(b.x)], 1u);
        const unsigned gen = old / nloc;
        if (old + 1u == (gen + 1u) * nloc) {
            __builtin_amdgcn_fence(__ATOMIC_RELEASE, "agent");
            asm volatile("s_waitcnt vmcnt(0)" ::: "memory");
            const unsigned og = xb_add(&bar[XB_TOP], 1u);
            const unsigned tg = og / nx;
            if (og + 1u == (tg + 1u) * nx) xb_add(&bar[XB_TOPGEN], 1u);
            else XB_SPIN(xb_ld(&bar[XB_TOPGEN]) == tg, bar);
            __builtin_amdgcn_fence(__ATOMIC_ACQUIRE, "agent");
            xb_add(&bar[XB_XGEN(b.x)], 1u);
            asm volatile("s_waitcnt vmcnt(0)" ::: "memory");
        } else {
            XB_SPIN(xb_ld(&bar[XB_XGEN(b.x)]) == gen, bar);
            __builtin_amdgcn_fence(__ATOMIC_ACQUIRE, "agent");
            asm volatile("s_waitcnt vmcnt(0)" ::: "memory");
        }
    }
    __syncthreads();
}
#define GAS __attribute__((address_space(1)))
#define LAS __attribute__((address_space(3)))
typedef unsigned short bf16;
typedef unsigned v4u __attribute__((ext_vector_type(4)));
typedef unsigned v2u __attribute__((ext_vector_type(2)));
typedef float f32x4 __attribute__((ext_vector_type(4)));
typedef short bf16x8 __attribute__((ext_vector_type(8)));
typedef short bf16x4 __attribute__((ext_vector_type(4)));

constexpr int NWAVES = 8, NTHR = 512;
constexpr int D = 2048, SEQ = 2048, MP = 8192, MS = 128, MREAL = 8320, MT = 8448;
constexpr int MMEM = 1024, XAW = 512, TOKW = 1536, SGN = 3584, DFF = 5504, NUP = 11008;
constexpr int NGRP = 96, KH = 384;
constexpr float EPS = 1e-6f;
constexpr int NPHASE = 31;

constexpr size_t OFF_YP = 0, OFF_YS = 16777216, OFF_MK = 17039360, OFF_MV = 19136512, OFF_SRP = 21233664, OFF_SIP = 21282816,
                 OFF_CONVP = 21331968, OFF_SRS = 21508096, OFF_SIS = 23080960, OFF_CONVS = 24653824, OFF_SGV = 30289920, OUT_TOTAL = 30683136;

constexpr size_t MiB = 1u << 20;
constexpr size_t WS_CTL = 0, CTL_ZERO_BYTES = 1 * MiB;
constexpr size_t WS_WSGIN = 1 * MiB;
constexpr size_t WS_WSSMIN = WS_WSGIN + 28 * MiB;
constexpr size_t WS_WSGOUT = WS_WSSMIN + 16 * MiB;
constexpr size_t WS_WSSMOUT = WS_WSGOUT + 16 * MiB;
constexpr size_t WS_WGLU = WS_WSSMOUT + 16 * MiB;
constexpr size_t WS_WUP = WS_WGLU + 9 * MiB;
constexpr size_t WS_WDOWN = WS_WUP + 172 * MiB;
constexpr size_t WS_WMEM = WS_WDOWN + 86 * MiB;
constexpr size_t WS_WSB = WS_WMEM + 16 * MiB;
constexpr size_t WS_TB = WS_WSB + 1 * MiB;
constexpr size_t WS_BT2 = WS_TB + 36 * MiB;
constexpr size_t WS_LBT = WS_BT2 + 12 * MiB;
constexpr size_t WS_LB16 = WS_LBT + 128 * 1024;
constexpr size_t WS_BBAR = WS_LBT + 1 * MiB;
constexpr size_t WS_XRES = WS_BBAR + 2 * MiB;
constexpr size_t WS_XB = WS_XRES + 66 * MiB;
constexpr size_t WS_MEMB = WS_XB + 33 * MiB;
constexpr size_t WS_MKV = WS_MEMB + 4 * MiB;
constexpr size_t WS_ZU = WS_MKV + 8 * MiB;
constexpr size_t WS_ZV = WS_ZU + 25 * MiB;
constexpr size_t WS_Q = WS_ZV + 25 * MiB;
constexpr size_t WS_MIX = WS_Q + 9 * MiB;
constexpr size_t WS_AG = WS_MIX + 33 * MiB;
constexpr size_t WS_Y = WS_AG + 178 * MiB;
constexpr size_t WS_UH = WS_Y + 89 * MiB;
constexpr size_t WS_YB = WS_UH + 36 * MiB;
constexpr size_t WS_US = WS_YB + 25 * MiB;
constexpr size_t WS_END = WS_US + 1 * MiB;
constexpr int CW_BAR = 4096;
typedef unsigned long long ssq_t;
constexpr size_t CTL_SSX = 64 * 1024;
constexpr size_t CTL_SSV = 704 * 1024;
constexpr size_t CTL_SSMEM = 896 * 1024;
static_assert(CTL_SSX + 9 * MT * 8 <= CTL_SSV && CTL_SSV + 2 * MT * 8 <= CTL_SSMEM && CTL_SSMEM + 8192 <= CTL_ZERO_BYTES, "ctl map");

constexpr int LDS_BYTES = 147456, MISC_OFF = LDS_BYTES - 512;

__device__ __forceinline__ unsigned pk2(float lo, float hi) { return pg8::cvt_pk_bf16(lo, hi); }
__device__ __forceinline__ float bflo(unsigned w) { return __uint_as_float(w << 16); }
__device__ __forceinline__ float bfhi(unsigned w) { return __uint_as_float(w & 0xffff0000u); }
__device__ __forceinline__ float gelu_t(float x) { const float e = __builtin_amdgcn_exp2f(x * (-2.3022082f - 0.10294324f * x * x)); return x * __builtin_amdgcn_rcpf(1.f + e); }
__device__ __forceinline__ float sigmoid_f(float x) { return __builtin_amdgcn_rcpf(1.f + __builtin_amdgcn_exp2f(-1.4426950409f * x)); }
__device__ __forceinline__ ssq_t ss_fix(float v) { return (ssq_t)(long long)(v * 1073741824.0f); }
__device__ __forceinline__ float rstd_of(ssq_t ss, float inv_n) { return rsqrtf((float)ss * (1.0f / 1073741824.0f) * inv_n + EPS); }
__device__ __forceinline__ float wave_sum(float v) {
#pragma unroll
    for (int o = 1; o < 64; o <<= 1) v += __shfl_xor(v, o);
    return v;
}
__device__ __forceinline__ float wave_max(float v) {
#pragma unroll
    for (int o = 1; o < 64; o <<= 1) v = fmaxf(v, __shfl_xor(v, o));
    return v;
}
__device__ __forceinline__ void fadd_atomic(ssq_t* p, float v) { atomicAdd(p, ss_fix(v)); }
__device__ __forceinline__ f32x4 gelu4(f32x4 v) { return (f32x4){gelu_t(v[0]), gelu_t(v[1]), gelu_t(v[2]), gelu_t(v[3])}; }
__device__ __forceinline__ v4u pack8(f32x4 a, f32x4 b) { v4u w; w.x = pk2(a[0], a[1]); w.y = pk2(a[2], a[3]); w.z = pk2(b[0], b[1]); w.w = pk2(b[2], b[3]); return w; }
__device__ __forceinline__ float dot4(f32x4 a) { return (a[0] * a[0] + a[1] * a[1]) + (a[2] * a[2] + a[3] * a[3]); }

typedef const f32x4 (&AccRef)[2][2][4][2];
struct EpiSgIn {
    static constexpr bool PERM = true, AFTER_DRAIN = false;
    const ssq_t* ss; bf16* zu; bf16* zv; bf16* q; ssq_t* ssv;
    __device__ __forceinline__ void operator()(AccRef acc, const pg8::Unit& u, int wr, int wc, int fr, int fq) const {
        const int row0 = u.pm * 256 + wr * 64 + fr, colt = u.pn * 256 + wc * 32 + 8 * fq;
        const int kind = u.pn < 6 ? 0 : (u.pn < 12 ? 1 : 2);
#pragma unroll
        for (int ai = 0; ai < 2; ++ai)
#pragma unroll
            for (int m = 0; m < 4; ++m) {
                const int r = row0 + ai * 128 + m * 16; const float rs = rstd_of(ss[r], 1.f / 2048.f); float sq = 0.f;
#pragma unroll
                for (int bj = 0; bj < 2; ++bj) {
                    f32x4 v0 = acc[ai][bj][m][0] * rs, v1 = acc[ai][bj][m][1] * rs; const int c = colt + bj * 128;
                    if (kind < 2) { v0 = gelu4(v0); v1 = gelu4(v1); }
                    if (kind == 1) sq += dot4(v0) + dot4(v1);
                    bf16* dst = kind == 0 ? zu + (size_t)r * TOKW + c : (kind == 1 ? zv + (size_t)r * TOKW + (c - TOKW) : q + (size_t)r * XAW + (c - 2 * TOKW));
                    *(v4u*)dst = pack8(v0, v1);
                }
                if (kind == 1) { sq += __shfl_xor(sq, 16); sq += __shfl_xor(sq, 32); if (fq == 0) fadd_atomic(ssv + r, sq); }
                asm volatile("" ::: "memory");
            }
    }
};
struct EpiRes {
    static constexpr bool PERM = false, AFTER_DRAIN = false;
    float* xres; bf16* xb; ssq_t* ssn;
    __device__ __forceinline__ void operator()(AccRef acc, const pg8::Unit& u, int wr, int wc, int fr, int fq) const {
        const int row0 = u.pm * 256 + wr * 64 + fr, col0 = u.pn * 256 + wc * 32 + 4 * fq;
#pragma unroll
        for (int ai = 0; ai < 2; ++ai)
#pragma unroll
            for (int m = 0; m < 4; ++m) {
                const int r = row0 + ai * 128 + m * 16; float sq = 0.f;
                float* xp = xres + (size_t)r * D + col0; bf16* bp = xb + (size_t)r * D + col0;
#pragma unroll
                for (int bj = 0; bj < 2; ++bj)
#pragma unroll
                    for (int n = 0; n < 2; ++n) { const int off = bj * 128 + n * 16; const f32x4 o = *(const f32x4*)(xp + off) + acc[ai][bj][m][n]; *(f32x4*)(xp + off) = o; sq += dot4(o);
                        v2u w; w.x = pk2(o[0], o[1]); w.y = pk2(o[2], o[3]); *(v2u*)(bp + off) = w; }
                sq += __shfl_xor(sq, 16); sq += __shfl_xor(sq, 32); if (fq == 0) fadd_atomic(ssn + r, sq);
                asm volatile("" ::: "memory");
            }
    }
};
struct EpiUp {
    static constexpr bool PERM = true, AFTER_DRAIN = false;
    const ssq_t* ss; bf16* ag; float* out; int layer;
    __device__ __forceinline__ void operator()(AccRef acc, const pg8::Unit& u, int wr, int wc, int fr, int fq) const {
        const int row0 = u.pm * 256 + wr * 64 + fr, colt = u.pn * 256 + wc * 32 + 8 * fq;
#pragma unroll
        for (int ai = 0; ai < 2; ++ai)
#pragma unroll
            for (int m = 0; m < 4; ++m) {
                const int r = row0 + ai * 128 + m * 16; const float rs = rstd_of(ss[r], 1.f / 2048.f);
#pragma unroll
                for (int bj = 0; bj < 2; ++bj) {
                    const f32x4 v0 = acc[ai][bj][m][0] * rs, v1 = acc[ai][bj][m][1] * rs; const int c = colt + bj * 128;
                    *(v4u*)(ag + (size_t)r * NUP + c) = pack8(v0, v1);
                    if (c < DFF) {
                        float* o = nullptr;
                        if (r < MP) { const int t = r & (SEQ - 1); if (t >= SEQ - 2) o = out + OFF_CONVP + ((size_t)((layer * 4 + (r >> 11)) * 2 + (t - (SEQ - 2)))) * DFF + c; }
                        else if (r < MREAL) o = out + OFF_CONVS + ((size_t)((layer * MS + (r - MP)) * 2 + 1)) * DFF + c;
                        if (o) { *(f32x4*)o = v0; *(f32x4*)(o + 4) = v1; }
                    }
                }
                asm volatile("" ::: "memory");
            }
    }
};
struct EpiSsmIn {
    static constexpr bool PERM = true, AFTER_DRAIN = false;
    const ssq_t* ss; bf16* uh; float* us; bf16* q;
    __device__ __forceinline__ void operator()(AccRef acc, const pg8::Unit& u, int wr, int wc, int fr, int fq) const {
        const int row0 = u.pm * 256 + wr * 64 + fr, colt = u.pn * 256 + wc * 32 + 8 * fq;
#pragma unroll
        for (int ai = 0; ai < 2; ++ai)
#pragma unroll
            for (int m = 0; m < 4; ++m) {
                const int r = row0 + ai * 128 + m * 16; const float rs = rstd_of(ss[r], 1.f / 2048.f);
#pragma unroll
                for (int bj = 0; bj < 2; ++bj) {
                    const f32x4 v0 = acc[ai][bj][m][0] * rs, v1 = acc[ai][bj][m][1] * rs; const int c = colt + bj * 128;
                    if (u.pn < 6) {
                        if (r < MP) { const int h = c >> 4, c0 = c & 15; *(v4u*)(uh + ((size_t)(h * 512 + (r >> 4)) * KH + (r & 15) * 16 + c0)) = pack8(v0, v1); }
                        else if (r < MREAL) { float* o = us + (size_t)(r - MP) * TOKW + c; *(f32x4*)o = v0; *(f32x4*)(o + 4) = v1; }
                    } else *(v4u*)(q + (size_t)r * XAW + (c - TOKW)) = pack8(v0, v1);
                }
                asm volatile("" ::: "memory");
            }
    }
};
struct EpiToep {
    static constexpr bool PERM = true, AFTER_DRAIN = false;
    bf16* yb;
    __device__ __forceinline__ void operator()(AccRef acc, const pg8::Unit& u, int wr, int wc, int fr, int fq) const {
        const int h = u.pn, mh = u.pm - 2 * h;
#pragma unroll
        for (int ai = 0; ai < 2; ++ai)
#pragma unroll
            for (int m = 0; m < 4; ++m) {
                const int ml = mh * 256 + ai * 128 + wr * 64 + m * 16 + fr;
#pragma unroll
                for (int bj = 0; bj < 2; ++bj) {
                    const int cl = bj * 128 + wc * 32 + 8 * fq, tau = cl >> 4, c0 = cl & 15;
                    *(v4u*)(yb + (size_t)(ml * 16 + tau) * TOKW + h * 16 + c0) = pack8(gelu4(acc[ai][bj][m][0]), gelu4(acc[ai][bj][m][1]));
                    __builtin_amdgcn_sched_barrier(0);
                }
            }
    }
};
struct EpiGlu {
    static constexpr bool PERM = true, AFTER_DRAIN = false;
    const bf16* yb; const float* bias; bf16* mix;
    __device__ __forceinline__ void operator()(AccRef acc, const pg8::Unit& u, int wr, int wc, int fr, int fq) const {
        const int row0 = u.pm * 256 + wr * 64 + fr, colt = u.pn * 256 + wc * 32 + 8 * fq;
#pragma unroll
        for (int ai = 0; ai < 2; ++ai)
#pragma unroll
            for (int m = 0; m < 4; ++m) {
                const int r = row0 + ai * 128 + m * 16;
#pragma unroll
                for (int bj = 0; bj < 2; ++bj) {
                    const int c = colt + bj * 128; const f32x4 b0 = *(const f32x4*)(bias + c), b1 = *(const f32x4*)(bias + c + 4);
                    const v4u yw = *(const v4u*)(yb + (size_t)r * TOKW + c);
                    const f32x4 g0 = acc[ai][bj][m][0] + b0, g1 = acc[ai][bj][m][1] + b1;
                    f32x4 o0, o1;
                    o0[0] = bflo(yw.x) * sigmoid_f(g0[0]); o0[1] = bfhi(yw.x) * sigmoid_f(g0[1]); o0[2] = bflo(yw.y) * sigmoid_f(g0[2]); o0[3] = bfhi(yw.y) * sigmoid_f(g0[3]);
                    o1[0] = bflo(yw.z) * sigmoid_f(g1[0]); o1[1] = bfhi(yw.z) * sigmoid_f(g1[1]); o1[2] = bflo(yw.w) * sigmoid_f(g1[2]); o1[3] = bfhi(yw.w) * sigmoid_f(g1[3]);
                    *(v4u*)(mix + (size_t)r * D + c) = pack8(o0, o1);
                    asm volatile("" ::: "memory");
                }
            }
    }
};
struct EpiMem {
    static constexpr bool PERM = false, AFTER_DRAIN = false;
    const ssq_t* ssm; float* out; bf16* mkv;
    __device__ __forceinline__ void operator()(AccRef acc, const pg8::Unit& u, int wr, int wc, int fr, int fq) const {
        const int row0 = u.pm * 256 + wr * 64 + fr, col0 = u.pn * 256 + wc * 32 + 4 * fq;
#pragma unroll
        for (int ai = 0; ai < 2; ++ai)
#pragma unroll
            for (int m = 0; m < 4; ++m) {
                const int r = row0 + ai * 128 + m * 16; const float rs = rstd_of(ssm[r], 1.f / 2048.f);
#pragma unroll
                for (int bj = 0; bj < 2; ++bj)
#pragma unroll
                    for (int n = 0; n < 2; ++n) { const int c = col0 + bj * 128 + n * 16, li = c >> 10, cc = c & 1023; const f32x4 v = acc[ai][bj][m][n] * rs;
                        *(f32x4*)(out + (cc < 512 ? OFF_MK : OFF_MV) + (size_t)(li * 1024 + r) * 512 + (cc & 511)) = v;
                        v2u w; w.x = pk2(v[0], v[1]); w.y = pk2(v[2], v[3]); *(v2u*)(mkv + (size_t)(li * 1024 + r) * 1024 + cc) = w; }
            }
    }
};
struct ToepOrder {
    int G, c;
    __device__ bool next(int i, pg8::Unit& u) const { const int L = i * G + c; if (L >= 2 * NGRP) return false; const int h = L >> 1; u.pm = 2 * h + (L & 1); u.pn = h; return true; }
    __device__ __forceinline__ void a_ready(const pg8::Unit&) const {}
    __device__ __forceinline__ void done(const pg8::Unit&) const {}
};

__device__ __forceinline__ void p0_transpose_item(const float* W, const float* gain, int K, int N, bf16* WT, int row_off, LAS float* scr, int item, int lane) {
    const int nblk = N / 32, kb = item / nblk, nb = item % nblk, k0 = 64 * kb, n0 = 32 * nb;
#pragma unroll 8
    for (int i = 0; i < 32; ++i) { const int kk = 2 * i + (lane >> 5); const float g = gain ? gain[k0 + kk] : 1.f; scr[kk * 33 + (lane & 31)] = W[(size_t)(k0 + kk) * N + n0 + (lane & 31)] * g; }
    asm volatile("s_waitcnt lgkmcnt(0)" ::: "memory");
    const int c = lane & 7;
#pragma unroll
    for (int j = 0; j < 4; ++j) { const int n = (lane >> 3) + 8 * j; const LAS float* s = scr + (8 * c) * 33 + n;
        v4u o; o.x = pk2(s[0 * 33], s[1 * 33]); o.y = pk2(s[2 * 33], s[3 * 33]); o.z = pk2(s[4 * 33], s[5 * 33]); o.w = pk2(s[6 * 33], s[7 * 33]);
        *(v4u*)(WT + (size_t)(row_off + n0 + n) * K + k0 + 8 * c) = o; }
    asm volatile("s_waitcnt lgkmcnt(0)" ::: "memory");
}
__device__ __forceinline__ void p0_row(const float* src, float* dstf, bf16* dstb, ssq_t* ssp, int lane) {
    f32x4 v[8]; float s = 0.f;
#pragma unroll
    for (int j = 0; j < 8; ++j) { v[j] = src ? ((const f32x4*)src)[lane + 64 * j] : (f32x4){0.f, 0.f, 0.f, 0.f}; s += dot4(v[j]); }
    s = wave_sum(s);
#pragma unroll
    for (int j = 0; j < 8; ++j) { if (dstf) ((f32x4*)dstf)[lane + 64 * j] = v[j]; v2u w; w.x = pk2(v[j][0], v[j][1]); w.y = pk2(v[j][2], v[j][3]); ((v2u*)dstb)[lane + 64 * j] = w; }
    if (lane == 0) *ssp = ss_fix(s);
}
__device__ __forceinline__ void s5_tables(LAS float* L, int j, int h, const float* lam_re, const float* lam_im, const float* log_dt, const float* b_re, const float* b_im,
                                          const float* c_re, const float* c_im, const float* dvec, bf16* TB, bf16* BT2, float* LBT, float* LB16, float* BBART, int tid) {
    LAS float* PWr = L; LAS float* PWi = L + 1088; LAS float* BBr = L + 2176; LAS float* BBi = L + 3200; LAS float* Cr = L + 4224; LAS float* Ci = L + 5248; LAS float* KM = L + 6272;
    const int gh = j * NGRP + h;
    if (tid < 64) {
        const int p = tid, idx = gh * 64 + p; const float lr = lam_re[idx], li = lam_im[idx], dt = expf(log_dt[gh]);
        const float ar = lr * dt, ai = li * dt, mag = expf(ar); float sn, cs; sincosf(ai, &sn, &cs);
        const float lbr = mag * cs, lbi = mag * sn; const float sh = sinf(0.5f * ai);
        const float nr = expm1f(ar) * cs - 2.f * sh * sh, ni = lbi, den = lr * lr + li * li;
        const float kr = (nr * lr + ni * li) / den, ki = (ni * lr - nr * li) / den;
        float pr = 1.f, pi = 0.f;
#pragma unroll
        for (int n = 0; n < 17; ++n) { PWr[p * 17 + n] = pr; PWi[p * 17 + n] = pi; if (n == 16) { LB16[idx * 2] = pr; LB16[idx * 2 + 1] = pi; } const float t = pr * lbr - pi * lbi; pi = pr * lbi + pi * lbr; pr = t; }
        LBT[idx * 2] = lbr; LBT[idx * 2 + 1] = lbi;
#pragma unroll
        for (int c = 0; c < 16; ++c) { const float br = b_re[(size_t)idx * 16 + c], bi = b_im[(size_t)idx * 16 + c]; const float xr = kr * br - ki * bi, xi = kr * bi + ki * br;
            BBr[p * 16 + c] = xr; BBi[p * 16 + c] = xi; BBART[((size_t)idx * 16 + c) * 2] = xr; BBART[((size_t)idx * 16 + c) * 2 + 1] = xi; }
    }
#pragma unroll
    for (int i = 0; i < 2; ++i) { const int e = tid + 512 * i; Cr[e] = c_re[(size_t)gh * 1024 + e]; Ci[e] = c_im[(size_t)gh * 1024 + e]; }
    __syncthreads();
#pragma unroll 1
    for (int i = 0; i < 8; ++i) {
        const int e = tid * 8 + i, dl = e >> 8, c = (e >> 4) & 15, c2 = e & 15; float s = 0.f;
#pragma unroll 4
        for (int p = 0; p < 64; ++p) { const float wr_ = PWr[p * 17 + dl], wi_ = PWi[p * 17 + dl], xr = BBr[p * 16 + c2], xi = BBi[p * 16 + c2];
            s += Cr[c * 64 + p] * (wr_ * xr - wi_ * xi) - Ci[c * 64 + p] * (wr_ * xi + wi_ * xr); }
        if (dl == 0 && c == c2) s += dvec[j * TOKW + h * 16 + c];
        KM[e] = s;
    }
    __syncthreads();
#pragma unroll 1
    for (int it = 0; it < 24; ++it) {
        const int grp = tid + 512 * it, row = grp / 48, cg = grp % 48, tau = row >> 4, c = row & 15; float v[8];
        if (cg < 32) { const int sg = cg >> 1, c0 = (cg & 1) * 8;
#pragma unroll
            for (int i = 0; i < 8; ++i) v[i] = sg <= tau ? KM[(tau - sg) * 256 + c * 16 + c0 + i] : 0.f; }
        else if (cg < 40) {
#pragma unroll
            for (int i = 0; i < 8; ++i) { const int p = (cg - 32) * 8 + i; v[i] = Cr[c * 64 + p] * PWr[p * 17 + tau + 1] - Ci[c * 64 + p] * PWi[p * 17 + tau + 1]; } }
        else {
#pragma unroll
            for (int i = 0; i < 8; ++i) { const int p = (cg - 40) * 8 + i; v[i] = -(Cr[c * 64 + p] * PWi[p * 17 + tau + 1] + Ci[c * 64 + p] * PWr[p * 17 + tau + 1]); } }
        v4u w; w.x = pk2(v[0], v[1]); w.y = pk2(v[2], v[3]); w.z = pk2(v[4], v[5]); w.w = pk2(v[6], v[7]);
        *(v4u*)(TB + ((size_t)gh * 256 + row) * KH + cg * 8) = w;
    }
#pragma unroll 1
    for (int it = 0; it < 8; ++it) {
        const int grp = tid + 512 * it, row = grp >> 5, cg = grp & 31, ri = row >> 6, p = row & 63, n = 15 - (cg >> 1), c0 = (cg & 1) * 8; float v[8];
        const float wr_ = PWr[p * 17 + n], wi_ = PWi[p * 17 + n];
#pragma unroll
        for (int i = 0; i < 8; ++i) { const float xr = BBr[p * 16 + c0 + i], xi = BBi[p * 16 + c0 + i]; v[i] = ri == 0 ? (wr_ * xr - wi_ * xi) : (wr_ * xi + wi_ * xr); }
        v4u w; w.x = pk2(v[0], v[1]); w.y = pk2(v[2], v[3]); w.z = pk2(v[4], v[5]); w.w = pk2(v[6], v[7]);
        *(v4u*)(BT2 + ((size_t)gh * 128 + row) * 256 + cg * 8) = w;
    }
    __syncthreads();
}

constexpr int KS_LD = 136, VT_LD = 264, VT_OFF = 256 * KS_LD * 2;
__device__ __forceinline__ void attn_prompt_unit(LAS unsigned char* lds, const bf16* q, const bf16* mkv_l, bf16* mix, int unit, int tid) {
    const int b = unit >> 6, hd = (unit >> 4) & 3, qb = unit & 15, lane = tid & 63, w = tid >> 6, fr = lane & 15, fq = lane >> 4;
    LAS bf16* Ks = (LAS bf16*)lds; LAS bf16* Vt = (LAS bf16*)(lds + VT_OFF);
    const bf16* kvb = mkv_l + (size_t)(b * 256) * 1024 + hd * 128;
#pragma unroll
    for (int it = 0; it < 8; ++it) { const int id = tid + 512 * it, key = id >> 4, part = id & 15;
        const v4u kw = *(const v4u*)(kvb + (size_t)key * 1024 + part * 8); *(LAS v4u*)(Ks + key * KS_LD + part * 8) = kw;
        const v4u vw = *(const v4u*)(kvb + (size_t)key * 1024 + 512 + part * 8); LAS bf16* vp = Vt + (part * 8) * VT_LD + key;
        vp[0] = (bf16)(vw.x & 0xffff); vp[VT_LD] = (bf16)(vw.x >> 16); vp[2 * VT_LD] = (bf16)(vw.y & 0xffff); vp[3 * VT_LD] = (bf16)(vw.y >> 16);
        vp[4 * VT_LD] = (bf16)(vw.z & 0xffff); vp[5 * VT_LD] = (bf16)(vw.z >> 16); vp[6 * VT_LD] = (bf16)(vw.w & 0xffff); vp[7 * VT_LD] = (bf16)(vw.w >> 16); }
    const int r = b * SEQ + qb * 128 + w * 16 + fr;
    bf16x8 qf[4];
#pragma unroll
    for (int ks = 0; ks < 4; ++ks) qf[ks] = *(const bf16x8*)(q + (size_t)r * XAW + hd * 128 + ks * 32 + fq * 8);
    __syncthreads();
    f32x4 s[16];
#pragma unroll
    for (int t = 0; t < 16; ++t) { s[t] = (f32x4){0.f, 0.f, 0.f, 0.f};
#pragma unroll
        for (int ks = 0; ks < 4; ++ks) { const bf16x8 kf = *(const LAS bf16x8*)(Ks + (t * 16 + fr) * KS_LD + ks * 32 + fq * 8); s[t] = __builtin_amdgcn_mfma_f32_16x16x32_bf16(kf, qf[ks], s[t], 0, 0, 0); } }
    float mx = -3.0e38f;
#pragma unroll
    for (int t = 0; t < 16; ++t) mx = fmaxf(fmaxf(fmaxf(s[t][0], s[t][1]), fmaxf(s[t][2], s[t][3])), mx);
    mx = fmaxf(mx, __shfl_xor(mx, 16)); mx = fmaxf(mx, __shfl_xor(mx, 32));
    const float sc = 0.08838834764831845f * 1.4426950408889634f; float sum = 0.f;
#pragma unroll
    for (int t = 0; t < 16; ++t) {
#pragma unroll
        for (int jj = 0; jj < 4; ++jj) { const float p = __builtin_amdgcn_exp2f((s[t][jj] - mx) * sc); s[t][jj] = p; sum += p; } }
    sum += __shfl_xor(sum, 16); sum += __shfl_xor(sum, 32);
    f32x4 o[8];
#pragma unroll
    for (int dt = 0; dt < 8; ++dt) o[dt] = (f32x4){0.f, 0.f, 0.f, 0.f};
#pragma unroll
    for (int kk = 0; kk < 8; ++kk) {
        v4u pw; pw.x = pk2(s[2 * kk][0], s[2 * kk][1]); pw.y = pk2(s[2 * kk][2], s[2 * kk][3]); pw.z = pk2(s[2 * kk + 1][0], s[2 * kk + 1][1]); pw.w = pk2(s[2 * kk + 1][2], s[2 * kk + 1][3]);
        const bf16x8 pf = __builtin_bit_cast(bf16x8, pw);
#pragma unroll
        for (int dt = 0; dt < 8; ++dt) { const LAS bf16* vp = Vt + (dt * 16 + fr) * VT_LD + kk * 32 + fq * 4;
            v4u vw; const v2u lo = *(const LAS v2u*)vp, hi = *(const LAS v2u*)(vp + 16); vw.x = lo.x; vw.y = lo.y; vw.z = hi.x; vw.w = hi.y;
            o[dt] = __builtin_amdgcn_mfma_f32_16x16x32_bf16(__builtin_bit_cast(bf16x8, vw), pf, o[dt], 0, 0, 0); } }
    const float inv = 1.f / sum;
#pragma unroll
    for (int dt = 0; dt < 8; ++dt) { v2u w2; w2.x = pk2(o[dt][0] * inv, o[dt][1] * inv); w2.y = pk2(o[dt][2] * inv, o[dt][3] * inv);
        *(v2u*)(mix + (size_t)r * D + TOKW + hd * 128 + dt * 16 + fq * 4) = w2; }
    __syncthreads();
}
__device__ __forceinline__ void attn_sample_unit(LAS unsigned char* lds, const bf16* q, const float* ck, const float* cv, bf16* mix, int li, int unit, int tid) {
    const int b = unit >> 1, hp = unit & 1, lane = tid & 63, w = tid >> 6, hd = 2 * hp + (w >> 2), kq = (w & 3) * 64, dd = lane & 15, kg = lane >> 4;
    LAS float* red = (LAS float*)lds;
    const v4u qw = *(const v4u*)(q + (size_t)(MP + b) * XAW + hd * 128 + dd * 8);
    float qv[8] = {bflo(qw.x), bfhi(qw.x), bflo(qw.y), bfhi(qw.y), bflo(qw.z), bfhi(qw.z), bflo(qw.w), bfhi(qw.w)};
    const size_t base = ((size_t)(li * MS + b) * 256) * 512 + hd * 128 + dd * 8;
    float sc[16];
#pragma unroll
    for (int it = 0; it < 16; ++it) { const int key = kq + 4 * it + kg; const float* kp = ck + base + (size_t)key * 512; const f32x4 k0 = *(const f32x4*)kp, k1 = *(const f32x4*)(kp + 4);
        float d = qv[0] * k0[0] + qv[1] * k0[1] + qv[2] * k0[2] + qv[3] * k0[3] + qv[4] * k1[0] + qv[5] * k1[1] + qv[6] * k1[2] + qv[7] * k1[3];
        d += __shfl_xor(d, 1); d += __shfl_xor(d, 2); d += __shfl_xor(d, 4); d += __shfl_xor(d, 8); sc[it] = d; }
    float mx = sc[0];
#pragma unroll
    for (int it = 1; it < 16; ++it) mx = fmaxf(mx, sc[it]);
    mx = fmaxf(mx, __shfl_xor(mx, 16)); mx = fmaxf(mx, __shfl_xor(mx, 32));
    if (lane == 0) red[w] = mx;
    __syncthreads();
    const int w0 = w & 4; mx = fmaxf(fmaxf(red[w0], red[w0 + 1]), fmaxf(red[w0 + 2], red[w0 + 3]));
    const float scl = 0.08838834764831845f * 1.4426950408889634f; float sum = 0.f;
    float oacc[8] = {0.f, 0.f, 0.f, 0.f, 0.f, 0.f, 0.f, 0.f};
#pragma unroll
    for (int it = 0; it < 16; ++it) { const float p = __builtin_amdgcn_exp2f((sc[it] - mx) * scl); sum += p;
        const int key = kq + 4 * it + kg; const float* vp = cv + base + (size_t)key * 512; const f32x4 v0 = *(const f32x4*)vp, v1 = *(const f32x4*)(vp + 4);
        oacc[0] += p * v0[0]; oacc[1] += p * v0[1]; oacc[2] += p * v0[2]; oacc[3] += p * v0[3]; oacc[4] += p * v1[0]; oacc[5] += p * v1[1]; oacc[6] += p * v1[2]; oacc[7] += p * v1[3]; }
    sum += __shfl_xor(sum, 16); sum += __shfl_xor(sum, 32);
#pragma unroll
    for (int i = 0; i < 8; ++i) { oacc[i] += __shfl_xor(oacc[i], 16); oacc[i] += __shfl_xor(oacc[i], 32); }
    if (lane == 0) red[8 + w] = sum;
    if (lane < 16) {
#pragma unroll
        for (int i = 0; i < 8; ++i) red[16 + w * 128 + dd * 8 + i] = oacc[i]; }
    __syncthreads();
    if ((w & 3) == 0 && lane < 16) {
        const float tot = (red[8 + w] + red[9 + w]) + (red[10 + w] + red[11 + w]), inv = 1.f / tot; float o[8];
#pragma unroll
        for (int i = 0; i < 8; ++i) o[i] = ((red[16 + w * 128 + dd * 8 + i] + red[16 + (w + 1) * 128 + dd * 8 + i]) + (red[16 + (w + 2) * 128 + dd * 8 + i] + red[16 + (w + 3) * 128 + dd * 8 + i])) * inv;
        v4u ow; ow.x = pk2(o[0], o[1]); ow.y = pk2(o[2], o[3]); ow.z = pk2(o[4], o[5]); ow.w = pk2(o[6], o[7]);
        *(v4u*)(mix + (size_t)(MP + b) * D + TOKW + hd * 128 + dd * 8) = ow;
    }
    __syncthreads();
}

constexpr int SG_LD = 136;
__device__ __forceinline__ void sg_unit(LAS unsigned char* lds, const bf16* zu, const bf16* zv, const ssq_t* ssv, const float* g_v, const bf16* wsb, const float* b_s, bf16* mix, int unit, int tid) {
    const int ch = unit / 12, g = unit % 12, row0 = ch * 128, lane = tid & 63, w = tid >> 6, fr = lane & 15, fq = lane >> 4;
    LAS bf16* Vt = (LAS bf16*)lds;
    { const int s = tid & 127, dq = tid >> 7; const float rsv = rstd_of(ssv[row0 + s], 1.f / 1536.f);
#pragma unroll
      for (int it = 0; it < 4; ++it) { const int d0 = (dq + 4 * it) * 8; const v4u vw = *(const v4u*)(zv + (size_t)(row0 + s) * TOKW + g * 128 + d0);
          const f32x4 g0 = *(const f32x4*)(g_v + g * 128 + d0), g1 = *(const f32x4*)(g_v + g * 128 + d0 + 4);
          const unsigned a = pk2(bflo(vw.x) * rsv * g0[0], bfhi(vw.x) * rsv * g0[1]), b2 = pk2(bflo(vw.y) * rsv * g0[2], bfhi(vw.y) * rsv * g0[3]),
                         c2 = pk2(bflo(vw.z) * rsv * g1[0], bfhi(vw.z) * rsv * g1[1]), e2 = pk2(bflo(vw.w) * rsv * g1[2], bfhi(vw.w) * rsv * g1[3]);
          LAS bf16* vp = Vt + d0 * SG_LD + s;
          vp[0] = (bf16)(a & 0xffff); vp[SG_LD] = (bf16)(a >> 16); vp[2 * SG_LD] = (bf16)(b2 & 0xffff); vp[3 * SG_LD] = (bf16)(b2 >> 16);
          vp[4 * SG_LD] = (bf16)(c2 & 0xffff); vp[5 * SG_LD] = (bf16)(c2 >> 16); vp[6 * SG_LD] = (bf16)(e2 & 0xffff); vp[7 * SG_LD] = (bf16)(e2 >> 16); } }
    const int nks = (w >> 1) + 1;
    bf16x8 wf[4];
#pragma unroll
    for (int ks = 0; ks < 4; ++ks) wf[ks] = *(const bf16x8*)(wsb + ((size_t)g * 128 + w * 16 + fr) * 128 + ks * 32 + fq * 8);
    __syncthreads();
    f32x4 acc[8];
#pragma unroll
    for (int dt = 0; dt < 8; ++dt) { acc[dt] = (f32x4){0.f, 0.f, 0.f, 0.f};
#pragma unroll
        for (int ks = 0; ks < 4; ++ks) if (ks < nks) { const bf16x8 vf = *(const LAS bf16x8*)(Vt + (dt * 16 + fr) * SG_LD + ks * 32 + fq * 8); acc[dt] = __builtin_amdgcn_mfma_f32_16x16x32_bf16(vf, wf[ks], acc[dt], 0, 0, 0); } }
    const int t = w * 16 + fr, r = row0 + t; const float bias = b_s[g * 128 + t];
#pragma unroll
    for (int dt = 0; dt < 8; ++dt) { const int c = g * 128 + dt * 16 + fq * 4; const v2u uw = *(const v2u*)(zu + (size_t)r * TOKW + c);
        v2u ow; ow.x = pk2(bflo(uw.x) * (acc[dt][0] + bias), bfhi(uw.x) * (acc[dt][1] + bias)); ow.y = pk2(bflo(uw.y) * (acc[dt][2] + bias), bfhi(uw.y) * (acc[dt][3] + bias));
        *(v2u*)(mix + (size_t)r * D + c) = ow; }
    __syncthreads();
}

__device__ __forceinline__ void s5_state_task(LAS unsigned char* lds, bf16* uh, const bf16* bt2_l, const float* lb16_l, float* out, int j, int task, int tid) {
    const int b = task / NGRP, h = task % NGRP, lane = tid & 63, w = tid >> 6, fr = lane & 15, fq = lane >> 4;
    LAS float* S = (LAS float*)lds;
    bf16x8 af[8];
    const bf16* ap = uh + ((size_t)(h * 512 + b * 128 + w * 16 + fr)) * KH + fq * 8;
#pragma unroll
    for (int ks = 0; ks < 8; ++ks) af[ks] = *(const bf16x8*)(ap + ks * 32);
#pragma unroll
    for (int nt = 0; nt < 8; ++nt) { f32x4 acc = (f32x4){0.f, 0.f, 0.f, 0.f}; const bf16* bp = bt2_l + ((size_t)(h * 128 + nt * 16 + fr)) * 256 + fq * 8;
#pragma unroll
        for (int ks = 0; ks < 8; ++ks) { const bf16x8 bf = *(const bf16x8*)(bp + ks * 32); acc = __builtin_amdgcn_mfma_f32_16x16x32_bf16(af[ks], bf, acc, 0, 0, 0); }
#pragma unroll
        for (int jj = 0; jj < 4; ++jj) S[(w * 16 + fq * 4 + jj) * 129 + nt * 16 + fr] = acc[jj]; }
    __syncthreads();
    if (w == 0) {
        const int p = lane; const float lr = lb16_l[(h * 64 + p) * 2], li = lb16_l[(h * 64 + p) * 2 + 1]; float hr = 0.f, hi = 0.f;
        bf16* up = uh + ((size_t)(h * 512 + b * 128)) * KH + 256 + p;
#pragma unroll 4
        for (int m = 0; m < 128; ++m) { up[(size_t)m * KH] = (bf16)(pk2(hr, 0.f) & 0xffff); up[(size_t)m * KH + 64] = (bf16)(pk2(hi, 0.f) & 0xffff);
            const float sr = S[m * 129 + p], si = S[m * 129 + 64 + p]; const float t = lr * hr - li * hi + sr; hi = lr * hi + li * hr + si; hr = t; }
        out[OFF_SRP + ((size_t)(j * 4 + b) * NGRP + h) * 64 + p] = hr; out[OFF_SIP + ((size_t)(j * 4 + b) * NGRP + h) * 64 + p] = hi;
    }
    __syncthreads();
}
__device__ __forceinline__ void s5_sample_task(const float* us, const float* st_re, const float* st_im, const float* lbt_l, const float* bbar_l, const float* c_re_l, const float* c_im_l, const float* d_l,
                                               float* out, bf16* yb, int j, int task, int lane) {
    const int b = task / NGRP, h = task % NGRP, p = lane;
    float u[16];
#pragma unroll
    for (int c4 = 0; c4 < 4; ++c4) { const f32x4 t = *(const f32x4*)(us + (size_t)b * TOKW + h * 16 + c4 * 4); u[c4 * 4] = t[0]; u[c4 * 4 + 1] = t[1]; u[c4 * 4 + 2] = t[2]; u[c4 * 4 + 3] = t[3]; }
    float xr = 0.f, xi = 0.f; const float* bb = bbar_l + ((size_t)(h * 64 + p)) * 32;
#pragma unroll
    for (int c2 = 0; c2 < 8; ++c2) { const f32x4 t = *(const f32x4*)(bb + c2 * 4); xr += t[0] * u[2 * c2] + t[2] * u[2 * c2 + 1]; xi += t[1] * u[2 * c2] + t[3] * u[2 * c2 + 1]; }
    const size_t si_ = ((size_t)(j * MS + b) * NGRP + h) * 64 + p; const float s0r = st_re[si_], s0i = st_im[si_], lr = lbt_l[(h * 64 + p) * 2], li = lbt_l[(h * 64 + p) * 2 + 1];
    const float hr = lr * s0r - li * s0i + xr, hi = lr * s0i + li * s0r + xi;
    out[OFF_SRS + si_] = hr; out[OFF_SIS + si_] = hi;
    float yv = 0.f;
#pragma unroll
    for (int c = 0; c < 16; ++c) { float t = c_re_l[((size_t)(h * 16 + c)) * 64 + p] * hr - c_im_l[((size_t)(h * 16 + c)) * 64 + p] * hi; t = wave_sum(t); t += d_l[h * 16 + c] * u[c]; yv = (lane == c) ? t : yv; }
    if (lane < 16) yb[(size_t)(MP + b) * TOKW + h * 16 + lane] = (bf16)(pk2(gelu_t(yv), 0.f) & 0xffff);
}

#define RLX_AGENT __ATOMIC_RELAXED, __HIP_MEMORY_SCOPE_AGENT
struct Args { const float* in[34]; float* out; unsigned char* ws; int lo, hi; };
__global__ void __launch_bounds__(NTHR, 2) trunk_fwd(Args args) {
    extern __shared__ __attribute__((aligned(16))) unsigned char lds_raw[];
    LAS unsigned char* lds = (LAS unsigned char*)lds_raw;
    volatile LAS unsigned* MISC = (volatile LAS unsigned*)(lds + MISC_OFF);
    const int G = gridDim.x, blk = blockIdx.x;
    const Args* ap = &args;
#define ws (ap->ws)
#define out (ap->out)
#define x_prompt (ap->in[0])
#define x_sample (ap->in[1])
#define mem_prompt (ap->in[2])
#define cache_k (ap->in[3])
#define cache_v (ap->in[4])
#define st_re (ap->in[5])
#define st_im (ap->in[6])
#define st_conv (ap->in[7])
#define g_mix (ap->in[8])
#define g_ffn (ap->in[9])
#define g_mem (ap->in[10])
#define g_final (ap->in[11])
#define w_mem_kv (ap->in[12])
#define sg_w_in (ap->in[13])
#define sg_w_out (ap->in[14])
#define sg_g_v (ap->in[15])
#define sg_w_s (ap->in[16])
#define sg_b_s (ap->in[17])
#define ssm_w_in (ap->in[18])
#define ssm_w_out (ap->in[19])
#define lam_re (ap->in[20])
#define lam_im (ap->in[21])
#define log_dt (ap->in[22])
#define b_re (ap->in[23])
#define b_im (ap->in[24])
#define c_re (ap->in[25])
#define c_im (ap->in[26])
#define ssm_d (ap->in[27])
#define w_glu (ap->in[28])
#define b_glu (ap->in[29])
#define w_up (ap->in[30])
#define conv_w (ap->in[31])
#define conv_b (ap->in[32])
#define w_down (ap->in[33])
#define ctl ((unsigned*)(ws + WS_CTL))
#define SSX ((ssq_t*)(ws + CTL_SSX))
#define SSV ((ssq_t*)(ws + CTL_SSV))
#define SSMEM ((ssq_t*)(ws + CTL_SSMEM))
#define W_SGIN ((bf16*)(ws + WS_WSGIN))
#define W_SSMIN ((bf16*)(ws + WS_WSSMIN))
#define W_SGOUT ((bf16*)(ws + WS_WSGOUT))
#define W_SSMOUT ((bf16*)(ws + WS_WSSMOUT))
#define W_GLU ((bf16*)(ws + WS_WGLU))
#define W_UP ((bf16*)(ws + WS_WUP))
#define W_DOWN ((bf16*)(ws + WS_WDOWN))
#define W_MEM ((bf16*)(ws + WS_WMEM))
#define WSB ((bf16*)(ws + WS_WSB))
#define TB ((bf16*)(ws + WS_TB))
#define BT2 ((bf16*)(ws + WS_BT2))
#define LBT ((float*)(ws + WS_LBT))
#define LB16 ((float*)(ws + WS_LB16))
#define BBART ((float*)(ws + WS_BBAR))
#define XRES ((float*)(ws + WS_XRES))
#define XB ((bf16*)(ws + WS_XB))
#define MEMB ((bf16*)(ws + WS_MEMB))
#define MKV ((bf16*)(ws + WS_MKV))
#define ZU ((bf16*)(ws + WS_ZU))
#define ZV ((bf16*)(ws + WS_ZV))
#define QB ((bf16*)(ws + WS_Q))
#define MIX ((bf16*)(ws + WS_MIX))
#define AG ((bf16*)(ws + WS_AG))
#define YF ((bf16*)(ws + WS_Y))
#define UH ((bf16*)(ws + WS_UH))
#define YB ((bf16*)(ws + WS_YB))
#define US ((float*)(ws + WS_US))
    for (int u = threadIdx.x; u < 128; u += NTHR) MISC[u] = 0u;
    __syncthreads();
    XcdBarrier bar = xcd_barrier_post(ctl + CW_BAR, MISC + 8);
    const int lo = args.lo, hi = args.hi; int ph = 0;
#ifndef PHM
#define PHM 0xFFFFFFFFu
#endif
#define PH_BEGIN(k) if (((PHM >> (k)) & 1u) && ph >= lo && ph < hi) { unsigned z_; asm volatile("s_mov_b32 %0, 0" : "=s"(z_)); const Args* ap = (const Args*)((const char*)&args + z_); int tid = threadIdx.x; asm volatile("" : "+v"(tid)); const int lane = tid & 63, wave = __builtin_amdgcn_readfirstlane(tid >> 6); const int gw = blk * NWAVES + wave, NGW = G * NWAVES, gtid = blk * NTHR + tid, NT = G * NTHR; (void)lane; (void)gw; (void)NGW; (void)gtid; (void)NT;
#define PH_END do { if (ph >= lo && ph + 1 < hi) xcd_barrier(bar); ++ph; } while (0)

    PH_BEGIN(0)
        LAS float* scr = (LAS float*)(lds + wave * 16384);
#pragma unroll 1
        for (int mat = 0; mat < 22; ++mat) {
            const float* W; const float* gn = nullptr; int K, N; bf16* WT; int roff = 0;
            if (mat < 2) { W = sg_w_in + (size_t)mat * D * SGN; gn = g_mix + (2 * mat) * D; K = D; N = SGN; WT = W_SGIN + (size_t)mat * SGN * D; }
            else if (mat < 4) { const int j = mat - 2; W = ssm_w_in + (size_t)j * D * D; gn = g_mix + (2 * j + 1) * D; K = D; N = D; WT = W_SSMIN + (size_t)j * D * D; }
            else if (mat < 6) { const int j = mat - 4; W = sg_w_out + (size_t)j * D * D; K = D; N = D; WT = W_SGOUT + (size_t)j * D * D; }
            else if (mat < 8) { const int j = mat - 6; W = ssm_w_out + (size_t)j * D * D; K = D; N = D; WT = W_SSMOUT + (size_t)j * D * D; }
            else if (mat < 10) { const int j = mat - 8; W = w_glu + (size_t)j * TOKW * TOKW; K = TOKW; N = TOKW; WT = W_GLU + (size_t)j * TOKW * TOKW; }
            else if (mat < 14) { const int i = mat - 10; W = w_up + (size_t)i * D * NUP; gn = g_ffn + i * D; K = D; N = NUP; WT = W_UP + (size_t)i * NUP * D; }
            else if (mat < 18) { const int i = mat - 14; W = w_down + (size_t)i * DFF * D; K = DFF; N = D; WT = W_DOWN + (size_t)i * D * DFF; }
            else { const int i = mat - 18; W = w_mem_kv + (size_t)i * D * 1024; gn = g_mem + i * D; K = D; N = 1024; WT = W_MEM; roff = i * 1024; }
            const int nitems = (K / 64) * (N / 32);
#pragma unroll 1
            for (int it = gw; it < nitems; it += NGW) p0_transpose_item(W, gn, K, N, WT, roff, scr, it, lane);
        }
        for (int e = gtid; e < 2 * 12 * 128 * 128 / 4; e += NT) { const int e4 = e * 4, s = e4 & 127, t = (e4 >> 7) & 127; const f32x4 wv = *(const f32x4*)(sg_w_s + e4);
            v2u o; o.x = pk2(s <= t ? wv[0] : 0.f, s + 1 <= t ? wv[1] : 0.f); o.y = pk2(s + 2 <= t ? wv[2] : 0.f, s + 3 <= t ? wv[3] : 0.f); *(v2u*)(WSB + e4) = o; }
        for (int r = gw; r < MT + MMEM; r += NGW) {
            if (r < MT) { const float* src = r < MP ? x_prompt + (size_t)r * D : (r < MREAL ? x_sample + (size_t)(r - MP) * D : nullptr); p0_row(src, XRES + (size_t)r * D, XB + (size_t)r * D, SSX + r, lane); }
            else { const int m = r - MT; p0_row(mem_prompt + (size_t)m * D, nullptr, MEMB + (size_t)m * D, SSMEM + m, lane); }
        }
        __syncthreads();
        for (int un = blk; un < 2 * NGRP; un += G) { const int j = un / NGRP, h = un % NGRP;
            s5_tables((LAS float*)lds, j, h, lam_re, lam_im, log_dt, b_re, b_im, c_re, c_im, ssm_d, TB, BT2, LBT, LB16, BBART, tid); }
    }
    PH_END;
    PH_BEGIN(1)
        pg8::Gemm g{MEMB, W_MEM, MMEM, 4096, D}; pg8::StaticOrder S; S.init(MMEM, 4096, G, blk);
        EpiMem E{SSMEM, out, MKV};
        pg8::gemm_phase<EpiMem, pg8::StaticOrder, true, true>(lds, g, S, E);
    }
    PH_END;
#pragma unroll 1
    for (int li = 0; li < 4; ++li) {
        const int j = li >> 1;
        const ssq_t* ss_mix = SSX + (size_t)(2 * li) * MT; ssq_t* ss_ffn = SSX + (size_t)(2 * li + 1) * MT; ssq_t* ss_next = SSX + (size_t)(2 * li + 2) * MT;
        const bf16* mkv_l = MKV + (size_t)li * 1024 * 1024;
        if ((li & 1) == 0) {
            PH_BEGIN(2)
                pg8::Gemm g{XB, W_SGIN + (size_t)j * SGN * D, MT, SGN, D}; pg8::StaticOrder S; S.init(MT, SGN, G, blk);
                EpiSgIn E{ss_mix, ZU, ZV, QB, SSV + (size_t)j * MT};
                pg8::gemm_phase<EpiSgIn, pg8::StaticOrder, true, true>(lds, g, S, E);
            }
            PH_END;
            PH_BEGIN(3)
                const ssq_t* ssv = SSV + (size_t)j * MT; const float* gv = sg_g_v + j * TOKW;
#pragma unroll 1
                for (int un = blk; un < 768; un += G) sg_unit(lds, ZU, ZV, ssv, gv, WSB + (size_t)j * 12 * 128 * 128, sg_b_s + j * 12 * 128, MIX, un, tid);
#pragma unroll 1
                for (int un = blk; un < 256; un += G) attn_prompt_unit(lds, QB, mkv_l, MIX, un, tid);
#pragma unroll 1
                for (int un = blk; un < 256; un += G) attn_sample_unit(lds, QB, cache_k, cache_v, MIX, li, un, tid);
                for (int e = gtid; e < MS * TOKW / 8; e += NT) { const int b = e / 192, c = (e % 192) * 8, g = c >> 7, r = MP + b;
                    const float rsv = rstd_of(ssv[r], 1.f / 1536.f); const v4u vw = *(const v4u*)(ZV + (size_t)r * TOKW + c), uw = *(const v4u*)(ZU + (size_t)r * TOKW + c);
                    const f32x4 g0 = *(const f32x4*)(gv + c), g1 = *(const f32x4*)(gv + c + 4);
                    const f32x4 n0 = (f32x4){bflo(vw.x) * rsv * g0[0], bfhi(vw.x) * rsv * g0[1], bflo(vw.y) * rsv * g0[2], bfhi(vw.y) * rsv * g0[3]};
                    const f32x4 n1 = (f32x4){bflo(vw.z) * rsv * g1[0], bfhi(vw.z) * rsv * g1[1], bflo(vw.w) * rsv * g1[2], bfhi(vw.w) * rsv * g1[3]};
                    float* so = out + OFF_SGV + (size_t)(j * MS + b) * TOKW + c; *(f32x4*)so = n0; *(f32x4*)(so + 4) = n1;
                    const float w00 = sg_w_s[((size_t)(j * 12 + g) * 128) * 128], bs = sg_b_s[(j * 12 + g) * 128];
                    const f32x4 t0 = (f32x4){bflo(uw.x), bfhi(uw.x), bflo(uw.y), bfhi(uw.y)} * (n0 * w00 + bs), t1 = (f32x4){bflo(uw.z), bfhi(uw.z), bflo(uw.w), bfhi(uw.w)} * (n1 * w00 + bs);
                    *(v4u*)(MIX + (size_t)r * D + c) = pack8(t0, t1); }
            }
            PH_END;
        } else {
            PH_BEGIN(4)
                pg8::Gemm g{XB, W_SSMIN + (size_t)j * D * D, MT, D, D}; pg8::StaticOrder S; S.init(MT, D, G, blk);
                EpiSsmIn E{ss_mix, UH, US, QB};
                pg8::gemm_phase<EpiSsmIn, pg8::StaticOrder, true, true>(lds, g, S, E);
            }
            PH_END;
            PH_BEGIN(5)
#pragma unroll 1
                for (int tk = blk; tk < 4 * NGRP; tk += G) s5_state_task(lds, UH, BT2 + (size_t)j * NGRP * 128 * 256, LB16 + (size_t)j * NGRP * 64 * 2, out, j, tk, tid);
#pragma unroll 1
                for (int tk = gw; tk < MS * NGRP; tk += NGW)
                    s5_sample_task(US, st_re, st_im, LBT + (size_t)j * NGRP * 64 * 2, BBART + (size_t)j * NGRP * 64 * 32, c_re + (size_t)j * NGRP * 1024, c_im + (size_t)j * NGRP * 1024, ssm_d + j * TOKW, out, YB, j, tk, lane);
#pragma unroll 1
                for (int un = blk; un < 256; un += G) attn_prompt_unit(lds, QB, mkv_l, MIX, un, tid);
#pragma unroll 1
                for (int un = blk; un < 256; un += G) attn_sample_unit(lds, QB, cache_k, cache_v, MIX, li, un, tid);
            }
            PH_END;
            PH_BEGIN(6)
                int kh = KH; asm volatile("" : "+s"(kh)); pg8::Gemm g{UH, TB + (size_t)j * NGRP * 256 * KH, NGRP * 512, NGRP * 256, kh}; ToepOrder S{G, blk};
                EpiToep E{YB};
                pg8::gemm_phase<EpiToep, ToepOrder, true, true>(lds, g, S, E);
            }
            PH_END;
            PH_BEGIN(7)
                pg8::Gemm g{YB, W_GLU + (size_t)j * TOKW * TOKW, MT, TOKW, TOKW}; pg8::StaticOrder S; S.init(MT, TOKW, G, blk);
                EpiGlu E{YB, b_glu + j * TOKW, MIX};
                pg8::gemm_phase<EpiGlu, pg8::StaticOrder, true, true>(lds, g, S, E);
            }
            PH_END;
        }
        PH_BEGIN(8)
            const bf16* wo = (li & 1) ? W_SSMOUT + (size_t)j * D * D : W_SGOUT + (size_t)j * D * D;
            pg8::Gemm g{MIX, wo, MT, D, D}; pg8::StaticOrder S; S.init(MT, D, G, blk);
            EpiRes E{XRES, XB, ss_ffn};
            pg8::gemm_phase<EpiRes, pg8::StaticOrder, true, true>(lds, g, S, E);
        }
        PH_END;
        PH_BEGIN(9)
            pg8::Gemm g{XB, W_UP + (size_t)li * NUP * D, MT, NUP, D}; pg8::StaticOrder S; S.init(MT, NUP, G, blk);
            EpiUp E{ss_ffn, AG, out, li};
            pg8::gemm_phase<EpiUp, pg8::StaticOrder, true, true>(lds, g, S, E);
        }
        PH_END;
        PH_BEGIN(10)
            const float* cw = conv_w + (size_t)li * 3 * DFF; const float* cb = conv_b + (size_t)li * DFF;
#pragma unroll 1
            for (int e = gtid; e < MT * (DFF / 8); e += NT) {
                const int r = e / (DFF / 8), c = (e % (DFF / 8)) * 8;
                const v4u a0w = *(const v4u*)(AG + (size_t)r * NUP + c), gw_ = *(const v4u*)(AG + (size_t)r * NUP + DFF + c);
                float a1[8], a2[8];
                if (r < MP) { const int t = r & (SEQ - 1); v4u w1 = (v4u){0u, 0u, 0u, 0u}, w2 = (v4u){0u, 0u, 0u, 0u};
                    if (t >= 1) w1 = *(const v4u*)(AG + (size_t)(r - 1) * NUP + c); if (t >= 2) w2 = *(const v4u*)(AG + (size_t)(r - 2) * NUP + c);
                    a1[0] = bflo(w1.x); a1[1] = bfhi(w1.x); a1[2] = bflo(w1.y); a1[3] = bfhi(w1.y); a1[4] = bflo(w1.z); a1[5] = bfhi(w1.z); a1[6] = bflo(w1.w); a1[7] = bfhi(w1.w);
                    a2[0] = bflo(w2.x); a2[1] = bfhi(w2.x); a2[2] = bflo(w2.y); a2[3] = bfhi(w2.y); a2[4] = bflo(w2.z); a2[5] = bfhi(w2.z); a2[6] = bflo(w2.w); a2[7] = bfhi(w2.w); }
                else if (r < MREAL) { const int b = r - MP; const float* p2 = st_conv + ((size_t)(li * MS + b) * 2) * DFF + c; const float* p1 = p2 + DFF;
                    const f32x4 x0 = *(const f32x4*)p2, x1 = *(const f32x4*)(p2 + 4), y0 = *(const f32x4*)p1, y1 = *(const f32x4*)(p1 + 4);
                    a2[0] = x0[0]; a2[1] = x0[1]; a2[2] = x0[2]; a2[3] = x0[3]; a2[4] = x1[0]; a2[5] = x1[1]; a2[6] = x1[2]; a2[7] = x1[3];
                    a1[0] = y0[0]; a1[1] = y0[1]; a1[2] = y0[2]; a1[3] = y0[3]; a1[4] = y1[0]; a1[5] = y1[1]; a1[6] = y1[2]; a1[7] = y1[3];
                    float* co = out + OFF_CONVS + ((size_t)(li * MS + b) * 2) * DFF + c; *(f32x4*)co = y0; *(f32x4*)(co + 4) = y1; }
                else {
#pragma unroll
                    for (int i = 0; i < 8; ++i) { a1[i] = 0.f; a2[i] = 0.f; } }
                const float a0[8] = {bflo(a0w.x), bfhi(a0w.x), bflo(a0w.y), bfhi(a0w.y), bflo(a0w.z), bfhi(a0w.z), bflo(a0w.w), bfhi(a0w.w)};
                const float gg[8] = {bflo(gw_.x), bfhi(gw_.x), bflo(gw_.y), bfhi(gw_.y), bflo(gw_.z), bfhi(gw_.z), bflo(gw_.w), bfhi(gw_.w)};
                float yv[8];
#pragma unroll
                for (int h2 = 0; h2 < 2; ++h2) { const f32x4 k0 = *(const f32x4*)(cw + c + 4 * h2), k1 = *(const f32x4*)(cw + DFF + c + 4 * h2), k2 = *(const f32x4*)(cw + 2 * DFF + c + 4 * h2), kb = *(const f32x4*)(cb + c + 4 * h2);
#pragma unroll
                    for (int i = 0; i < 4; ++i) { const int q = 4 * h2 + i; const float cc = kb[i] + k0[i] * a2[q] + k1[i] * a1[q] + k2[i] * a0[q]; yv[q] = cc * sigmoid_f(cc) * gg[q]; } }
                v4u ow; ow.x = pk2(yv[0], yv[1]); ow.y = pk2(yv[2], yv[3]); ow.z = pk2(yv[4], yv[5]); ow.w = pk2(yv[6], yv[7]);
                *(v4u*)(YF + (size_t)r * DFF + c) = ow;
            }
        }
        PH_END;
        PH_BEGIN(11)
            pg8::Gemm g{YF, W_DOWN + (size_t)li * D * DFF, MT, D, DFF}; pg8::StaticOrder S; S.init(MT, D, G, blk);
            EpiRes E{XRES, XB, ss_next};
            pg8::gemm_phase<EpiRes, pg8::StaticOrder, true, true>(lds, g, S, E);
        }
        PH_END;
    }
    PH_BEGIN(12)
#pragma unroll 1
        for (int r = gw; r < MREAL; r += NGW) {
            const f32x4* xr = (const f32x4*)(XRES + (size_t)r * D); f32x4 v[8]; float s = 0.f;
#pragma unroll
            for (int jj = 0; jj < 8; ++jj) { v[jj] = xr[lane + 64 * jj]; s += dot4(v[jj]); }
            const float rs = rsqrtf(wave_sum(s) * (1.f / 2048.f) + EPS);
            f32x4* o = (f32x4*)(out + (r < MP ? OFF_YP + (size_t)r * D : OFF_YS + (size_t)(r - MP) * D));
#pragma unroll
            for (int jj = 0; jj < 8; ++jj) o[lane + 64 * jj] = v[jj] * rs * ((const f32x4*)g_final)[lane + 64 * jj];
        }
    }
    PH_END;
#undef PH_BEGIN
#undef PH_END
}
#undef x_prompt
#undef x_sample
#undef mem_prompt
#undef cache_k
#undef cache_v
#undef st_re
#undef st_im
#undef st_conv
#undef g_mix
#undef g_ffn
#undef g_mem
#undef g_final
#undef w_mem_kv
#undef sg_w_in
#undef sg_w_out
#undef sg_g_v
#undef sg_w_s
#undef sg_b_s
#undef ssm_w_in
#undef ssm_w_out
#undef lam_re
#undef lam_im
#undef log_dt
#undef b_re
#undef b_im
#undef c_re
#undef c_im
#undef ssm_d
#undef w_glu
#undef b_glu
#undef w_up
#undef conv_w
#undef conv_b
#undef w_down
#undef ctl
#undef SSX
#undef SSV
#undef SSMEM
#undef W_SGIN
#undef W_SSMIN
#undef W_SGOUT
#undef W_SSMOUT
#undef W_GLU
#undef W_UP
#undef W_DOWN
#undef W_MEM
#undef WSB
#undef TB
#undef BT2
#undef LBT
#undef LB16
#undef BBART
#undef XRES
#undef XB
#undef MEMB
#undef MKV
#undef ZU
#undef ZV
#undef QB
#undef MIX
#undef AG
#undef YF
#undef UH
#undef YB
#undef US
#undef ws
#undef out

#ifndef MK_ONE_LAUNCH
#define MK_ONE_LAUNCH 0
#endif
extern "C" void kernel_launch(void* const* d_in, const int* in_sizes, int n_in, void* d_out, int out_size, void* d_ws, size_t ws_size, hipStream_t stream) {
    static int grid = 0;
    if (grid == 0) {
        if (n_in != 34 || (size_t)out_size != OUT_TOTAL || ws_size < WS_END) { fprintf(stderr, "kernel_launch: unexpected shapes (n_in %d, out %d, ws %zu)\n", n_in, out_size, ws_size); grid = -1; return; }
        int dev = 0, cus = 0;
        if (hipGetDevice(&dev) != hipSuccess || hipDeviceGetAttribute(&cus, hipDeviceAttributeMultiprocessorCount, dev) != hipSuccess) { grid = -1; return; }
        if (hipFuncSetAttribute((const void*)trunk_fwd, hipFuncAttributeMaxDynamicSharedMemorySize, LDS_BYTES) != hipSuccess) { fprintf(stderr, "kernel_launch: hipFuncSetAttribute failed\n"); grid = -1; return; }
        int per_cu = 0;
        if (hipOccupancyMaxActiveBlocksPerMultiprocessor(&per_cu, (const void*)trunk_fwd, NTHR, LDS_BYTES) != hipSuccess || per_cu < 1) fprintf(stderr, "kernel_launch: occupancy query says %d\n", per_cu);
        (void)hipGetLastError();
        grid = cus;
    }
    if (grid < 0) return;
    if (hipMemsetAsync((char*)d_ws + WS_CTL, 0, CTL_ZERO_BYTES, stream) != hipSuccess) return;
    Args a{};
    for (int i = 0; i < 34; ++i) a.in[i] = (const float*)d_in[i];
    a.out = (float*)d_out; a.ws = (unsigned char*)d_ws;
#if MK_ONE_LAUNCH
    a.lo = 0; a.hi = NPHASE;
    hipLaunchKernelGGL(trunk_fwd, dim3(grid), dim3(NTHR), LDS_BYTES, stream, a);
#else
    for (int p = 0; p < NPHASE; ++p) { a.lo = p; a.hi = p + 1; hipLaunchKernelGGL(trunk_fwd, dim3(grid), dim3(NTHR), LDS_BYTES, stream, a); }
#endif
#ifdef OUTMASK
    {
        const size_t offs[12] = {OFF_YP, OFF_YS, OFF_MK, OFF_MV, OFF_SRP, OFF_SIP, OFF_CONVP, OFF_SRS, OFF_SIS, OFF_CONVS, OFF_SGV, OUT_TOTAL};
        for (int i = 0; i < 11; ++i) if (!((OUTMASK >> i) & 1)) (void)hipMemsetAsync((float*)d_out + offs[i], 0, (offs[i + 1] - offs[i]) * 4, stream);
    }
#endif
}
```

```cpp
#include <hip/hip_runtime.h>
#include <cstdio>
#include <cstdint>
namespace pg8 {
#define PG8_LAS __attribute__((address_space(3)))
typedef unsigned short bf16_t;
typedef short bf16x8 __attribute__((ext_vector_type(8)));
typedef float f32x4 __attribute__((ext_vector_type(4)));
typedef unsigned u32x4 __attribute__((ext_vector_type(4)));
constexpr int BM = 256, BK = 64, HALF = 128, HTB = HALF * BK * 2  , STAGE_BYTES = 8 * HTB, NXCD = 8, WGM = 8;

__host__ __device__ __forceinline__ int lds_byte(int r, int c) { const int st = (r >> 4) * 2 + (c >> 5), rr = r & 15, cc = c & 31, ob = rr * 64 + cc * 2; return st * 1024 + (ob ^ (((ob >> 9) & 1) << 5)); }
__host__ __device__ __forceinline__ void stage_rc(int b, int& R, int& C) { const int st = b / 1024, sb = b % 1024, swz = sb ^ (((sb >> 9) & 1) << 5); R = (st >> 1) * 16 + swz / 64; C = (st & 1) * 32 + (swz % 64) / 2; }
__host__ __device__ __forceinline__ int perm32(int rho) { const int n = rho >> 4, i = rho & 15; return 8 * (i >> 2) + 4 * n + (i & 3); }

struct Unit { int pm, pn; };
struct Gemm { const bf16_t* A; const bf16_t* Bt; int M, N, K; };

struct StaticOrder {
    int nM, nN, nwg, G, c;
    __host__ __device__ void init(int M, int N, int G_, int c_) { nM = M / BM; nN = N / BM; nwg = nM * nN; G = G_; c = c_; }
    __host__ __device__ bool next(int i, Unit& u) const {
        const long L = (long)i * G + c; if (L >= nwg) return false;
        int wgid = (int)L; { const int q = nwg / NXCD, r = nwg % NXCD, xcd = wgid % NXCD, off = wgid / NXCD; wgid = (xcd < r ? xcd * (q + 1) : r * (q + 1) + (xcd - r) * q) + off; }
        const int nig = WGM * nN, gid = wgid / nig, fm = gid * WGM, gsz = (nM - fm) < WGM ? (nM - fm) : WGM;
        u.pm = fm + ((wgid % nig) % gsz); u.pn = (wgid % nig) / gsz; return true;
    }
    __device__ __forceinline__ void a_ready(const Unit&) const {}
    __device__ __forceinline__ void done(const Unit&) const {}
};
__device__ __forceinline__ unsigned cvt_pk_bf16(float lo, float hi) { unsigned r; asm volatile("v_cvt_pk_bf16_f32 %0, %1, %2" : "=v"(r) : "v"(lo), "v"(hi)); return r; }
typedef float f32x2 __attribute__((ext_vector_type(2)));
template <class Epi, class Sched, bool ALIGN_EPI = false, bool SP2 = false>
__device__ __forceinline__ void gemm_phase(PG8_LAS unsigned char* lds, const Gemm g, const Sched& S, const Epi& E) {
    int tid = threadIdx.x; asm volatile("" : "+v"(tid)); const int wid = __builtin_amdgcn_readfirstlane(tid >> 6), lane = tid & 63, wr = wid >> 2, wc = wid & 3, fr = lane & 15, fq = lane >> 4;
    const int K = g.K, nt = K / BK;
    unsigned voffA[2], voffB[2];
#pragma unroll
    for (int i = 0; i < 2; ++i) { int R, C; stage_rc(tid * 16 + i * 8192, R, C); const int Rb = Epi::PERM ? ((R & ~31) + perm32(R & 31)) : R;
        voffA[i] = (unsigned)(R * K + C) * 2u; voffB[i] = (unsigned)(Rb * K + C) * 2u; }
    const size_t kstep = (size_t)(BK * 2);
    const size_t hstep = (size_t)HALF * K * 2;
    const size_t tstep = 2 * hstep;
    const unsigned ldsw = (unsigned)wid * 1024u;
    const int aoff = lds_byte(wr * 64 + fr, fq * 8), boff = lds_byte(wc * 32 + fr, fq * 8);
#define PG8_SA(b, h) (((b) * 2 + (h)) * HTB)
#define PG8_SB(b, h) ((4 + (b) * 2 + (h)) * HTB)
#define PG8_STAGE(bufoff, gbase, voff) do { _Pragma("unroll") for (int _i = 0; _i < 2; ++_i) \
        __builtin_amdgcn_global_load_lds((const unsigned*)((const char*)(gbase) + (voff)[_i]), (PG8_LAS unsigned*)(lds + (bufoff) + ldsw + _i * 8192), 16, 0, 0); } while (0)
#define PG8_LDA(dst, b, h) do { _Pragma("unroll") for (int m = 0; m < 4; ++m) _Pragma("unroll") for (int k = 0; k < 2; ++k) dst[m][k] = *(const PG8_LAS bf16x8*)(lds + PG8_SA(b, h) + aoff + m * 2048 + k * 1024); } while (0)
#define PG8_LDB(dst, b, h) do { _Pragma("unroll") for (int n = 0; n < 2; ++n) _Pragma("unroll") for (int k = 0; k < 2; ++k) dst[n][k] = *(const PG8_LAS bf16x8*)(lds + PG8_SB(b, h) + boff + n * 2048 + k * 1024); } while (0)
#define PG8_MMA(ai, bj, At, Bt) do { __builtin_amdgcn_s_setprio(1); _Pragma("unroll") for (int m = 0; m < 4; ++m) _Pragma("unroll") for (int n = 0; n < 2; ++n) _Pragma("unroll") for (int k = 0; k < 2; ++k) \
        acc[ai][bj][m][n] = __builtin_amdgcn_mfma_f32_16x16x32_bf16(Bt[n][k], At[m][k], acc[ai][bj][m][n], 0, 0, 0); __builtin_amdgcn_s_setprio(0); } while (0)
#define PG8_WAIT_V(n) asm volatile("s_waitcnt vmcnt(" #n ")" ::: "memory")
#define PG8_WAIT_L(n) asm volatile("s_waitcnt lgkmcnt(" #n ")" ::: "memory")
#define PG8_BAR __builtin_amdgcn_s_barrier()
#define PG8_SCHED __builtin_amdgcn_sched_barrier(0)
    Unit cur, nxt; int ui = 0;
    if (!S.next(0, cur)) return;
    f32x4 acc[2][2][4][2];
#pragma unroll
    for (int a = 0; a < 2; ++a)
#pragma unroll
        for (int b = 0; b < 2; ++b)
#pragma unroll
            for (int m = 0; m < 4; ++m)
#pragma unroll
                for (int n = 0; n < 2; ++n) acc[a][b][m][n] = (f32x4){0.f, 0.f, 0.f, 0.f};
    bf16x8 At[4][2], B0[2][2], B1[2][2];
    const char* cA = (const char*)g.A + (size_t)cur.pm * tstep; const char* cB = (const char*)g.Bt + (size_t)cur.pn * tstep;
    S.a_ready(cur);
    if constexpr (SP2) {
        PG8_STAGE(PG8_SB(0, 0), cB, voffB); PG8_STAGE(PG8_SB(0, 1), cB + hstep, voffB); PG8_STAGE(PG8_SA(0, 0), cA, voffA); PG8_STAGE(PG8_SA(0, 1), cA + hstep, voffA);
        if (wr == 1) PG8_BAR;
        PG8_WAIT_V(2); PG8_BAR;
        PG8_STAGE(PG8_SB(1, 0), cB + kstep, voffB); PG8_STAGE(PG8_SA(1, 0), cA + kstep, voffA); PG8_STAGE(PG8_SB(1, 1), cB + hstep + kstep, voffB);
        PG8_WAIT_V(6); PG8_BAR;
    } else {
        PG8_STAGE(PG8_SB(0, 0), cB, voffB); PG8_STAGE(PG8_SA(0, 0), cA, voffA); PG8_STAGE(PG8_SB(0, 1), cB + hstep, voffB); PG8_STAGE(PG8_SA(0, 1), cA + hstep, voffA);
        if (wr == 1) PG8_BAR;
        PG8_WAIT_V(4); PG8_BAR;
        PG8_STAGE(PG8_SB(1, 0), cB + kstep, voffB); PG8_STAGE(PG8_SA(1, 0), cA + kstep, voffA); PG8_STAGE(PG8_SB(1, 1), cB + hstep + kstep, voffB);
        PG8_WAIT_V(6); PG8_BAR;
    }
    for (;;) {
        const bool has_next = S.next(ui + 1, nxt);
        const char* nA = has_next ? (const char*)g.A + (size_t)nxt.pm * tstep : cA; const char* nB = has_next ? (const char*)g.Bt + (size_t)nxt.pn * tstep : cB;
        for (int t = 0; t < nt; t += 2) {
            const bool last = (t == nt - 2);
            const char* a1 = cA + (size_t)(t + 1) * kstep;
            const char* a2 = last ? nA : cA + (size_t)(t + 2) * kstep; const char* b2 = last ? nB : cB + (size_t)(t + 2) * kstep;
            const char* a3 = a2 + kstep; const char* b3 = b2 + kstep;
            if (last && has_next) S.a_ready(nxt);
            if constexpr (SP2) {
            PG8_LDB(B0, 0, 0); PG8_LDB(B1, 0, 1); PG8_SCHED; PG8_LDA(At, 0, 0); PG8_STAGE(PG8_SA(1, 1), a1 + hstep, voffA);
            PG8_WAIT_V(8); PG8_WAIT_L(0); PG8_BAR; PG8_MMA(0, 0, At, B0); PG8_MMA(0, 1, At, B1); PG8_BAR; PG8_SCHED;
            PG8_LDA(At, 0, 1); PG8_STAGE(PG8_SB(0, 0), b2, voffB); PG8_STAGE(PG8_SB(0, 1), b2 + hstep, voffB); PG8_STAGE(PG8_SA(0, 0), a2, voffA);
            PG8_WAIT_V(8); PG8_WAIT_L(0); PG8_BAR; PG8_MMA(1, 0, At, B0); PG8_MMA(1, 1, At, B1); PG8_BAR; PG8_SCHED;
            PG8_LDB(B0, 1, 0); PG8_LDB(B1, 1, 1); PG8_SCHED; PG8_LDA(At, 1, 0); PG8_STAGE(PG8_SA(0, 1), a2 + hstep, voffA);
            PG8_WAIT_V(8); PG8_WAIT_L(0); PG8_BAR; PG8_MMA(0, 0, At, B0); PG8_MMA(0, 1, At, B1); PG8_BAR; PG8_SCHED;
            PG8_LDA(At, 1, 1); PG8_STAGE(PG8_SB(1, 0), b3, voffB); PG8_STAGE(PG8_SB(1, 1), b3 + hstep, voffB); PG8_STAGE(PG8_SA(1, 0), a3, voffA);
            PG8_WAIT_V(8); PG8_WAIT_L(0); PG8_BAR; PG8_MMA(1, 0, At, B0); PG8_MMA(1, 1, At, B1); PG8_BAR; PG8_SCHED;
            } else {
            PG8_LDB(B0, 0, 0); PG8_SCHED; PG8_LDA(At, 0, 0); PG8_STAGE(PG8_SA(1, 1), a1 + hstep, voffA);
            PG8_WAIT_L(8); PG8_BAR; PG8_WAIT_L(0); PG8_MMA(0, 0, At, B0); PG8_BAR; PG8_SCHED;
            PG8_LDB(B1, 0, 1); PG8_STAGE(PG8_SB(0, 0), b2, voffB);
            PG8_BAR; PG8_WAIT_L(0); PG8_MMA(0, 1, At, B1); PG8_BAR;
            PG8_LDA(At, 0, 1); PG8_STAGE(PG8_SA(0, 0), a2, voffA);
            PG8_BAR; PG8_WAIT_L(0); PG8_MMA(1, 0, At, B0); PG8_BAR; PG8_SCHED;
            PG8_STAGE(PG8_SB(0, 1), b2 + hstep, voffB);
            PG8_WAIT_V(6); PG8_BAR; PG8_MMA(1, 1, At, B1); PG8_BAR;
            PG8_LDB(B0, 1, 0); PG8_SCHED; PG8_LDA(At, 1, 0); PG8_STAGE(PG8_SA(0, 1), a2 + hstep, voffA);
            PG8_WAIT_L(8); PG8_BAR; PG8_WAIT_L(0); PG8_MMA(0, 0, At, B0); PG8_BAR; PG8_SCHED;
            PG8_LDB(B1, 1, 1); PG8_STAGE(PG8_SB(1, 0), b3, voffB);
            PG8_BAR; PG8_WAIT_L(0); PG8_MMA(0, 1, At, B1); PG8_BAR;
            PG8_LDA(At, 1, 1); PG8_STAGE(PG8_SA(1, 0), a3, voffA);
            PG8_BAR; PG8_WAIT_L(0); PG8_MMA(1, 0, At, B0); PG8_BAR; PG8_SCHED;
            PG8_STAGE(PG8_SB(1, 1), b3 + hstep, voffB);
            PG8_WAIT_V(6); PG8_BAR; PG8_MMA(1, 1, At, B1); PG8_BAR;
            }
        }
        if constexpr (ALIGN_EPI) { if (wr == 0) PG8_BAR; }
        if constexpr (!Epi::AFTER_DRAIN) { E(acc, cur, wr, wc, fr, fq); S.done(cur); }
        if (!has_next) break;
#pragma unroll
        for (int a = 0; a < 2; ++a)
#pragma unroll
            for (int b = 0; b < 2; ++b)
#pragma unroll
                for (int m = 0; m < 4; ++m)
#pragma unroll
                    for (int n = 0; n < 2; ++n) acc[a][b][m][n] = (f32x4){0.f, 0.f, 0.f, 0.f};
        cur = nxt; cA = nA; cB = nB; ++ui;
        if constexpr (ALIGN_EPI) { if (wr == 1) PG8_BAR; }
    }
    PG8_WAIT_V(0);
    if constexpr (!ALIGN_EPI) { if (wr == 0) PG8_BAR; }
    PG8_BAR;
    if constexpr (Epi::AFTER_DRAIN) { E.fused(acc, cur, wr, wc, fr, fq, lds, wid, lane); S.done(cur); }
#undef PG8_SA
#undef PG8_SB
#undef PG8_STAGE
#undef PG8_LDA
#undef PG8_LDB
#undef PG8_MMA
#undef PG8_WAIT_V
#undef PG8_WAIT_L
#undef PG8_BAR
#undef PG8_SCHED
}
}
#define LAS_BAR __attribute__((address_space(3)))
#define XB_TMO      128
#define XB_XCNT(j)  (256  + 64 * (j))
#define XB_XSUB(j)  (1280 + 64 * (j))
#define XB_XGEN(j)  (2304 + 64 * (j))
#define XB_TOP      3328
#define XB_TOPGEN   3392
#define XCD_BAR_WORDS 3456
#define XB_SPIN_CAP (1u << 18)

__device__ __forceinline__ unsigned xb_ld(unsigned* p)              { return __hip_atomic_load(p, __ATOMIC_RELAXED, __HIP_MEMORY_SCOPE_AGENT); }
__device__ __forceinline__ unsigned xb_add(unsigned* p, unsigned v) { return __hip_atomic_fetch_add(p, v, __ATOMIC_RELAXED, __HIP_MEMORY_SCOPE_AGENT); }
__device__ __forceinline__ unsigned xb_xcc_id() { return (unsigned)__builtin_amdgcn_s_getreg((3 << 11) | 20) & 0xFu; }
#define XB_SPIN(cond, bar) do { unsigned _sp = 0; while (cond) { __builtin_amdgcn_s_sleep(1); \
    if ((++_sp & 255u) == 0u) { if (xb_ld(&(bar)[XB_TMO])) break; if (_sp > XB_SPIN_CAP) { atomicAdd(&(bar)[XB_TMO], 1u); break; } } } } while (0)

struct XcdBarrier {
    unsigned* bar; unsigned x;
    volatile LAS_BAR unsigned* st;
};

__device__ __forceinline__ XcdBarrier xcd_barrier_post(unsigned* bar, volatile LAS_BAR unsigned* st) {
    XcdBarrier b; b.bar = bar; b.x = xb_xcc_id(); b.st = st;
    if (threadIdx.x == 0) (void)xb_add(&bar[XB_XCNT(b.x)], 1u);
    return b;
}
__device__ __forceinline__ void xcd_barrier_complete(unsigned* bar, unsigned x, unsigned& nloc, unsigned& nx) {
    const unsigned G = gridDim.x * gridDim.y * gridDim.z;
    unsigned sum, cnt, mine, sp = 0u;
    for (;;) {
        sum = 0u; cnt = 0u; mine = 0u;
#pragma unroll
        for (unsigned j = 0; j < 16; ++j) { const unsigned c = xb_ld(&bar[XB_XCNT(j)]); sum += c; cnt += (c > 0u) ? 1u : 0u; mine = (j == x) ? c : mine; }
        if (sum == G) break;
        __builtin_amdgcn_s_sleep(1);
        if ((++sp & 255u) == 0u) { if (xb_ld(&bar[XB_TMO])) break; if (sp > XB_SPIN_CAP) { atomicAdd(&bar[XB_TMO], 1u); break; } }
    }
    nloc = mine > 0u ? mine : 1u; nx = cnt > 0u ? cnt : 1u;
}

__device__ __forceinline__ void xcd_barrier(const XcdBarrier& b) {
    asm volatile("s_waitcnt vmcnt(0)" ::: "memory");
    __syncthreads();
    if (threadIdx.x == 0) {
        unsigned* bar = b.bar;
        __builtin_amdgcn_s_waitcnt(0);
        unsigned nloc = b.st[0], nx = b.st[1];
        if (nloc == 0u) { xcd_barrier_complete(bar, b.x, nloc, nx); b.st[0] = nloc; b.st[1] = nx; }
        const unsigned old = xb_add(&bar[XB_XSUB(b.x)], 1u);
        const unsigned gen = old / nloc;
        if (old + 1u == (gen + 1u) * nloc) {
            __builtin_amdgcn_fence(__ATOMIC_RELEASE, "agent");
            asm volatile("s_waitcnt vmcnt(0)" ::: "memory");
            const unsigned og = xb_add(&bar[XB_TOP], 1u);
            const unsigned tg = og / nx;
            if (og + 1u == (tg + 1u) * nx) xb_add(&bar[XB_TOPGEN], 1u);
            else XB_SPIN(xb_ld(&bar[XB_TOPGEN]) == tg, bar);
            __builtin_amdgcn_fence(__ATOMIC_ACQUIRE, "agent");
            xb_add(&bar[XB_XGEN(b.x)], 1u);
            asm volatile("s_waitcnt vmcnt(0)" ::: "memory");
        } else {
            XB_SPIN(xb_ld(&bar[XB_XGEN(b.x)]) == gen, bar);
            __builtin_amdgcn_fence(__ATOMIC_ACQUIRE, "agent");
            asm volatile("s_waitcnt vmcnt(0)" ::: "memory");
        }
    }
    __syncthreads();
}
#define GAS __attribute__((address_space(1)))
#define LAS __attribute__((address_space(3)))
typedef unsigned short bf16;
typedef unsigned v4u __attribute__((ext_vector_type(4)));
typedef unsigned v2u __attribute__((ext_vector_type(2)));
typedef float f32x4 __attribute__((ext_vector_type(4)));
typedef short bf16x8 __attribute__((ext_vector_type(8)));
typedef short bf16x4 __attribute__((ext_vector_type(4)));

constexpr int NWAVES = 8, NTHR = 512;
constexpr int D = 2048, SEQ = 2048, MP = 8192, MS = 128, MREAL = 8320, MT = 8448;
constexpr int MMEM = 1024, XAW = 512, TOKW = 1536, SGN = 3584, DFF = 5504, NUP = 11008;
constexpr int NGRP = 96, KH = 384;
constexpr float EPS = 1e-6f;
constexpr int NPHASE = 31;

constexpr size_t OFF_YP = 0, OFF_YS = 16777216, OFF_MK = 17039360, OFF_MV = 19136512, OFF_SRP = 21233664, OFF_SIP = 21282816,
                 OFF_CONVP = 21331968, OFF_SRS = 21508096, OFF_SIS = 23080960, OFF_CONVS = 24653824, OFF_SGV = 30289920, OUT_TOTAL = 30683136;

constexpr size_t MiB = 1u << 20;
constexpr size_t WS_CTL = 0, CTL_ZERO_BYTES = 1 * MiB;
constexpr size_t WS_WSGIN = 1 * MiB;
constexpr size_t WS_WSSMIN = WS_WSGIN + 28 * MiB;
constexpr size_t WS_WSGOUT = WS_WSSMIN + 16 * MiB;
constexpr size_t WS_WSSMOUT = WS_WSGOUT + 16 * MiB;
constexpr size_t WS_WGLU = WS_WSSMOUT + 16 * MiB;
constexpr size_t WS_WUP = WS_WGLU + 9 * MiB;
constexpr size_t WS_WDOWN = WS_WUP + 172 * MiB;
constexpr size_t WS_WMEM = WS_WDOWN + 86 * MiB;
constexpr size_t WS_WSB = WS_WMEM + 16 * MiB;
constexpr size_t WS_TB = WS_WSB + 1 * MiB;
constexpr size_t WS_BT2 = WS_TB + 36 * MiB;
constexpr size_t WS_LBT = WS_BT2 + 12 * MiB;
constexpr size_t WS_LB16 = WS_LBT + 128 * 1024;
constexpr size_t WS_BBAR = WS_LBT + 1 * MiB;
constexpr size_t WS_XRES = WS_BBAR + 2 * MiB;
constexpr size_t WS_XB = WS_XRES + 66 * MiB;
constexpr size_t WS_MEMB = WS_XB + 33 * MiB;
constexpr size_t WS_MKV = WS_MEMB + 4 * MiB;
constexpr size_t WS_ZU = WS_MKV + 8 * MiB;
constexpr size_t WS_ZV = WS_ZU + 25 * MiB;
constexpr size_t WS_Q = WS_ZV + 25 * MiB;
constexpr size_t WS_MIX = WS_Q + 9 * MiB;
constexpr size_t WS_AG = WS_MIX + 33 * MiB;
constexpr size_t WS_Y = WS_AG + 178 * MiB;
constexpr size_t WS_UH = WS_Y + 89 * MiB;
constexpr size_t WS_YB = WS_UH + 36 * MiB;
constexpr size_t WS_US = WS_YB + 25 * MiB;
constexpr size_t WS_END = WS_US + 1 * MiB;
constexpr int CW_BAR = 4096;
typedef unsigned long long ssq_t;
constexpr size_t CTL_SSX = 64 * 1024;
constexpr size_t CTL_SSV = 704 * 1024;
constexpr size_t CTL_SSMEM = 896 * 1024;
static_assert(CTL_SSX + 9 * MT * 8 <= CTL_SSV && CTL_SSV + 2 * MT * 8 <= CTL_SSMEM && CTL_SSMEM + 8192 <= CTL_ZERO_BYTES, "ctl map");

constexpr int LDS_BYTES = 147456, MISC_OFF = LDS_BYTES - 512;

__device__ __forceinline__ unsigned pk2(float lo, float hi) { return pg8::cvt_pk_bf16(lo, hi); }
__device__ __forceinline__ float bflo(unsigned w) { return __uint_as_float(w << 16); }
__device__ __forceinline__ float bfhi(unsigned w) { return __uint_as_float(w & 0xffff0000u); }
__device__ __forceinline__ float gelu_t(float x) { const float e = __builtin_amdgcn_exp2f(x * (-2.3022082f - 0.10294324f * x * x)); return x * __builtin_amdgcn_rcpf(1.f + e); }
__device__ __forceinline__ float sigmoid_f(float x) { return __builtin_amdgcn_rcpf(1.f + __builtin_amdgcn_exp2f(-1.4426950409f * x)); }
__device__ __forceinline__ ssq_t ss_fix(float v) { return (ssq_t)(long long)(v * 1073741824.0f); }
__device__ __forceinline__ float rstd_of(ssq_t ss, float inv_n) { return rsqrtf((float)ss * (1.0f / 1073741824.0f) * inv_n + EPS); }
__device__ __forceinline__ float wave_sum(float v) {
#pragma unroll
    for (int o = 1; o < 64; o <<= 1) v += __shfl_xor(v, o);
    return v;
}
__device__ __forceinline__ float wave_max(float v) {
#pragma unroll
    for (int o = 1; o < 64; o <<= 1) v = fmaxf(v, __shfl_xor(v, o));
    return v;
}
__device__ __forceinline__ void fadd_atomic(ssq_t* p, float v) { atomicAdd(p, ss_fix(v)); }
__device__ __forceinline__ f32x4 gelu4(f32x4 v) { return (f32x4){gelu_t(v[0]), gelu_t(v[1]), gelu_t(v[2]), gelu_t(v[3])}; }
__device__ __forceinline__ v4u pack8(f32x4 a, f32x4 b) { v4u w; w.x = pk2(a[0], a[1]); w.y = pk2(a[2], a[3]); w.z = pk2(b[0], b[1]); w.w = pk2(b[2], b[3]); return w; }
__device__ __forceinline__ float dot4(f32x4 a) { return (a[0] * a[0] + a[1] * a[1]) + (a[2] * a[2] + a[3] * a[3]); }

typedef const f32x4 (&AccRef)[2][2][4][2];
struct EpiSgIn {
    static constexpr bool PERM = true, AFTER_DRAIN = false;
    const ssq_t* ss; bf16* zu; bf16* zv; bf16* q; ssq_t* ssv;
    __device__ __forceinline__ void operator()(AccRef acc, const pg8::Unit& u, int wr, int wc, int fr, int fq) const {
        const int row0 = u.pm * 256 + wr * 64 + fr, colt = u.pn * 256 + wc * 32 + 8 * fq;
        const int kind = u.pn < 6 ? 0 : (u.pn < 12 ? 1 : 2);
#pragma unroll
        for (int ai = 0; ai < 2; ++ai)
#pragma unroll
            for (int m = 0; m < 4; ++m) {
                const int r = row0 + ai * 128 + m * 16; const float rs = rstd_of(ss[r], 1.f / 2048.f); float sq = 0.f;
#pragma unroll
                for (int bj = 0; bj < 2; ++bj) {
                    f32x4 v0 = acc[ai][bj][m][0] * rs, v1 = acc[ai][bj][m][1] * rs; const int c = colt + bj * 128;
                    if (kind < 2) { v0 = gelu4(v0); v1 = gelu4(v1); }
                    if (kind == 1) sq += dot4(v0) + dot4(v1);
                    bf16* dst = kind == 0 ? zu + (size_t)r * TOKW + c : (kind == 1 ? zv + (size_t)r * TOKW + (c - TOKW) : q + (size_t)r * XAW + (c - 2 * TOKW));
                    *(v4u*)dst = pack8(v0, v1);
                }
                if (kind == 1) { sq += __shfl_xor(sq, 16); sq += __shfl_xor(sq, 32); if (fq == 0) fadd_atomic(ssv + r, sq); }
                asm volatile("" ::: "memory");
            }
    }
};
struct EpiRes {
    static constexpr bool PERM = false, AFTER_DRAIN = false;
    float* xres; bf16* xb; ssq_t* ssn;
    __device__ __forceinline__ void operator()(AccRef acc, const pg8::Unit& u, int wr, int wc, int fr, int fq) const {
        const int row0 = u.pm * 256 + wr * 64 + fr, col0 = u.pn * 256 + wc * 32 + 4 * fq;
#pragma unroll
        for (int ai = 0; ai < 2; ++ai)
#pragma unroll
            for (int m = 0; m < 4; ++m) {
                const int r = row0 + ai * 128 + m * 16; float sq = 0.f;
                float* xp = xres + (size_t)r * D + col0; bf16* bp = xb + (size_t)r * D + col0;
#pragma unroll
                for (int bj = 0; bj < 2; ++bj)
#pragma unroll
                    for (int n = 0; n < 2; ++n) { const int off = bj * 128 + n * 16; const f32x4 o = *(const f32x4*)(xp + off) + acc[ai][bj][m][n]; *(f32x4*)(xp + off) = o; sq += dot4(o);
                        v2u w; w.x = pk2(o[0], o[1]); w.y = pk2(o[2], o[3]); *(v2u*)(bp + off) = w; }
                sq += __shfl_xor(sq, 16); sq += __shfl_xor(sq, 32); if (fq == 0) fadd_atomic(ssn + r, sq);
                asm volatile("" ::: "memory");
            }
    }
};
struct EpiUp {
    static constexpr bool PERM = true, AFTER_DRAIN = false;
    const ssq_t* ss; bf16* ag; float* out; int layer;
    __device__ __forceinline__ void operator()(AccRef acc, const pg8::Unit& u, int wr, int wc, int fr, int fq) const {
        const int row0 = u.pm * 256 + wr * 64 + fr, colt = u.pn * 256 + wc * 32 + 8 * fq;
#pragma unroll
        for (int ai = 0; ai < 2; ++ai)
#pragma unroll
            for (int m = 0; m < 4; ++m) {
                const int r = row0 + ai * 128 + m * 16; const float rs = rstd_of(ss[r], 1.f / 2048.f);
#pragma unroll
                for (int bj = 0; bj < 2; ++bj) {
                    const f32x4 v0 = acc[ai][bj][m][0] * rs, v1 = acc[ai][bj][m][1] * rs; const int c = colt + bj * 128;
                    *(v4u*)(ag + (size_t)r * NUP + c) = pack8(v0, v1);
                    if (c < DFF) {
                        float* o = nullptr;
                        if (r < MP) { const int t = r & (SEQ - 1); if (t >= SEQ - 2) o = out + OFF_CONVP + ((size_t)((layer * 4 + (r >> 11)) * 2 + (t - (SEQ - 2)))) * DFF + c; }
                        else if (r < MREAL) o = out + OFF_CONVS + ((size_t)((layer * MS + (r - MP)) * 2 + 1)) * DFF + c;
                        if (o) { *(f32x4*)o = v0; *(f32x4*)(o + 4) = v1; }
                    }
                }
                asm volatile("" ::: "memory");
            }
    }
};
struct EpiSsmIn {
    static constexpr bool PERM = true, AFTER_DRAIN = false;
    const ssq_t* ss; bf16* uh; float* us; bf16* q;
    __device__ __forceinline__ void operator()(AccRef acc, const pg8::Unit& u, int wr, int wc, int fr, int fq) const {
        const int row0 = u.pm * 256 + wr * 64 + fr, colt = u.pn * 256 + wc * 32 + 8 * fq;
#pragma unroll
        for (int ai = 0; ai < 2; ++ai)
#pragma unroll
            for (int m = 0; m < 4; ++m) {
                const int r = row0 + ai * 128 + m * 16; const float rs = rstd_of(ss[r], 1.f / 2048.f);
#pragma unroll
                for (int bj = 0; bj < 2; ++bj) {
                    const f32x4 v0 = acc[ai][bj][m][0] * rs, v1 = acc[ai][bj][m][1] * rs; const int c = colt + bj * 128;
                    if (u.pn < 6) {
                        if (r < MP) { const int h = c >> 4, c0 = c & 15; *(v4u*)(uh + ((size_t)(h * 512 + (r >> 4)) * KH + (r & 15) * 16 + c0)) = pack8(v0, v1); }
                        else if (r < MREAL) { float* o = us + (size_t)(r - MP) * TOKW + c; *(f32x4*)o = v0; *(f32x4*)(o + 4) = v1; }
                    } else *(v4u*)(q + (size_t)r * XAW + (c - TOKW)) = pack8(v0, v1);
                }
                asm volatile("" ::: "memory");
            }
    }
};
struct EpiToep {
    static constexpr bool PERM = true, AFTER_DRAIN = false;
    bf16* yb;
    __device__ __forceinline__ void operator()(AccRef acc, const pg8::Unit& u, int wr, int wc, int fr, int fq) const {
        const int h = u.pn, mh = u.pm - 2 * h;
#pragma unroll
        for (int ai = 0; ai < 2; ++ai)
#pragma unroll
            for (int m = 0; m < 4; ++m) {
                const int ml = mh * 256 + ai * 128 + wr * 64 + m * 16 + fr;
#pragma unroll
                for (int bj = 0; bj < 2; ++bj) {
                    const int cl = bj * 128 + wc * 32 + 8 * fq, tau = cl >> 4, c0 = cl & 15;
                    *(v4u*)(yb + (size_t)(ml * 16 + tau) * TOKW + h * 16 + c0) = pack8(gelu4(acc[ai][bj][m][0]), gelu4(acc[ai][bj][m][1]));
                    __builtin_amdgcn_sched_barrier(0);
                }
            }
    }
};
struct EpiGlu {
    static constexpr bool PERM = true, AFTER_DRAIN = false;
    const bf16* yb; const float* bias; bf16* mix;
    __device__ __forceinline__ void operator()(AccRef acc, const pg8::Unit& u, int wr, int wc, int fr, int fq) const {
        const int row0 = u.pm * 256 + wr * 64 + fr, colt = u.pn * 256 + wc * 32 + 8 * fq;
#pragma unroll
        for (int ai = 0; ai < 2; ++ai)
#pragma unroll
            for (int m = 0; m < 4; ++m) {
                const int r = row0 + ai * 128 + m * 16;
#pragma unroll
                for (int bj = 0; bj < 2; ++bj) {
                    const int c = colt + bj * 128; const f32x4 b0 = *(const f32x4*)(bias + c), b1 = *(const f32x4*)(bias + c + 4);
                    const v4u yw = *(const v4u*)(yb + (size_t)r * TOKW + c);
                    const f32x4 g0 = acc[ai][bj][m][0] + b0, g1 = acc[ai][bj][m][1] + b1;
                    f32x4 o0, o1;
                    o0[0] = bflo(yw.x) * sigmoid_f(g0[0]); o0[1] = bfhi(yw.x) * sigmoid_f(g0[1]); o0[2] = bflo(yw.y) * sigmoid_f(g0[2]); o0[3] = bfhi(yw.y) * sigmoid_f(g0[3]);
                    o1[0] = bflo(yw.z) * sigmoid_f(g1[0]); o1[1] = bfhi(yw.z) * sigmoid_f(g1[1]); o1[2] = bflo(yw.w) * sigmoid_f(g1[2]); o1[3] = bfhi(yw.w) * sigmoid_f(g1[3]);
                    *(v4u*)(mix + (size_t)r * D + c) = pack8(o0, o1);
                    asm volatile("" ::: "memory");
                }
            }
    }
};
struct EpiMem {
    static constexpr bool PERM = false, AFTER_DRAIN = false;
    const ssq_t* ssm; float* out; bf16* mkv;
    __device__ __forceinline__ void operator()(AccRef acc, const pg8::Unit& u, int wr, int wc, int fr, int fq) const {
        const int row0 = u.pm * 256 + wr * 64 + fr, col0 = u.pn * 256 + wc * 32 + 4 * fq;
#pragma unroll
        for (int ai = 0; ai < 2; ++ai)
#pragma unroll
            for (int m = 0; m < 4; ++m) {
                const int r = row0 + ai * 128 + m * 16; const float rs = rstd_of(ssm[r], 1.f / 2048.f);
#pragma unroll
                for (int bj = 0; bj < 2; ++bj)
#pragma unroll
                    for (int n = 0; n < 2; ++n) { const int c = col0 + bj * 128 + n * 16, li = c >> 10, cc = c & 1023; const f32x4 v = acc[ai][bj][m][n] * rs;
                        *(f32x4*)(out + (cc < 512 ? OFF_MK : OFF_MV) + (size_t)(li * 1024 + r) * 512 + (cc & 511)) = v;
                        v2u w; w.x = pk2(v[0], v[1]); w.y = pk2(v[2], v[3]); *(v2u*)(mkv + (size_t)(li * 1024 + r) * 1024 + cc) = w; }
            }
    }
};
struct ToepOrder {
    int G, c;
    __device__ bool next(int i, pg8::Unit& u) const { const int L = i * G + c; if (L >= 2 * NGRP) return false; const int h = L >> 1; u.pm = 2 * h + (L & 1); u.pn = h; return true; }
    __device__ __forceinline__ void a_ready(const pg8::Unit&) const {}
    __device__ __forceinline__ void done(const pg8::Unit&) const {}
};

__device__ __forceinline__ void p0_transpose_item(const float* W, const float* gain, int K, int N, bf16* WT, int row_off, LAS float* scr, int item, int lane) {
    const int nblk = N / 32, kb = item / nblk, nb = item % nblk, k0 = 64 * kb, n0 = 32 * nb;
#pragma unroll 8
    for (int i = 0; i < 32; ++i) { const int kk = 2 * i + (lane >> 5); const float g = gain ? gain[k0 + kk] : 1.f; scr[kk * 33 + (lane & 31)] = W[(size_t)(k0 + kk) * N + n0 + (lane & 31)] * g; }
    asm volatile("s_waitcnt lgkmcnt(0)" ::: "memory");
    const int c = lane & 7;
#pragma unroll
    for (int j = 0; j < 4; ++j) { const int n = (lane >> 3) + 8 * j; const LAS float* s = scr + (8 * c) * 33 + n;
        v4u o; o.x = pk2(s[0 * 33], s[1 * 33]); o.y = pk2(s[2 * 33], s[3 * 33]); o.z = pk2(s[4 * 33], s[5 * 33]); o.w = pk2(s[6 * 33], s[7 * 33]);
        *(v4u*)(WT + (size_t)(row_off + n0 + n) * K + k0 + 8 * c) = o; }
    asm volatile("s_waitcnt lgkmcnt(0)" ::: "memory");
}
__device__ __forceinline__ void p0_row(const float* src, float* dstf, bf16* dstb, ssq_t* ssp, int lane) {
    f32x4 v[8]; float s = 0.f;
#pragma unroll
    for (int j = 0; j < 8; ++j) { v[j] = src ? ((const f32x4*)src)[lane + 64 * j] : (f32x4){0.f, 0.f, 0.f, 0.f}; s += dot4(v[j]); }
    s = wave_sum(s);
#pragma unroll
    for (int j = 0; j < 8; ++j) { if (dstf) ((f32x4*)dstf)[lane + 64 * j] = v[j]; v2u w; w.x = pk2(v[j][0], v[j][1]); w.y = pk2(v[j][2], v[j][3]); ((v2u*)dstb)[lane + 64 * j] = w; }
    if (lane == 0) *ssp = ss_fix(s);
}
__device__ __forceinline__ void s5_tables(LAS float* L, int j, int h, const float* lam_re, const float* lam_im, const float* log_dt, const float* b_re, const float* b_im,
                                          const float* c_re, const float* c_im, const float* dvec, bf16* TB, bf16* BT2, float* LBT, float* LB16, float* BBART, int tid) {
    LAS float* PWr = L; LAS float* PWi = L + 1088; LAS float* BBr = L + 2176; LAS float* BBi = L + 3200; LAS float* Cr = L + 4224; LAS float* Ci = L + 5248; LAS float* KM = L + 6272;
    const int gh = j * NGRP + h;
    if (tid < 64) {
        const int p = tid, idx = gh * 64 + p; const float lr = lam_re[idx], li = lam_im[idx], dt = expf(log_dt[gh]);
        const float ar = lr * dt, ai = li * dt, mag = expf(ar); float sn, cs; sincosf(ai, &sn, &cs);
        const float lbr = mag * cs, lbi = mag * sn; const float sh = sinf(0.5f * ai);
        const float nr = expm1f(ar) * cs - 2.f * sh * sh, ni = lbi, den = lr * lr + li * li;
        const float kr = (nr * lr + ni * li) / den, ki = (ni * lr - nr * li) / den;
        float pr = 1.f, pi = 0.f;
#pragma unroll
        for (int n = 0; n < 17; ++n) { PWr[p * 17 + n] = pr; PWi[p * 17 + n] = pi; if (n == 16) { LB16[idx * 2] = pr; LB16[idx * 2 + 1] = pi; } const float t = pr * lbr - pi * lbi; pi = pr * lbi + pi * lbr; pr = t; }
        LBT[idx * 2] = lbr; LBT[idx * 2 + 1] = lbi;
#pragma unroll
        for (int c = 0; c < 16; ++c) { const float br = b_re[(size_t)idx * 16 + c], bi = b_im[(size_t)idx * 16 + c]; const float xr = kr * br - ki * bi, xi = kr * bi + ki * br;
            BBr[p * 16 + c] = xr; BBi[p * 16 + c] = xi; BBART[((size_t)idx * 16 + c) * 2] = xr; BBART[((size_t)idx * 16 + c) * 2 + 1] = xi; }
    }
#pragma unroll
    for (int i = 0; i < 2; ++i) { const int e = tid + 512 * i; Cr[e] = c_re[(size_t)gh * 1024 + e]; Ci[e] = c_im[(size_t)gh * 1024 + e]; }
    __syncthreads();
#pragma unroll 1
    for (int i = 0; i < 8; ++i) {
        const int e = tid * 8 + i, dl = e >> 8, c = (e >> 4) & 15, c2 = e & 15; float s = 0.f;
#pragma unroll 4
        for (int p = 0; p < 64; ++p) { const float wr_ = PWr[p * 17 + dl], wi_ = PWi[p * 17 + dl], xr = BBr[p * 16 + c2], xi = BBi[p * 16 + c2];
            s += Cr[c * 64 + p] * (wr_ * xr - wi_ * xi) - Ci[c * 64 + p] * (wr_ * xi + wi_ * xr); }
        if (dl == 0 && c == c2) s += dvec[j * TOKW + h * 16 + c];
        KM[e] = s;
    }
    __syncthreads();
#pragma unroll 1
    for (int it = 0; it < 24; ++it) {
        const int grp = tid + 512 * it, row = grp / 48, cg = grp % 48, tau = row >> 4, c = row & 15; float v[8];
        if (cg < 32) { const int sg = cg >> 1, c0 = (cg & 1) * 8;
#pragma unroll
            for (int i = 0; i < 8; ++i) v[i] = sg <= tau ? KM[(tau - sg) * 256 + c * 16 + c0 + i] : 0.f; }
        else if (cg < 40) {
#pragma unroll
            for (int i = 0; i < 8; ++i) { const int p = (cg - 32) * 8 + i; v[i] = Cr[c * 64 + p] * PWr[p * 17 + tau + 1] - Ci[c * 64 + p] * PWi[p * 17 + tau + 1]; } }
        else {
#pragma unroll
            for (int i = 0; i < 8; ++i) { const int p = (cg - 40) * 8 + i; v[i] = -(Cr[c * 64 + p] * PWi[p * 17 + tau + 1] + Ci[c * 64 + p] * PWr[p * 17 + tau + 1]); } }
        v4u w; w.x = pk2(v[0], v[1]); w.y = pk2(v[2], v[3]); w.z = pk2(v[4], v[5]); w.w = pk2(v[6], v[7]);
        *(v4u*)(TB + ((size_t)gh * 256 + row) * KH + cg * 8) = w;
    }
#pragma unroll 1
    for (int it = 0; it < 8; ++it) {
        const int grp = tid + 512 * it, row = grp >> 5, cg = grp & 31, ri = row >> 6, p = row & 63, n = 15 - (cg >> 1), c0 = (cg & 1) * 8; float v[8];
        const float wr_ = PWr[p * 17 + n], wi_ = PWi[p * 17 + n];
#pragma unroll
        for (int i = 0; i < 8; ++i) { const float xr = BBr[p * 16 + c0 + i], xi = BBi[p * 16 + c0 + i]; v[i] = ri == 0 ? (wr_ * xr - wi_ * xi) : (wr_ * xi + wi_ * xr); }
        v4u w; w.x = pk2(v[0], v[1]); w.y = pk2(v[2], v[3]); w.z = pk2(v[4], v[5]); w.w = pk2(v[6], v[7]);
        *(v4u*)(BT2 + ((size_t)gh * 128 + row) * 256 + cg * 8) = w;
    }
    __syncthreads();
}

constexpr int KS_LD = 136, VT_LD = 264, VT_OFF = 256 * KS_LD * 2;
__device__ __forceinline__ void attn_prompt_unit(LAS unsigned char* lds, const bf16* q, const bf16* mkv_l, bf16* mix, int unit, int tid) {
    const int b = unit >> 6, hd = (unit >> 4) & 3, qb = unit & 15, lane = tid & 63, w = tid >> 6, fr = lane & 15, fq = lane >> 4;
    LAS bf16* Ks = (LAS bf16*)lds; LAS bf16* Vt = (LAS bf16*)(lds + VT_OFF);
    const bf16* kvb = mkv_l + (size_t)(b * 256) * 1024 + hd * 128;
#pragma unroll
    for (int it = 0; it < 8; ++it) { const int id = tid + 512 * it, key = id >> 4, part = id & 15;
        const v4u kw = *(const v4u*)(kvb + (size_t)key * 1024 + part * 8); *(LAS v4u*)(Ks + key * KS_LD + part * 8) = kw;
        const v4u vw = *(const v4u*)(kvb + (size_t)key * 1024 + 512 + part * 8); LAS bf16* vp = Vt + (part * 8) * VT_LD + key;
        vp[0] = (bf16)(vw.x & 0xffff); vp[VT_LD] = (bf16)(vw.x >> 16); vp[2 * VT_LD] = (bf16)(vw.y & 0xffff); vp[3 * VT_LD] = (bf16)(vw.y >> 16);
        vp[4 * VT_LD] = (bf16)(vw.z & 0xffff); vp[5 * VT_LD] = (bf16)(vw.z >> 16); vp[6 * VT_LD] = (bf16)(vw.w & 0xffff); vp[7 * VT_LD] = (bf16)(vw.w >> 16); }
    const int r = b * SEQ + qb * 128 + w * 16 + fr;
    bf16x8 qf[4];
#pragma unroll
    for (int ks = 0; ks < 4; ++ks) qf[ks] = *(const bf16x8*)(q + (size_t)r * XAW + hd * 128 + ks * 32 + fq * 8);
    __syncthreads();
    f32x4 s[16];
#pragma unroll
    for (int t = 0; t < 16; ++t) { s[t] = (f32x4){0.f, 0.f, 0.f, 0.f};
#pragma unroll
        for (int ks = 0; ks < 4; ++ks) { const bf16x8 kf = *(const LAS bf16x8*)(Ks + (t * 16 + fr) * KS_LD + ks * 32 + fq * 8); s[t] = __builtin_amdgcn_mfma_f32_16x16x32_bf16(kf, qf[ks], s[t], 0, 0, 0); } }
    float mx = -3.0e38f;
#pragma unroll
    for (int t = 0; t < 16; ++t) mx = fmaxf(fmaxf(fmaxf(s[t][0], s[t][1]), fmaxf(s[t][2], s[t][3])), mx);
    mx = fmaxf(mx, __shfl_xor(mx, 16)); mx = fmaxf(mx, __shfl_xor(mx, 32));
    const float sc = 0.08838834764831845f * 1.4426950408889634f; float sum = 0.f;
#pragma unroll
    for (int t = 0; t < 16; ++t) {
#pragma unroll
        for (int jj = 0; jj < 4; ++jj) { const float p = __builtin_amdgcn_exp2f((s[t][jj] - mx) * sc); s[t][jj] = p; sum += p; } }
    sum += __shfl_xor(sum, 16); sum += __shfl_xor(sum, 32);
    f32x4 o[8];
#pragma unroll
    for (int dt = 0; dt < 8; ++dt) o[dt] = (f32x4){0.f, 0.f, 0.f, 0.f};
#pragma unroll
    for (int kk = 0; kk < 8; ++kk) {
        v4u pw; pw.x = pk2(s[2 * kk][0], s[2 * kk][1]); pw.y = pk2(s[2 * kk][2], s[2 * kk][3]); pw.z = pk2(s[2 * kk + 1][0], s[2 * kk + 1][1]); pw.w = pk2(s[2 * kk + 1][2], s[2 * kk + 1][3]);
        const bf16x8 pf = __builtin_bit_cast(bf16x8, pw);
#pragma unroll
        for (int dt = 0; dt < 8; ++dt) { const LAS bf16* vp = Vt + (dt * 16 + fr) * VT_LD + kk * 32 + fq * 4;
            v4u vw; const v2u lo = *(const LAS v2u*)vp, hi = *(const LAS v2u*)(vp + 16); vw.x = lo.x; vw.y = lo.y; vw.z = hi.x; vw.w = hi.y;
            o[dt] = __builtin_amdgcn_mfma_f32_16x16x32_bf16(__builtin_bit_cast(bf16x8, vw), pf, o[dt], 0, 0, 0); } }
    const float inv = 1.f / sum;
#pragma unroll
    for (int dt = 0; dt < 8; ++dt) { v2u w2; w2.x = pk2(o[dt][0] * inv, o[dt][1] * inv); w2.y = pk2(o[dt][2] * inv, o[dt][3] * inv);
        *(v2u*)(mix + (size_t)r * D + TOKW + hd * 128 + dt * 16 + fq * 4) = w2; }
    __syncthreads();
}
__device__ __forceinline__ void attn_sample_unit(LAS unsigned char* lds, const bf16* q, const float* ck, const float* cv, bf16* mix, int li, int unit, int tid) {
    const int b = unit >> 1, hp = unit & 1, lane = tid & 63, w = tid >> 6, hd = 2 * hp + (w >> 2), kq = (w & 3) * 64, dd = lane & 15, kg = lane >> 4;
    LAS float* red = (LAS float*)lds;
    const v4u qw = *(const v4u*)(q + (size_t)(MP + b) * XAW + hd * 128 + dd * 8);
    float qv[8] = {bflo(qw.x), bfhi(qw.x), bflo(qw.y), bfhi(qw.y), bflo(qw.z), bfhi(qw.z), bflo(qw.w), bfhi(qw.w)};
    const size_t base = ((size_t)(li * MS + b) * 256) * 512 + hd * 128 + dd * 8;
    float sc[16];
#pragma unroll
    for (int it = 0; it < 16; ++it) { const int key = kq + 4 * it + kg; const float* kp = ck + base + (size_t)key * 512; const f32x4 k0 = *(const f32x4*)kp, k1 = *(const f32x4*)(kp + 4);
        float d = qv[0] * k0[0] + qv[1] * k0[1] + qv[2] * k0[2] + qv[3] * k0[3] + qv[4] * k1[0] + qv[5] * k1[1] + qv[6] * k1[2] + qv[7] * k1[3];
        d += __shfl_xor(d, 1); d += __shfl_xor(d, 2); d += __shfl_xor(d, 4); d += __shfl_xor(d, 8); sc[it] = d; }
    float mx = sc[0];
#pragma unroll
    for (int it = 1; it < 16; ++it) mx = fmaxf(mx, sc[it]);
    mx = fmaxf(mx, __shfl_xor(mx, 16)); mx = fmaxf(mx, __shfl_xor(mx, 32));
    if (lane == 0) red[w] = mx;
    __syncthreads();
    const int w0 = w & 4; mx = fmaxf(fmaxf(red[w0], red[w0 + 1]), fmaxf(red[w0 + 2], red[w0 + 3]));
    const float scl = 0.08838834764831845f * 1.4426950408889634f; float sum = 0.f;
    float oacc[8] = {0.f, 0.f, 0.f, 0.f, 0.f, 0.f, 0.f, 0.f};
#pragma unroll
    for (int it = 0; it < 16; ++it) { const float p = __builtin_amdgcn_exp2f((sc[it] - mx) * scl); sum += p;
        const int key = kq + 4 * it + kg; const float* vp = cv + base + (size_t)key * 512; const f32x4 v0 = *(const f32x4*)vp, v1 = *(const f32x4*)(vp + 4);
        oacc[0] += p * v0[0]; oacc[1] += p * v0[1]; oacc[2] += p * v0[2]; oacc[3] += p * v0[3]; oacc[4] += p * v1[0]; oacc[5] += p * v1[1]; oacc[6] += p * v1[2]; oacc[7] += p * v1[3]; }
    sum += __shfl_xor(sum, 16); sum += __shfl_xor(sum, 32);
#pragma unroll
    for (int i = 0; i < 8; ++i) { oacc[i] += __shfl_xor(oacc[i], 16); oacc[i] += __shfl_xor(oacc[i], 32); }
    if (lane == 0) red[8 + w] = sum;
    if (lane < 16) {
#pragma unroll
        for (int i = 0; i < 8; ++i) red[16 + w * 128 + dd * 8 + i] = oacc[i]; }
    __syncthreads();
    if ((w & 3) == 0 && lane < 16) {
        const float tot = (red[8 + w] + red[9 + w]) + (red[10 + w] + red[11 + w]), inv = 1.f / tot; float o[8];
#pragma unroll
        for (int i = 0; i < 8; ++i) o[i] = ((red[16 + w * 128 + dd * 8 + i] + red[16 + (w + 1) * 128 + dd * 8 + i]) + (red[16 + (w + 2) * 128 + dd * 8 + i] + red[16 + (w + 3) * 128 + dd * 8 + i])) * inv;
        v4u ow; ow.x = pk2(o[0], o[1]); ow.y = pk2(o[2], o[3]); ow.z = pk2(o[4], o[5]); ow.w = pk2(o[6], o[7]);
        *(v4u*)(mix + (size_t)(MP + b) * D + TOKW + hd * 128 + dd * 8) = ow;
    }
    __syncthreads();
}

constexpr int SG_LD = 136;
__device__ __forceinline__ void sg_unit(LAS unsigned char* lds, const bf16* zu, const bf16* zv, const ssq_t* ssv, const float* g_v, const bf16* wsb, const float* b_s, bf16* mix, int unit, int tid) {
    const int ch = unit / 12, g = unit % 12, row0 = ch * 128, lane = tid & 63, w = tid >> 6, fr = lane & 15, fq = lane >> 4;
    LAS bf16* Vt = (LAS bf16*)lds;
    { const int s = tid & 127, dq = tid >> 7; const float rsv = rstd_of(ssv[row0 + s], 1.f / 1536.f);
#pragma unroll
      for (int it = 0; it < 4; ++it) { const int d0 = (dq + 4 * it) * 8; const v4u vw = *(const v4u*)(zv + (size_t)(row0 + s) * TOKW + g * 128 + d0);
          const f32x4 g0 = *(const f32x4*)(g_v + g * 128 + d0), g1 = *(const f32x4*)(g_v + g * 128 + d0 + 4);
          const unsigned a = pk2(bflo(vw.x) * rsv * g0[0], bfhi(vw.x) * rsv * g0[1]), b2 = pk2(bflo(vw.y) * rsv * g0[2], bfhi(vw.y) * rsv * g0[3]),
                         c2 = pk2(bflo(vw.z) * rsv * g1[0], bfhi(vw.z) * rsv * g1[1]), e2 = pk2(bflo(vw.w) * rsv * g1[2], bfhi(vw.w) * rsv * g1[3]);
          LAS bf16* vp = Vt + d0 * SG_LD + s;
          vp[0] = (bf16)(a & 0xffff); vp[SG_LD] = (bf16)(a >> 16); vp[2 * SG_LD] = (bf16)(b2 & 0xffff); vp[3 * SG_LD] = (bf16)(b2 >> 16);
          vp[4 * SG_LD] = (bf16)(c2 & 0xffff); vp[5 * SG_LD] = (bf16)(c2 >> 16); vp[6 * SG_LD] = (bf16)(e2 & 0xffff); vp[7 * SG_LD] = (bf16)(e2 >> 16); } }
    const int nks = (w >> 1) + 1;
    bf16x8 wf[4];
#pragma unroll
    for (int ks = 0; ks < 4; ++ks) wf[ks] = *(const bf16x8*)(wsb + ((size_t)g * 128 + w * 16 + fr) * 128 + ks * 32 + fq * 8);
    __syncthreads();
    f32x4 acc[8];
#pragma unroll
    for (int dt = 0; dt < 8; ++dt) { acc[dt] = (f32x4){0.f, 0.f, 0.f, 0.f};
#pragma unroll
        for (int ks = 0; ks < 4; ++ks) if (ks < nks) { const bf16x8 vf = *(const LAS bf16x8*)(Vt + (dt * 16 + fr) * SG_LD + ks * 32 + fq * 8); acc[dt] = __builtin_amdgcn_mfma_f32_16x16x32_bf16(vf, wf[ks], acc[dt], 0, 0, 0); } }
    const int t = w * 16 + fr, r = row0 + t; const float bias = b_s[g * 128 + t];
#pragma unroll
    for (int dt = 0; dt < 8; ++dt) { const int c = g * 128 + dt * 16 + fq * 4; const v2u uw = *(const v2u*)(zu + (size_t)r * TOKW + c);
        v2u ow; ow.x = pk2(bflo(uw.x) * (acc[dt][0] + bias), bfhi(uw.x) * (acc[dt][1] + bias)); ow.y = pk2(bflo(uw.y) * (acc[dt][2] + bias), bfhi(uw.y) * (acc[dt][3] + bias));
        *(v2u*)(mix + (size_t)r * D + c) = ow; }
    __syncthreads();
}

__device__ __forceinline__ void s5_state_task(LAS unsigned char* lds, bf16* uh, const bf16* bt2_l, const float* lb16_l, float* out, int j, int task, int tid) {
    const int b = task / NGRP, h = task % NGRP, lane = tid & 63, w = tid >> 6, fr = lane & 15, fq = lane >> 4;
    LAS float* S = (LAS float*)lds;
    bf16x8 af[8];
    const bf16* ap = uh + ((size_t)(h * 512 + b * 128 + w * 16 + fr)) * KH + fq * 8;
#pragma unroll
    for (int ks = 0; ks < 8; ++ks) af[ks] = *(const bf16x8*)(ap + ks * 32);
#pragma unroll
    for (int nt = 0; nt < 8; ++nt) { f32x4 acc = (f32x4){0.f, 0.f, 0.f, 0.f}; const bf16* bp = bt2_l + ((size_t)(h * 128 + nt * 16 + fr)) * 256 + fq * 8;
#pragma unroll
        for (int ks = 0; ks < 8; ++ks) { const bf16x8 bf = *(const bf16x8*)(bp + ks * 32); acc = __builtin_amdgcn_mfma_f32_16x16x32_bf16(af[ks], bf, acc, 0, 0, 0); }
#pragma unroll
        for (int jj = 0; jj < 4; ++jj) S[(w * 16 + fq * 4 + jj) * 129 + nt * 16 + fr] = acc[jj]; }
    __syncthreads();
    if (w == 0) {
        const int p = lane; const float lr = lb16_l[(h * 64 + p) * 2], li = lb16_l[(h * 64 + p) * 2 + 1]; float hr = 0.f, hi = 0.f;
        bf16* up = uh + ((size_t)(h * 512 + b * 128)) * KH + 256 + p;
#pragma unroll 4
        for (int m = 0; m < 128; ++m) { up[(size_t)m * KH] = (bf16)(pk2(hr, 0.f) & 0xffff); up[(size_t)m * KH + 64] = (bf16)(pk2(hi, 0.f) & 0xffff);
            const float sr = S[m * 129 + p], si = S[m * 129 + 64 + p]; const float t = lr * hr - li * hi + sr; hi = lr * hi + li * hr + si; hr = t; }
        out[OFF_SRP + ((size_t)(j * 4 + b) * NGRP + h) * 64 + p] = hr; out[OFF_SIP + ((size_t)(j * 4 + b) * NGRP + h) * 64 + p] = hi;
    }
    __syncthreads();
}
__device__ __forceinline__ void s5_sample_task(const float* us, const float* st_re, const float* st_im, const float* lbt_l, const float* bbar_l, const float* c_re_l, const float* c_im_l, const float* d_l,
                                               float* out, bf16* yb, int j, int task, int lane) {
    const int b = task / NGRP, h = task % NGRP, p = lane;
    float u[16];
#pragma unroll
    for (int c4 = 0; c4 < 4; ++c4) { const f32x4 t = *(const f32x4*)(us + (size_t)b * TOKW + h * 16 + c4 * 4); u[c4 * 4] = t[0]; u[c4 * 4 + 1] = t[1]; u[c4 * 4 + 2] = t[2]; u[c4 * 4 + 3] = t[3]; }
    float xr = 0.f, xi = 0.f; const float* bb = bbar_l + ((size_t)(h * 64 + p)) * 32;
#pragma unroll
    for (int c2 = 0; c2 < 8; ++c2) { const f32x4 t = *(const f32x4*)(bb + c2 * 4); xr += t[0] * u[2 * c2] + t[2] * u[2 * c2 + 1]; xi += t[1] * u[2 * c2] + t[3] * u[2 * c2 + 1]; }
    const size_t si_ = ((size_t)(j * MS + b) * NGRP + h) * 64 + p; const float s0r = st_re[si_], s0i = st_im[si_], lr = lbt_l[(h * 64 + p) * 2], li = lbt_l[(h * 64 + p) * 2 + 1];
    const float hr = lr * s0r - li * s0i + xr, hi = lr * s0i + li * s0r + xi;
    out[OFF_SRS + si_] = hr; out[OFF_SIS + si_] = hi;
    float yv = 0.f;
#pragma unroll
    for (int c = 0; c < 16; ++c) { float t = c_re_l[((size_t)(h * 16 + c)) * 64 + p] * hr - c_im_l[((size_t)(h * 16 + c)) * 64 + p] * hi; t = wave_sum(t); t += d_l[h * 16 + c] * u[c]; yv = (lane == c) ? t : yv; }
    if (lane < 16) yb[(size_t)(MP + b) * TOKW + h * 16 + lane] = (bf16)(pk2(gelu_t(yv), 0.f) & 0xffff);
}

#define RLX_AGENT __ATOMIC_RELAXED, __HIP_MEMORY_SCOPE_AGENT
struct Args { const float* in[34]; float* out; unsigned char* ws; int lo, hi; };
__global__ void __launch_bounds__(NTHR, 2) trunk_fwd(Args args) {
    extern __shared__ __attribute__((aligned(16))) unsigned char lds_raw[];
    LAS unsigned char* lds = (LAS unsigned char*)lds_raw;
    volatile LAS unsigned* MISC = (volatile LAS unsigned*)(lds + MISC_OFF);
    const int G = gridDim.x, blk = blockIdx.x;
    const Args* ap = &args;
#define ws (ap->ws)
#define out (ap->out)
#define x_prompt (ap->in[0])
#define x_sample (ap->in[1])
#define mem_prompt (ap->in[2])
#define cache_k (ap->in[3])
#define cache_v (ap->in[4])
#define st_re (ap->in[5])
#define st_im (ap->in[6])
#define st_conv (ap->in[7])
#define g_mix (ap->in[8])
#define g_ffn (ap->in[9])
#define g_mem (ap->in[10])
#define g_final (ap->in[11])
#define w_mem_kv (ap->in[12])
#define sg_w_in (ap->in[13])
#define sg_w_out (ap->in[14])
#define sg_g_v (ap->in[15])
#define sg_w_s (ap->in[16])
#define sg_b_s (ap->in[17])
#define ssm_w_in (ap->in[18])
#define ssm_w_out (ap->in[19])
#define lam_re (ap->in[20])
#define lam_im (ap->in[21])
#define log_dt (ap->in[22])
#define b_re (ap->in[23])
#define b_im (ap->in[24])
#define c_re (ap->in[25])
#define c_im (ap->in[26])
#define ssm_d (ap->in[27])
#define w_glu (ap->in[28])
#define b_glu (ap->in[29])
#define w_up (ap->in[30])
#define conv_w (ap->in[31])
#define conv_b (ap->in[32])
#define w_down (ap->in[33])
#define ctl ((unsigned*)(ws + WS_CTL))
#define SSX ((ssq_t*)(ws + CTL_SSX))
#define SSV ((ssq_t*)(ws + CTL_SSV))
#define SSMEM ((ssq_t*)(ws + CTL_SSMEM))
#define W_SGIN ((bf16*)(ws + WS_WSGIN))
#define W_SSMIN ((bf16*)(ws + WS_WSSMIN))
#define W_SGOUT ((bf16*)(ws + WS_WSGOUT))
#define W_SSMOUT ((bf16*)(ws + WS_WSSMOUT))
#define W_GLU ((bf16*)(ws + WS_WGLU))
#define W_UP ((bf16*)(ws + WS_WUP))
#define W_DOWN ((bf16*)(ws + WS_WDOWN))
#define W_MEM ((bf16*)(ws + WS_WMEM))
#define WSB ((bf16*)(ws + WS_WSB))
#define TB ((bf16*)(ws + WS_TB))
#define BT2 ((bf16*)(ws + WS_BT2))
#define LBT ((float*)(ws + WS_LBT))
#define LB16 ((float*)(ws + WS_LB16))
#define BBART ((float*)(ws + WS_BBAR))
#define XRES ((float*)(ws + WS_XRES))
#define XB ((bf16*)(ws + WS_XB))
#define MEMB ((bf16*)(ws + WS_MEMB))
#define MKV ((bf16*)(ws + WS_MKV))
#define ZU ((bf16*)(ws + WS_ZU))
#define ZV ((bf16*)(ws + WS_ZV))
#define QB ((bf16*)(ws + WS_Q))
#define MIX ((bf16*)(ws + WS_MIX))
#define AG ((bf16*)(ws + WS_AG))
#define YF ((bf16*)(ws + WS_Y))
#define UH ((bf16*)(ws + WS_UH))
#define YB ((bf16*)(ws + WS_YB))
#define US ((float*)(ws + WS_US))
    for (int u = threadIdx.x; u < 128; u += NTHR) MISC[u] = 0u;
    __syncthreads();
    XcdBarrier bar = xcd_barrier_post(ctl + CW_BAR, MISC + 8);
    const int lo = args.lo, hi = args.hi; int ph = 0;
#ifndef PHM
#define PHM 0xFFFFFFFFu
#endif
#define PH_BEGIN(k) if (((PHM >> (k)) & 1u) && ph >= lo && ph < hi) { unsigned z_; asm volatile("s_mov_b32 %0, 0" : "=s"(z_)); const Args* ap = (const Args*)((const char*)&args + z_); int tid = threadIdx.x; asm volatile("" : "+v"(tid)); const int lane = tid & 63, wave = __builtin_amdgcn_readfirstlane(tid >> 6); const int gw = blk * NWAVES + wave, NGW = G * NWAVES, gtid = blk * NTHR + tid, NT = G * NTHR; (void)lane; (void)gw; (void)NGW; (void)gtid; (void)NT;
#define PH_END do { if (ph >= lo && ph + 1 < hi) xcd_barrier(bar); ++ph; } while (0)

    PH_BEGIN(0)
        LAS float* scr = (LAS float*)(lds + wave * 16384);
#pragma unroll 1
        for (int mat = 0; mat < 22; ++mat) {
            const float* W; const float* gn = nullptr; int K, N; bf16* WT; int roff = 0;
            if (mat < 2) { W = sg_w_in + (size_t)mat * D * SGN; gn = g_mix + (2 * mat) * D; K = D; N = SGN; WT = W_SGIN + (size_t)mat * SGN * D; }
            else if (mat < 4) { const int j = mat - 2; W = ssm_w_in + (size_t)j * D * D; gn = g_mix + (2 * j + 1) * D; K = D; N = D; WT = W_SSMIN + (size_t)j * D * D; }
            else if (mat < 6) { const int j = mat - 4; W = sg_w_out + (size_t)j * D * D; K = D; N = D; WT = W_SGOUT + (size_t)j * D * D; }
            else if (mat < 8) { const int j = mat - 6; W = ssm_w_out + (size_t)j * D * D; K = D; N = D; WT = W_SSMOUT + (size_t)j * D * D; }
            else if (mat < 10) { const int j = mat - 8; W = w_glu + (size_t)j * TOKW * TOKW; K = TOKW; N = TOKW; WT = W_GLU + (size_t)j * TOKW * TOKW; }
            else if (mat < 14) { const int i = mat - 10; W = w_up + (size_t)i * D * NUP; gn = g_ffn + i * D; K = D; N = NUP; WT = W_UP + (size_t)i * NUP * D; }
            else if (mat < 18) { const int i = mat - 14; W = w_down + (size_t)i * DFF * D; K = DFF; N = D; WT = W_DOWN + (size_t)i * D * DFF; }
            else { const int i = mat - 18; W = w_mem_kv + (size_t)i * D * 1024; gn = g_mem + i * D; K = D; N = 1024; WT = W_MEM; roff = i * 1024; }
            const int nitems = (K / 64) * (N / 32);
#pragma unroll 1
            for (int it = gw; it < nitems; it += NGW) p0_transpose_item(W, gn, K, N, WT, roff, scr, it, lane);
        }
        for (int e = gtid; e < 2 * 12 * 128 * 128 / 4; e += NT) { const int e4 = e * 4, s = e4 & 127, t = (e4 >> 7) & 127; const f32x4 wv = *(const f32x4*)(sg_w_s + e4);
            v2u o; o.x = pk2(s <= t ? wv[0] : 0.f, s + 1 <= t ? wv[1] : 0.f); o.y = pk2(s + 2 <= t ? wv[2] : 0.f, s + 3 <= t ? wv[3] : 0.f); *(v2u*)(WSB + e4) = o; }
        for (int r = gw; r < MT + MMEM; r += NGW) {
            if (r < MT) { const float* src = r < MP ? x_prompt + (size_t)r * D : (r < MREAL ? x_sample + (size_t)(r - MP) * D : nullptr); p0_row(src, XRES + (size_t)r * D, XB + (size_t)r * D, SSX + r, lane); }
            else { const int m = r - MT; p0_row(mem_prompt + (size_t)m * D, nullptr, MEMB + (size_t)m * D, SSMEM + m, lane); }
        }
        __syncthreads();
        for (int un = blk; un < 2 * NGRP; un += G) { const int j = un / NGRP, h = un % NGRP;
            s5_tables((LAS float*)lds, j, h, lam_re, lam_im, log_dt, b_re, b_im, c_re, c_im, ssm_d, TB, BT2, LBT, LB16, BBART, tid); }
    }
    PH_END;
    PH_BEGIN(1)
        pg8::Gemm g{MEMB, W_MEM, MMEM, 4096, D}; pg8::StaticOrder S; S.init(MMEM, 4096, G, blk);
        EpiMem E{SSMEM, out, MKV};
        pg8::gemm_phase<EpiMem, pg8::StaticOrder, true, true>(lds, g, S, E);
    }
    PH_END;
#pragma unroll 1
    for (int li = 0; li < 4; ++li) {
        const int j = li >> 1;
        const ssq_t* ss_mix = SSX + (size_t)(2 * li) * MT; ssq_t* ss_ffn = SSX + (size_t)(2 * li + 1) * MT; ssq_t* ss_next = SSX + (size_t)(2 * li + 2) * MT;
        const bf16* mkv_l = MKV + (size_t)li * 1024 * 1024;
        if ((li & 1) == 0) {
            PH_BEGIN(2)
                pg8::Gemm g{XB, W_SGIN + (size_t)j * SGN * D, MT, SGN, D}; pg8::StaticOrder S; S.init(MT, SGN, G, blk);
                EpiSgIn E{ss_mix, ZU, ZV, QB, SSV + (size_t)j * MT};
                pg8::gemm_phase<EpiSgIn, pg8::StaticOrder, true, true>(lds, g, S, E);
            }
            PH_END;
            PH_BEGIN(3)
                const ssq_t* ssv = SSV + (size_t)j * MT; const float* gv = sg_g_v + j * TOKW;
#pragma unroll 1
                for (int un = blk; un < 768; un += G) sg_unit(lds, ZU, ZV, ssv, gv, WSB + (size_t)j * 12 * 128 * 128, sg_b_s + j * 12 * 128, MIX, un, tid);
#pragma unroll 1
                for (int un = blk; un < 256; un += G) attn_prompt_unit(lds, QB, mkv_l, MIX, un, tid);
#pragma unroll 1
                for (int un = blk; un < 256; un += G) attn_sample_unit(lds, QB, cache_k, cache_v, MIX, li, un, tid);
                for (int e = gtid; e < MS * TOKW / 8; e += NT) { const int b = e / 192, c = (e % 192) * 8, g = c >> 7, r = MP + b;
                    const float rsv = rstd_of(ssv[r], 1.f / 1536.f); const v4u vw = *(const v4u*)(ZV + (size_t)r * TOKW + c), uw = *(const v4u*)(ZU + (size_t)r * TOKW + c);
                    const f32x4 g0 = *(const f32x4*)(gv + c), g1 = *(const f32x4*)(gv + c + 4);
                    const f32x4 n0 = (f32x4){bflo(vw.x) * rsv * g0[0], bfhi(vw.x) * rsv * g0[1], bflo(vw.y) * rsv * g0[2], bfhi(vw.y) * rsv * g0[3]};
                    const f32x4 n1 = (f32x4){bflo(vw.z) * rsv * g1[0], bfhi(vw.z) * rsv * g1[1], bflo(vw.w) * rsv * g1[2], bfhi(vw.w) * rsv * g1[3]};
                    float* so = out + OFF_SGV + (size_t)(j * MS + b) * TOKW + c; *(f32x4*)so = n0; *(f32x4*)(so + 4) = n1;
                    const float w00 = sg_w_s[((size_t)(j * 12 + g) * 128) * 128], bs = sg_b_s[(j * 12 + g) * 128];
                    const f32x4 t0 = (f32x4){bflo(uw.x), bfhi(uw.x), bflo(uw.y), bfhi(uw.y)} * (n0 * w00 + bs), t1 = (f32x4){bflo(uw.z), bfhi(uw.z), bflo(uw.w), bfhi(uw.w)} * (n1 * w00 + bs);
                    *(v4u*)(MIX + (size_t)r * D + c) = pack8(t0, t1); }
            }
            PH_END;
        } else {
            PH_BEGIN(4)
                pg8::Gemm g{XB, W_SSMIN + (size_t)j * D * D, MT, D, D}; pg8::StaticOrder S; S.init(MT, D, G, blk);
                EpiSsmIn E{ss_mix, UH, US, QB};
                pg8::gemm_phase<EpiSsmIn, pg8::StaticOrder, true, true>(lds, g, S, E);
            }
            PH_END;
            PH_BEGIN(5)
#pragma unroll 1
                for (int tk = blk; tk < 4 * NGRP; tk += G) s5_state_task(lds, UH, BT2 + (size_t)j * NGRP * 128 * 256, LB16 + (size_t)j * NGRP * 64 * 2, out, j, tk, tid);
#pragma unroll 1
                for (int tk = gw; tk < MS * NGRP; tk += NGW)
                    s5_sample_task(US, st_re, st_im, LBT + (size_t)j * NGRP * 64 * 2, BBART + (size_t)j * NGRP * 64 * 32, c_re + (size_t)j * NGRP * 1024, c_im + (size_t)j * NGRP * 1024, ssm_d + j * TOKW, out, YB, j, tk, lane);
#pragma unroll 1
                for (int un = blk; un < 256; un += G) attn_prompt_unit(lds, QB, mkv_l, MIX, un, tid);
#pragma unroll 1
                for (int un = blk; un < 256; un += G) attn_sample_unit(lds, QB, cache_k, cache_v, MIX, li, un, tid);
            }
            PH_END;
            PH_BEGIN(6)
                int kh = KH; asm volatile("" : "+s"(kh)); pg8::Gemm g{UH, TB + (size_t)j * NGRP * 256 * KH, NGRP * 512, NGRP * 256, kh}; ToepOrder S{G, blk};
                EpiToep E{YB};
                pg8::gemm_phase<EpiToep, ToepOrder, true, true>(lds, g, S, E);
            }
            PH_END;
            PH_BEGIN(7)
                pg8::Gemm g{YB, W_GLU + (size_t)j * TOKW * TOKW, MT, TOKW, TOKW}; pg8::StaticOrder S; S.init(MT, TOKW, G, blk);
                EpiGlu E{YB, b_glu + j * TOKW, MIX};
                pg8::gemm_phase<EpiGlu, pg8::StaticOrder, true, true>(lds, g, S, E);
            }
            PH_END;
        }
        PH_BEGIN(8)
            const bf16* wo = (li & 1) ? W_SSMOUT + (size_t)j * D * D : W_SGOUT + (size_t)j * D * D;
            pg8::Gemm g{MIX, wo, MT, D, D}; pg8::StaticOrder S; S.init(MT, D, G, blk);
            EpiRes E{XRES, XB, ss_ffn};
            pg8::gemm_phase<EpiRes, pg8::StaticOrder, true, true>(lds, g, S, E);
        }
        PH_END;
        PH_BEGIN(9)
            pg8::Gemm g{XB, W_UP + (size_t)li * NUP * D, MT, NUP, D}; pg8::StaticOrder S; S.init(MT, NUP, G, blk);
            EpiUp E{ss_ffn, AG, out, li};
            pg8::gemm_phase<EpiUp, pg8::StaticOrder, true, true>(lds, g, S, E);
        }
        PH_END;
        PH_BEGIN(10)
            const float* cw = conv_w + (size_t)li * 3 * DFF; const float* cb = conv_b + (size_t)li * DFF;
#pragma unroll 1
            for (int e = gtid; e < MT * (DFF / 8); e += NT) {
                const int r = e / (DFF / 8), c = (e % (DFF / 8)) * 8;
                const v4u a0w = *(const v4u*)(AG + (size_t)r * NUP + c), gw_ = *(const v4u*)(AG + (size_t)r * NUP + DFF + c);
                float a1[8], a2[8];
                if (r < MP) { const int t = r & (SEQ - 1); v4u w1 = (v4u){0u, 0u, 0u, 0u}, w2 = (v4u){0u, 0u, 0u, 0u};
                    if (t >= 1) w1 = *(const v4u*)(AG + (size_t)(r - 1) * NUP + c); if (t >= 2) w2 = *(const v4u*)(AG + (size_t)(r - 2) * NUP + c);
                    a1[0] = bflo(w1.x); a1[1] = bfhi(w1.x); a1[2] = bflo(w1.y); a1[3] = bfhi(w1.y); a1[4] = bflo(w1.z); a1[5] = bfhi(w1.z); a1[6] = bflo(w1.w); a1[7] = bfhi(w1.w);
                    a2[0] = bflo(w2.x); a2[1] = bfhi(w2.x); a2[2] = bflo(w2.y); a2[3] = bfhi(w2.y); a2[4] = bflo(w2.z); a2[5] = bfhi(w2.z); a2[6] = bflo(w2.w); a2[7] = bfhi(w2.w); }
                else if (r < MREAL) { const int b = r - MP; const float* p2 = st_conv + ((size_t)(li * MS + b) * 2) * DFF + c; const float* p1 = p2 + DFF;
                    const f32x4 x0 = *(const f32x4*)p2, x1 = *(const f32x4*)(p2 + 4), y0 = *(const f32x4*)p1, y1 = *(const f32x4*)(p1 + 4);
                    a2[0] = x0[0]; a2[1] = x0[1]; a2[2] = x0[2]; a2[3] = x0[3]; a2[4] = x1[0]; a2[5] = x1[1]; a2[6] = x1[2]; a2[7] = x1[3];
                    a1[0] = y0[0]; a1[1] = y0[1]; a1[2] = y0[2]; a1[3] = y0[3]; a1[4] = y1[0]; a1[5] = y1[1]; a1[6] = y1[2]; a1[7] = y1[3];
                    float* co = out + OFF_CONVS + ((size_t)(li * MS + b) * 2) * DFF + c; *(f32x4*)co = y0; *(f32x4*)(co + 4) = y1; }
                else {
#pragma unroll
                    for (int i = 0; i < 8; ++i) { a1[i] = 0.f; a2[i] = 0.f; } }
                const float a0[8] = {bflo(a0w.x), bfhi(a0w.x), bflo(a0w.y), bfhi(a0w.y), bflo(a0w.z), bfhi(a0w.z), bflo(a0w.w), bfhi(a0w.w)};
                const float gg[8] = {bflo(gw_.x), bfhi(gw_.x), bflo(gw_.y), bfhi(gw_.y), bflo(gw_.z), bfhi(gw_.z), bflo(gw_.w), bfhi(gw_.w)};
                float yv[8];
#pragma unroll
                for (int h2 = 0; h2 < 2; ++h2) { const f32x4 k0 = *(const f32x4*)(cw + c + 4 * h2), k1 = *(const f32x4*)(cw + DFF + c + 4 * h2), k2 = *(const f32x4*)(cw + 2 * DFF + c + 4 * h2), kb = *(const f32x4*)(cb + c + 4 * h2);
#pragma unroll
                    for (int i = 0; i < 4; ++i) { const int q = 4 * h2 + i; const float cc = kb[i] + k0[i] * a2[q] + k1[i] * a1[q] + k2[i] * a0[q]; yv[q] = cc * sigmoid_f(cc) * gg[q]; } }
                v4u ow; ow.x = pk2(yv[0], yv[1]); ow.y = pk2(yv[2], yv[3]); ow.z = pk2(yv[4], yv[5]); ow.w = pk2(yv[6], yv[7]);
                *(v4u*)(YF + (size_t)r * DFF + c) = ow;
            }
        }
        PH_END;
        PH_BEGIN(11)
            pg8::Gemm g{YF, W_DOWN + (size_t)li * D * DFF, MT, D, DFF}; pg8::StaticOrder S; S.init(MT, D, G, blk);
            EpiRes E{XRES, XB, ss_next};
            pg8::gemm_phase<EpiRes, pg8::StaticOrder, true, true>(lds, g, S, E);
        }
        PH_END;
    }
    PH_BEGIN(12)
#pragma unroll 1
        for (int r = gw; r < MREAL; r += NGW) {
            const f32x4* xr = (const f32x4*)(XRES + (size_t)r * D); f32x4 v[8]; float s = 0.f;
#pragma unroll
            for (int jj = 0; jj < 8; ++jj) { v[jj] = xr[lane + 64 * jj]; s += dot4(v[jj]); }
            const float rs = rsqrtf(wave_sum(s) * (1.f / 2048.f) + EPS);
            f32x4* o = (f32x4*)(out + (r < MP ? OFF_YP + (size_t)r * D : OFF_YS + (size_t)(r - MP) * D));
#pragma unroll
            for (int jj = 0; jj < 8; ++jj) o[lane + 64 * jj] = v[jj] * rs * ((const f32x4*)g_final)[lane + 64 * jj];
        }
    }
    PH_END;
#undef PH_BEGIN
#undef PH_END
}
#undef x_prompt
#undef x_sample
#undef mem_prompt
#undef cache_k
#undef cache_v
#undef st_re
#undef st_im
#undef st_conv
#undef g_mix
#undef g_ffn
#undef g_mem
#undef g_final
#undef w_mem_kv
#undef sg_w_in
#undef sg_w_out
#undef sg_g_v
#undef sg_w_s
#undef sg_b_s
#undef ssm_w_in
#undef ssm_w_out
#undef lam_re
#undef lam_im
#undef log_dt
#undef b_re
#undef b_im
#undef c_re
#undef c_im
#undef ssm_d
#undef w_glu
#undef b_glu
#undef w_up
#undef conv_w
#undef conv_b
#undef w_down
#undef ctl
#undef SSX
#undef SSV
#undef SSMEM
#undef W_SGIN
#undef W_SSMIN
#undef W_SGOUT
#undef W_SSMOUT
#undef W_GLU
#undef W_UP
#undef W_DOWN
#undef W_MEM
#undef WSB
#undef TB
#undef BT2
#undef LBT
#undef LB16
#undef BBART
#undef XRES
#undef XB
#undef MEMB
#undef MKV
#undef ZU
#undef ZV
#undef QB
#undef MIX
#undef AG
#undef YF
#undef UH
#undef YB
#undef US
#undef ws
#undef out

#ifndef MK_ONE_LAUNCH
#define MK_ONE_LAUNCH 1
#endif
extern "C" void kernel_launch(void* const* d_in, const int* in_sizes, int n_in, void* d_out, int out_size, void* d_ws, size_t ws_size, hipStream_t stream) {
    static int grid = 0;
    if (grid == 0) {
        if (n_in != 34 || (size_t)out_size != OUT_TOTAL || ws_size < WS_END) { fprintf(stderr, "kernel_launch: unexpected shapes (n_in %d, out %d, ws %zu)\n", n_in, out_size, ws_size); grid = -1; return; }
        int dev = 0, cus = 0;
        if (hipGetDevice(&dev) != hipSuccess || hipDeviceGetAttribute(&cus, hipDeviceAttributeMultiprocessorCount, dev) != hipSuccess) { grid = -1; return; }
        if (hipFuncSetAttribute((const void*)trunk_fwd, hipFuncAttributeMaxDynamicSharedMemorySize, LDS_BYTES) != hipSuccess) { fprintf(stderr, "kernel_launch: hipFuncSetAttribute failed\n"); grid = -1; return; }
        int per_cu = 0;
        if (hipOccupancyMaxActiveBlocksPerMultiprocessor(&per_cu, (const void*)trunk_fwd, NTHR, LDS_BYTES) != hipSuccess || per_cu < 1) fprintf(stderr, "kernel_launch: occupancy query says %d\n", per_cu);
        (void)hipGetLastError();
        grid = cus;
    }
    if (grid < 0) return;
    if (hipMemsetAsync((char*)d_ws + WS_CTL, 0, CTL_ZERO_BYTES, stream) != hipSuccess) return;
    Args a{};
    for (int i = 0; i < 34; ++i) a.in[i] = (const float*)d_in[i];
    a.out = (float*)d_out; a.ws = (unsigned char*)d_ws;
#if MK_ONE_LAUNCH
    a.lo = 0; a.hi = NPHASE;
    hipLaunchKernelGGL(trunk_fwd, dim3(grid), dim3(NTHR), LDS_BYTES, stream, a);
#else
    for (int p = 0; p < NPHASE; ++p) { a.lo = p; a.hi = p + 1; hipLaunchKernelGGL(trunk_fwd, dim3(grid), dim3(NTHR), LDS_BYTES, stream, a); }
#endif
#ifdef OUTMASK
    {
        const size_t offs[12] = {OFF_YP, OFF_YS, OFF_MK, OFF_MV, OFF_SRP, OFF_SIP, OFF_CONVP, OFF_SRS, OFF_SIS, OFF_CONVS, OFF_SGV, OUT_TOTAL};
        for (int i = 0; i < 11; ++i) if (!((OUTMASK >> i) & 1)) (void)hipMemsetAsync((float*)d_out + offs[i], 0, (offs[i + 1] - offs[i]) * 4, stream);
    }
#endif
}
```

```cpp
#include <hip/hip_runtime.h>
#include <cstdio>
#include <cstdint>
namespace pg8 {
#define PG8_LAS __attribute__((address_space(3)))
typedef unsigned short bf16_t;
typedef short bf16x8 __attribute__((ext_vector_type(8)));
typedef float f32x4 __attribute__((ext_vector_type(4)));
typedef unsigned u32x4 __attribute__((ext_vector_type(4)));
constexpr int BM = 256, BK = 64, HALF = 128, HTB = HALF * BK * 2  , STAGE_BYTES = 8 * HTB, NXCD = 8, WGM = 8;

__host__ __device__ __forceinline__ int lds_byte(int r, int c) { const int st = (r >> 4) * 2 + (c >> 5), rr = r & 15, cc = c & 31, ob = rr * 64 + cc * 2; return st * 1024 + (ob ^ (((ob >> 9) & 1) << 5)); }
__host__ __device__ __forceinline__ void stage_rc(int b, int& R, int& C) { const int st = b / 1024, sb = b % 1024, swz = sb ^ (((sb >> 9) & 1) << 5); R = (st >> 1) * 16 + swz / 64; C = (st & 1) * 32 + (swz % 64) / 2; }
__host__ __device__ __forceinline__ int perm32(int rho) { const int n = rho >> 4, i = rho & 15; return 8 * (i >> 2) + 4 * n + (i & 3); }

struct Unit { int pm, pn; };
struct Gemm { const bf16_t* A; const bf16_t* Bt; int M, N, K; };

struct StaticOrder {
    int nM, nN, nwg, G, c;
    __host__ __device__ void init(int M, int N, int G_, int c_) { nM = M / BM; nN = N / BM; nwg = nM * nN; G = G_; c = c_; }
    __host__ __device__ bool next(int i, Unit& u) const {
        const long L = (long)i * G + c; if (L >= nwg) return false;
        int wgid = (int)L; { const int q = nwg / NXCD, r = nwg % NXCD, xcd = wgid % NXCD, off = wgid / NXCD; wgid = (xcd < r ? xcd * (q + 1) : r * (q + 1) + (xcd - r) * q) + off; }
        const int nig = WGM * nN, gid = wgid / nig, fm = gid * WGM, gsz = (nM - fm) < WGM ? (nM - fm) : WGM;
        u.pm = fm + ((wgid % nig) % gsz); u.pn = (wgid % nig) / gsz; return true;
    }
    __device__ __forceinline__ void a_ready(const Unit&) const {}
    __device__ __forceinline__ void done(const Unit&) const {}
};
__device__ __forceinline__ unsigned cvt_pk_bf16(float lo, float hi) { unsigned r; asm volatile("v_cvt_pk_bf16_f32 %0, %1, %2" : "=v"(r) : "v"(lo), "v"(hi)); return r; }
typedef float f32x2 __attribute__((ext_vector_type(2)));
template <class Epi, class Sched, bool ALIGN_EPI = false, bool SP2 = false>
__device__ __forceinline__ void gemm_phase(PG8_LAS unsigned char* lds, const Gemm g, const Sched& S, const Epi& E) {
    int tid = threadIdx.x; asm volatile("" : "+v"(tid)); const int wid = __builtin_amdgcn_readfirstlane(tid >> 6), lane = tid & 63, wr = wid >> 2, wc = wid & 3, fr = lane & 15, fq = lane >> 4;
    const int K = g.K, nt = K / BK;
    unsigned voffA[2], voffB[2];
#pragma unroll
    for (int i = 0; i < 2; ++i) { int R, C; stage_rc(tid * 16 + i * 8192, R, C); const int Rb = Epi::PERM ? ((R & ~31) + perm32(R & 31)) : R;
        voffA[i] = (unsigned)(R * K + C) * 2u; voffB[i] = (unsigned)(Rb * K + C) * 2u; }
    const size_t kstep = (size_t)(BK * 2);
    const size_t hstep = (size_t)HALF * K * 2;
    const size_t tstep = 2 * hstep;
    const unsigned ldsw = (unsigned)wid * 1024u;
    const int aoff = lds_byte(wr * 64 + fr, fq * 8), boff = lds_byte(wc * 32 + fr, fq * 8);
#define PG8_SA(b, h) (((b) * 2 + (h)) * HTB)
#define PG8_SB(b, h) ((4 + (b) * 2 + (h)) * HTB)
#define PG8_STAGE(bufoff, gbase, voff) do { _Pragma("unroll") for (int _i = 0; _i < 2; ++_i) \
        __builtin_amdgcn_global_load_lds((const unsigned*)((const char*)(gbase) + (voff)[_i]), (PG8_LAS unsigned*)(lds + (bufoff) + ldsw + _i * 8192), 16, 0, 0); } while (0)
#define PG8_LDA(dst, b, h) do { _Pragma("unroll") for (int m = 0; m < 4; ++m) _Pragma("unroll") for (int k = 0; k < 2; ++k) dst[m][k] = *(const PG8_LAS bf16x8*)(lds + PG8_SA(b, h) + aoff + m * 2048 + k * 1024); } while (0)
#define PG8_LDB(dst, b, h) do { _Pragma("unroll") for (int n = 0; n < 2; ++n) _Pragma("unroll") for (int k = 0; k < 2; ++k) dst[n][k] = *(const PG8_LAS bf16x8*)(lds + PG8_SB(b, h) + boff + n * 2048 + k * 1024); } while (0)
#define PG8_MMA(ai, bj, At, Bt) do { __builtin_amdgcn_s_setprio(1); _Pragma("unroll") for (int m = 0; m < 4; ++m) _Pragma("unroll") for (int n = 0; n < 2; ++n) _Pragma("unroll") for (int k = 0; k < 2; ++k) \
        acc[ai][bj][m][n] = __builtin_amdgcn_mfma_f32_16x16x32_bf16(Bt[n][k], At[m][k], acc[ai][bj][m][n], 0, 0, 0); __builtin_amdgcn_s_setprio(0); } while (0)
#define PG8_WAIT_V(n) asm volatile("s_waitcnt vmcnt(" #n ")" ::: "memory")
#define PG8_WAIT_L(n) asm volatile("s_waitcnt lgkmcnt(" #n ")" ::: "memory")
#define PG8_BAR __builtin_amdgcn_s_barrier()
#define PG8_SCHED __builtin_amdgcn_sched_barrier(0)
    Unit cur, nxt; int ui = 0;
    if (!S.next(0, cur)) return;
    f32x4 acc[2][2][4][2];
#pragma unroll
    for (int a = 0; a < 2; ++a)
#pragma unroll
        for (int b = 0; b < 2; ++b)
#pragma unroll
            for (int m = 0; m < 4; ++m)
#pragma unroll
                for (int n = 0; n < 2; ++n) acc[a][b][m][n] = (f32x4){0.f, 0.f, 0.f, 0.f};
    bf16x8 At[4][2], B0[2][2], B1[2][2];
    const char* cA = (const char*)g.A + (size_t)cur.pm * tstep; const char* cB = (const char*)g.Bt + (size_t)cur.pn * tstep;
    S.a_ready(cur);
    if constexpr (SP2) {
        PG8_STAGE(PG8_SB(0, 0), cB, voffB); PG8_STAGE(PG8_SB(0, 1), cB + hstep, voffB); PG8_STAGE(PG8_SA(0, 0), cA, voffA); PG8_STAGE(PG8_SA(0, 1), cA + hstep, voffA);
        if (wr == 1) PG8_BAR;
        PG8_WAIT_V(2); PG8_BAR;
        PG8_STAGE(PG8_SB(1, 0), cB + kstep, voffB); PG8_STAGE(PG8_SA(1, 0), cA + kstep, voffA); PG8_STAGE(PG8_SB(1, 1), cB + hstep + kstep, voffB);
        PG8_WAIT_V(6); PG8_BAR;
    } else {
        PG8_STAGE(PG8_SB(0, 0), cB, voffB); PG8_STAGE(PG8_SA(0, 0), cA, voffA); PG8_STAGE(PG8_SB(0, 1), cB + hstep, voffB); PG8_STAGE(PG8_SA(0, 1), cA + hstep, voffA);
        if (wr == 1) PG8_BAR;
        PG8_WAIT_V(4); PG8_BAR;
        PG8_STAGE(PG8_SB(1, 0), cB + kstep, voffB); PG8_STAGE(PG8_SA(1, 0), cA + kstep, voffA); PG8_STAGE(PG8_SB(1, 1), cB + hstep + kstep, voffB);
        PG8_WAIT_V(6); PG8_BAR;
    }
    for (;;) {
        const bool has_next = S.next(ui + 1, nxt);
        const char* nA = has_next ? (const char*)g.A + (size_t)nxt.pm * tstep : cA; const char* nB = has_next ? (const char*)g.Bt + (size_t)nxt.pn * tstep : cB;
        for (int t = 0; t < nt; t += 2) {
            const bool last = (t == nt - 2);
            const char* a1 = cA + (size_t)(t + 1) * kstep;
            const char* a2 = last ? nA : cA + (size_t)(t + 2) * kstep; const char* b2 = last ? nB : cB + (size_t)(t + 2) * kstep;
            const char* a3 = a2 + kstep; const char* b3 = b2 + kstep;
            if (last && has_next) S.a_ready(nxt);
            if constexpr (SP2) {
            PG8_LDB(B0, 0, 0); PG8_LDB(B1, 0, 1); PG8_SCHED; PG8_LDA(At, 0, 0); PG8_STAGE(PG8_SA(1, 1), a1 + hstep, voffA);
            PG8_WAIT_V(8); PG8_WAIT_L(0); PG8_BAR; PG8_MMA(0, 0, At, B0); PG8_MMA(0, 1, At, B1); PG8_BAR; PG8_SCHED;
            PG8_LDA(At, 0, 1); PG8_STAGE(PG8_SB(0, 0), b2, voffB); PG8_STAGE(PG8_SB(0, 1), b2 + hstep, voffB); PG8_STAGE(PG8_SA(0, 0), a2, voffA);
            PG8_WAIT_V(8); PG8_WAIT_L(0); PG8_BAR; PG8_MMA(1, 0, At, B0); PG8_MMA(1, 1, At, B1); PG8_BAR; PG8_SCHED;
            PG8_LDB(B0, 1, 0); PG8_LDB(B1, 1, 1); PG8_SCHED; PG8_LDA(At, 1, 0); PG8_STAGE(PG8_SA(0, 1), a2 + hstep, voffA);
            PG8_WAIT_V(8); PG8_WAIT_L(0); PG8_BAR; PG8_MMA(0, 0, At, B0); PG8_MMA(0, 1, At, B1); PG8_BAR; PG8_SCHED;
            PG8_LDA(At, 1, 1); PG8_STAGE(PG8_SB(1, 0), b3, voffB); PG8_STAGE(PG8_SB(1, 1), b3 + hstep, voffB); PG8_STAGE(PG8_SA(1, 0), a3, voffA);
            PG8_WAIT_V(8); PG8_WAIT_L(0); PG8_BAR; PG8_MMA(1, 0, At, B0); PG8_MMA(1, 1, At, B1); PG8_BAR; PG8_SCHED;
            } else {
            PG8_LDB(B0, 0, 0); PG8_SCHED; PG8_LDA(At, 0, 0); PG8_STAGE(PG8_SA(1, 1), a1 + hstep, voffA);
            PG8_WAIT_L(8); PG8_BAR; PG8_WAIT_L(0); PG8_MMA(0, 0, At, B0); PG8_BAR; PG8_SCHED;
            PG8_LDB(B1, 0, 1); PG8_STAGE(PG8_SB(0, 0), b2, voffB);
            PG8_BAR; PG8_WAIT_L(0); PG8_MMA(0, 1, At, B1); PG8_BAR;
            PG8_LDA(At, 0, 1); PG8_STAGE(PG8_SA(0, 0), a2, voffA);
            PG8_BAR; PG8_WAIT_L(0); PG8_MMA(1, 0, At, B0); PG8_BAR; PG8_SCHED;
            PG8_STAGE(PG8_SB(0, 1), b2 + hstep, voffB);
            PG8_WAIT_V(6); PG8_BAR; PG8_MMA(1, 1, At, B1); PG8_BAR;
            PG8_LDB(B0, 1, 0); PG8_SCHED; PG8_LDA(At, 1, 0); PG8_STAGE(PG8_SA(0, 1), a2 + hstep, voffA);
            PG8_WAIT_L(8); PG8_BAR; PG8_WAIT_L(0); PG8_MMA(0, 0, At, B0); PG8_BAR; PG8_SCHED;
            PG8_LDB(B1, 1, 1); PG8_STAGE(PG8_SB(1, 0), b3, voffB);
            PG8_BAR; PG8_WAIT_L(0); PG8_MMA(0, 1, At, B1); PG8_BAR;
            PG8_LDA(At, 1, 1); PG8_STAGE(PG8_SA(1, 0), a3, voffA);
            PG8_BAR; PG8_WAIT_L(0); PG8_MMA(1, 0, At, B0); PG8_BAR; PG8_SCHED;
            PG8_STAGE(PG8_SB(1, 1), b3 + hstep, voffB);
            PG8_WAIT_V(6); PG8_BAR; PG8_MMA(1, 1, At, B1); PG8_BAR;
            }
        }
        if constexpr (ALIGN_EPI) { if (wr == 0) PG8_BAR; }
        if constexpr (!Epi::AFTER_DRAIN) { E(acc, cur, wr, wc, fr, fq); S.done(cur); }
        if (!has_next) break;
#pragma unroll
        for (int a = 0; a < 2; ++a)
#pragma unroll
            for (int b = 0; b < 2; ++b)
#pragma unroll
                for (int m = 0; m < 4; ++m)
#pragma unroll
                    for (int n = 0; n < 2; ++n) acc[a][b][m][n] = (f32x4){0.f, 0.f, 0.f, 0.f};
        cur = nxt; cA = nA; cB = nB; ++ui;
        if constexpr (ALIGN_EPI) { if (wr == 1) PG8_BAR; }
    }
    PG8_WAIT_V(0);
    if constexpr (!ALIGN_EPI) { if (wr == 0) PG8_BAR; }
    PG8_BAR;
    if constexpr (Epi::AFTER_DRAIN) { E.fused(acc, cur, wr, wc, fr, fq, lds, wid, lane); S.done(cur); }
#undef PG8_SA
#undef PG8_SB
#undef PG8_STAGE
#undef PG8_LDA
#undef PG8_LDB
#undef PG8_MMA
#undef PG8_WAIT_V
#undef PG8_WAIT_L
#undef PG8_BAR
#undef PG8_SCHED
}
}
#define LAS_BAR __attribute__((address_space(3)))
#define XB_TMO      128
#define XB_XCNT(j)  (256  + 64 * (j))
#define XB_XSUB(j)  (1280 + 64 * (j))
#define XB_XGEN(j)  (2304 + 64 * (j))
#define XB_TOP      3328
#define XB_TOPGEN   3392
#define XCD_BAR_WORDS 3456
#define XB_SPIN_CAP (1u << 18)

__device__ __forceinline__ unsigned xb_ld(unsigned* p)              { return __hip_atomic_load(p, __ATOMIC_RELAXED, __HIP_MEMORY_SCOPE_AGENT); }
__device__ __forceinline__ unsigned xb_add(unsigned* p, unsigned v) { return __hip_atomic_fetch_add(p, v, __ATOMIC_RELAXED, __HIP_MEMORY_SCOPE_AGENT); }
__device__ __forceinline__ unsigned xb_xcc_id() { return (unsigned)__builtin_amdgcn_s_getreg((3 << 11) | 20) & 0xFu; }
#define XB_SPIN(cond, bar) do { unsigned _sp = 0; while (cond) { __builtin_amdgcn_s_sleep(1); \
    if ((++_sp & 255u) == 0u) { if (xb_ld(&(bar)[XB_TMO])) break; if (_sp > XB_SPIN_CAP) { atomicAdd(&(bar)[XB_TMO], 1u); break; } } } } while (0)

struct XcdBarrier {
    unsigned* bar; unsigned x;
    volatile LAS_BAR unsigned* st;
};

__device__ __forceinline__ XcdBarrier xcd_barrier_post(unsigned* bar, volatile LAS_BAR unsigned* st) {
    XcdBarrier b; b.bar = bar; b.x = xb_xcc_id(); b.st = st;
    if (threadIdx.x == 0) (void)xb_add(&bar[XB_XCNT(b.x)], 1u);
    return b;
}
__device__ __forceinline__ void xcd_barrier_complete(unsigned* bar, unsigned x, unsigned& nloc, unsigned& nx) {
    const unsigned G = gridDim.x * gridDim.y * gridDim.z;
    unsigned sum, cnt, mine, sp = 0u;
    for (;;) {
        sum = 0u; cnt = 0u; mine = 0u;
#pragma unroll
        for (unsigned j = 0; j < 16; ++j) { const unsigned c = xb_ld(&bar[XB_XCNT(j)]); sum += c; cnt += (c > 0u) ? 1u : 0u; mine = (j == x) ? c : mine; }
        if (sum == G) break;
        __builtin_amdgcn_s_sleep(1);
        if ((++sp & 255u) == 0u) { if (xb_ld(&bar[XB_TMO])) break; if (sp > XB_SPIN_CAP) { atomicAdd(&bar[XB_TMO], 1u); break; } }
    }
    nloc = mine > 0u ? mine : 1u; nx = cnt > 0u ? cnt : 1u;
}

__device__ __forceinline__ void xcd_barrier(const XcdBarrier& b) {
    asm volatile("s_waitcnt vmcnt(0)" ::: "memory");
    __syncthreads();
    if (threadIdx.x == 0) {
        unsigned* bar = b.bar;
        __builtin_amdgcn_s_waitcnt(0);
        unsigned nloc = b.st[0], nx = b.st[1];
        if (nloc == 0u) { xcd_barrier_complete(bar, b.x, nloc, nx); b.st[0] = nloc; b.st[1] = nx; }
        const unsigned old = xb_add(&bar[XB_XSUB(b.x)], 1u);
        const unsigned gen = old / nloc;
        if (old + 1u == (gen + 1u) * nloc) {
            __builtin_amdgcn_fence(__ATOMIC_RELEASE, "agent");
            asm volatile("s_waitcnt vmcnt(0)" ::: "memory");
            const unsigned og = xb_add(&bar[XB_TOP], 1u);
            const unsigned tg = og / nx;
            if (og + 1u == (tg + 1u) * nx) xb_add(&bar[XB_TOPGEN], 1u);
            else XB_SPIN(xb_ld(&bar[XB_TOPGEN]) == tg, bar);
            __builtin_amdgcn_fence(__ATOMIC_ACQUIRE, "agent");
            xb_add(&bar[XB_XGEN(b.x)], 1u);
            asm volatile("s_waitcnt vmcnt(0)" ::: "memory");
        } else {
            XB_SPIN(xb_ld(&bar[XB_XGEN(b.x)]) == gen, bar);
            __builtin_amdgcn_fence(__ATOMIC_ACQUIRE, "agent");
            asm volatile("s_waitcnt vmcnt(0)" ::: "memory");
        }
    }
    __syncthreads();
}
#define GAS __attribute__((address_space(1)))
#define LAS __attribute__((address_space(3)))
typedef unsigned short bf16;
typedef unsigned v4u __attribute__((ext_vector_type(4)));
typedef unsigned v2u __attribute__((ext_vector_type(2)));
typedef float f32x4 __attribute__((ext_vector_type(4)));
typedef short bf16x8 __attribute__((ext_vector_type(8)));
typedef short bf16x4 __attribute__((ext_vector_type(4)));

constexpr int NWAVES = 8, NTHR = 512;
constexpr int D = 2048, SEQ = 2048, MP = 8192, MS = 128, MREAL = 8320, MT = 8448;
constexpr int MMEM = 1024, XAW = 512, TOKW = 1536, SGN = 3584, DFF = 5504, NUP = 11008;
constexpr int NGRP = 96, KH = 384;
constexpr float EPS = 1e-6f;
constexpr int NPHASE = 31;

constexpr size_t OFF_YP = 0, OFF_YS = 16777216, OFF_MK = 17039360, OFF_MV = 19136512, OFF_SRP = 21233664, OFF_SIP = 21282816,
                 OFF_CONVP = 21331968, OFF_SRS = 21508096, OFF_SIS = 23080960, OFF_CONVS = 24653824, OFF_SGV = 30289920, OUT_TOTAL = 30683136;

constexpr size_t MiB = 1u << 20;
constexpr size_t WS_CTL = 0, CTL_ZERO_BYTES = 1 * MiB;
constexpr size_t WS_WSGIN = 1 * MiB;
constexpr size_t WS_WSSMIN = WS_WSGIN + 28 * MiB;
constexpr size_t WS_WSGOUT = WS_WSSMIN + 16 * MiB;
constexpr size_t WS_WSSMOUT = WS_WSGOUT + 16 * MiB;
constexpr size_t WS_WGLU = WS_WSSMOUT + 16 * MiB;
constexpr size_t WS_WUP = WS_WGLU + 9 * MiB;
constexpr size_t WS_WDOWN = WS_WUP + 172 * MiB;
constexpr size_t WS_WMEM = WS_WDOWN + 86 * MiB;
constexpr size_t WS_WSB = WS_WMEM + 16 * MiB;
constexpr size_t WS_TB = WS_WSB + 1 * MiB;
constexpr size_t WS_BT2 = WS_TB + 36 * MiB;
constexpr size_t WS_LBT = WS_BT2 + 12 * MiB;
constexpr size_t WS_LB16 = WS_LBT + 128 * 1024;
constexpr size_t WS_BBAR = WS_LBT + 1 * MiB;
constexpr size_t WS_XRES = WS_BBAR + 2 * MiB;
constexpr size_t WS_XB = WS_XRES + 66 * MiB;
constexpr size_t WS_MEMB = WS_XB + 33 * MiB;
constexpr size_t WS_MKV = WS_MEMB + 4 * MiB;
constexpr size_t WS_ZU = WS_MKV + 8 * MiB;
constexpr size_t WS_ZV = WS_ZU + 25 * MiB;
constexpr size_t WS_Q = WS_ZV + 25 * MiB;
constexpr size_t WS_MIX = WS_Q + 9 * MiB;
constexpr size_t WS_AG = WS_MIX + 33 * MiB;
constexpr size_t WS_Y = WS_AG + 178 * MiB;
constexpr size_t WS_UH = WS_Y + 89 * MiB;
constexpr size_t WS_YB = WS_UH + 36 * MiB;
constexpr size_t WS_US = WS_YB + 25 * MiB;
constexpr size_t WS_END = WS_US + 1 * MiB;
constexpr int CW_BAR = 4096;
typedef unsigned long long ssq_t;
constexpr size_t CTL_SSX = 64 * 1024;
constexpr size_t CTL_SSV = 704 * 1024;
constexpr size_t CTL_SSMEM = 896 * 1024;
static_assert(CTL_SSX + 9 * MT * 8 <= CTL_SSV && CTL_SSV + 2 * MT * 8 <= CTL_SSMEM && CTL_SSMEM + 8192 <= CTL_ZERO_BYTES, "ctl map");

constexpr int LDS_BYTES = 147456, MISC_OFF = LDS_BYTES - 512;

__device__ __forceinline__ unsigned pk2(float lo, float hi) { return pg8::cvt_pk_bf16(lo, hi); }
__device__ __forceinline__ float bflo(unsigned w) { return __uint_as_float(w << 16); }
__device__ __forceinline__ float bfhi(unsigned w) { return __uint_as_float(w & 0xffff0000u); }
__device__ __forceinline__ float gelu_t(float x) { const float e = __builtin_amdgcn_exp2f(x * (-2.3022082f - 0.10294324f * x * x)); return x * __builtin_amdgcn_rcpf(1.f + e); }
__device__ __forceinline__ float sigmoid_f(float x) { return __builtin_amdgcn_rcpf(1.f + __builtin_amdgcn_exp2f(-1.4426950409f * x)); }
__device__ __forceinline__ ssq_t ss_fix(float v) { return (ssq_t)(long long)(v * 1073741824.0f); }
__device__ __forceinline__ float rstd_of(ssq_t ss, float inv_n) { return rsqrtf((float)ss * (1.0f / 1073741824.0f) * inv_n + EPS); }
__device__ __forceinline__ float wave_sum(float v) {
#pragma unroll
    for (int o = 1; o < 64; o <<= 1) v += __shfl_xor(v, o);
    return v;
}
__device__ __forceinline__ float wave_max(float v) {
#pragma unroll
    for (int o = 1; o < 64; o <<= 1) v = fmaxf(v, __shfl_xor(v, o));
    return v;
}
__device__ __forceinline__ void fadd_atomic(ssq_t* p, float v) { atomicAdd(p, ss_fix(v)); }
__device__ __forceinline__ f32x4 gelu4(f32x4 v) { return (f32x4){gelu_t(v[0]), gelu_t(v[1]), gelu_t(v[2]), gelu_t(v[3])}; }
__device__ __forceinline__ v4u pack8(f32x4 a, f32x4 b) { v4u w; w.x = pk2(a[0], a[1]); w.y = pk2(a[2], a[3]); w.z = pk2(b[0], b[1]); w.w = pk2(b[2], b[3]); return w; }
__device__ __forceinline__ float dot4(f32x4 a) { return (a[0] * a[0] + a[1] * a[1]) + (a[2] * a[2] + a[3] * a[3]); }

typedef const f32x4 (&AccRef)[2][2][4][2];
struct EpiSgIn {
    static constexpr bool PERM = true, AFTER_DRAIN = false;
    const ssq_t* ss; bf16* zu; bf16* zv; bf16* q; ssq_t* ssv;
    __device__ __forceinline__ void operator()(AccRef acc, const pg8::Unit& u, int wr, int wc, int fr, int fq) const {
        const int row0 = u.pm * 256 + wr * 64 + fr, colt = u.pn * 256 + wc * 32 + 8 * fq;
        const int kind = u.pn < 6 ? 0 : (u.pn < 12 ? 1 : 2);
#pragma unroll
        for (int ai = 0; ai < 2; ++ai)
#pragma unroll
            for (int m = 0; m < 4; ++m) {
                const int r = row0 + ai * 128 + m * 16; const float rs = rstd_of(ss[r], 1.f / 2048.f); float sq = 0.f;
#pragma unroll
                for (int bj = 0; bj < 2; ++bj) {
                    f32x4 v0 = acc[ai][bj][m][0] * rs, v1 = acc[ai][bj][m][1] * rs; const int c = colt + bj * 128;
                    if (kind < 2) { v0 = gelu4(v0); v1 = gelu4(v1); }
                    if (kind == 1) sq += dot4(v0) + dot4(v1);
                    bf16* dst = kind == 0 ? zu + (size_t)r * TOKW + c : (kind == 1 ? zv + (size_t)r * TOKW + (c - TOKW) : q + (size_t)r * XAW + (c - 2 * TOKW));
                    *(v4u*)dst = pack8(v0, v1);
                }
                if (kind == 1) { sq += __shfl_xor(sq, 16); sq += __shfl_xor(sq, 32); if (fq == 0) fadd_atomic(ssv + r, sq); }
                asm volatile("" ::: "memory");
            }
    }
};
struct EpiRes {
    static constexpr bool PERM = false, AFTER_DRAIN = false;
    float* xres; bf16* xb; ssq_t* ssn;
    __device__ __forceinline__ void operator()(AccRef acc, const pg8::Unit& u, int wr, int wc, int fr, int fq) const {
        const int row0 = u.pm * 256 + wr * 64 + fr, col0 = u.pn * 256 + wc * 32 + 4 * fq;
#pragma unroll
        for (int ai = 0; ai < 2; ++ai)
#pragma unroll
            for (int m = 0; m < 4; ++m) {
                const int r = row0 + ai * 128 + m * 16; float sq = 0.f;
                float* xp = xres + (size_t)r * D + col0; bf16* bp = xb + (size_t)r * D + col0;
#pragma unroll
                for (int bj = 0; bj < 2; ++bj)
#pragma unroll
                    for (int n = 0; n < 2; ++n) { const int off = bj * 128 + n * 16; const f32x4 o = *(const f32x4*)(xp + off) + acc[ai][bj][m][n]; *(f32x4*)(xp + off) = o; sq += dot4(o);
                        v2u w; w.x = pk2(o[0], o[1]); w.y = pk2(o[2], o[3]); *(v2u*)(bp + off) = w; }
                sq += __shfl_xor(sq, 16); sq += __shfl_xor(sq, 32); if (fq == 0) fadd_atomic(ssn + r, sq);
                asm volatile("" ::: "memory");
            }
    }
};
struct EpiUp {
    static constexpr bool PERM = true, AFTER_DRAIN = false;
    const ssq_t* ss; bf16* ag; float* out; int layer;
    __device__ __forceinline__ void operator()(AccRef acc, const pg8::Unit& u, int wr, int wc, int fr, int fq) const {
        const int row0 = u.pm * 256 + wr * 64 + fr, colt = u.pn * 256 + wc * 32 + 8 * fq;
#pragma unroll
        for (int ai = 0; ai < 2; ++ai)
#pragma unroll
            for (int m = 0; m < 4; ++m) {
                const int r = row0 + ai * 128 + m * 16; const float rs = rstd_of(ss[r], 1.f / 2048.f);
#pragma unroll
                for (int bj = 0; bj < 2; ++bj) {
                    const f32x4 v0 = acc[ai][bj][m][0] * rs, v1 = acc[ai][bj][m][1] * rs; const int c = colt + bj * 128;
                    *(v4u*)(ag + (size_t)r * NUP + c) = pack8(v0, v1);
                    if (c < DFF) {
                        float* o = nullptr;
                        if (r < MP) { const int t = r & (SEQ - 1); if (t >= SEQ - 2) o = out + OFF_CONVP + ((size_t)((layer * 4 + (r >> 11)) * 2 + (t - (SEQ - 2)))) * DFF + c; }
                        else if (r < MREAL) o = out + OFF_CONVS + ((size_t)((layer * MS + (r - MP)) * 2 + 1)) * DFF + c;
                        if (o) { *(f32x4*)o = v0; *(f32x4*)(o + 4) = v1; }
                    }
                }
                asm volatile("" ::: "memory");
            }
    }
};
struct EpiSsmIn {
    static constexpr bool PERM = true, AFTER_DRAIN = false;
    const ssq_t* ss; bf16* uh; float* us; bf16* q;
    __device__ __forceinline__ void operator()(AccRef acc, const pg8::Unit& u, int wr, int wc, int fr, int fq) const {
        const int row0 = u.pm * 256 + wr * 64 + fr, colt = u.pn * 256 + wc * 32 + 8 * fq;
#pragma unroll
        for (int ai = 0; ai < 2; ++ai)
#pragma unroll
            for (int m = 0; m < 4; ++m) {
                const int r = row0 + ai * 128 + m * 16; const float rs = rstd_of(ss[r], 1.f / 2048.f);
#pragma unroll
                for (int bj = 0; bj < 2; ++bj) {
                    const f32x4 v0 = acc[ai][bj][m][0] * rs, v1 = acc[ai][bj][m][1] * rs; const int c = colt + bj * 128;
                    if (u.pn < 6) {
                        if (r < MP) { const int h = c >> 4, c0 = c & 15; *(v4u*)(uh + ((size_t)(h * 512 + (r >> 4)) * KH + (r & 15) * 16 + c0)) = pack8(v0, v1); }
                        else if (r < MREAL) { float* o = us + (size_t)(r - MP) * TOKW + c; *(f32x4*)o = v0; *(f32x4*)(o + 4) = v1; }
                    } else *(v4u*)(q + (size_t)r * XAW + (c - TOKW)) = pack8(v0, v1);
                }
                asm volatile("" ::: "memory");
            }
    }
};
struct EpiToep {
    static constexpr bool PERM = true, AFTER_DRAIN = false;
    bf16* yb;
    __device__ __forceinline__ void operator()(AccRef acc, const pg8::Unit& u, int wr, int wc, int fr, int fq) const {
        const int h = u.pn, mh = u.pm - 2 * h;
#pragma unroll
        for (int ai = 0; ai < 2; ++ai)
#pragma unroll
            for (int m = 0; m < 4; ++m) {
                const int ml = mh * 256 + ai * 128 + wr * 64 + m * 16 + fr;
#pragma unroll
                for (int bj = 0; bj < 2; ++bj) {
                    const int cl = bj * 128 + wc * 32 + 8 * fq, tau = cl >> 4, c0 = cl & 15;
                    *(v4u*)(yb + (size_t)(ml * 16 + tau) * TOKW + h * 16 + c0) = pack8(gelu4(acc[ai][bj][m][0]), gelu4(acc[ai][bj][m][1]));
                    __builtin_amdgcn_sched_barrier(0);
                }
            }
    }
};
struct EpiGlu {
    static constexpr bool PERM = true, AFTER_DRAIN = false;
    const bf16* yb; const float* bias; bf16* mix;
    __device__ __forceinline__ void operator()(AccRef acc, const pg8::Unit& u, int wr, int wc, int fr, int fq) const {
        const int row0 = u.pm * 256 + wr * 64 + fr, colt = u.pn * 256 + wc * 32 + 8 * fq;
#pragma unroll
        for (int ai = 0; ai < 2; ++ai)
#pragma unroll
            for (int m = 0; m < 4; ++m) {
                const int r = row0 + ai * 128 + m * 16;
#pragma unroll
                for (int bj = 0; bj < 2; ++bj) {
                    const int c = colt + bj * 128; const f32x4 b0 = *(const f32x4*)(bias + c), b1 = *(const f32x4*)(bias + c + 4);
                    const v4u yw = *(const v4u*)(yb + (size_t)r * TOKW + c);
                    const f32x4 g0 = acc[ai][bj][m][0] + b0, g1 = acc[ai][bj][m][1] + b1;
                    f32x4 o0, o1;
                    o0[0] = bflo(yw.x) * sigmoid_f(g0[0]); o0[1] = bfhi(yw.x) * sigmoid_f(g0[1]); o0[2] = bflo(yw.y) * sigmoid_f(g0[2]); o0[3] = bfhi(yw.y) * sigmoid_f(g0[3]);
                    o1[0] = bflo(yw.z) * sigmoid_f(g1[0]); o1[1] = bfhi(yw.z) * sigmoid_f(g1[1]); o1[2] = bflo(yw.w) * sigmoid_f(g1[2]); o1[3] = bfhi(yw.w) * sigmoid_f(g1[3]);
                    *(v4u*)(mix + (size_t)r * D + c) = pack8(o0, o1);
                    asm volatile("" ::: "memory");
                }
            }
    }
};
struct EpiMem {
    static constexpr bool PERM = false, AFTER_DRAIN = false;
    const ssq_t* ssm; float* out; bf16* mkv;
    __device__ __forceinline__ void operator()(AccRef acc, const pg8::Unit& u, int wr, int wc, int fr, int fq) const {
        const int row0 = u.pm * 256 + wr * 64 + fr, col0 = u.pn * 256 + wc * 32 + 4 * fq;
#pragma unroll
        for (int ai = 0; ai < 2; ++ai)
#pragma unroll
            for (int m = 0; m < 4; ++m) {
                const int r = row0 + ai * 128 + m * 16; const float rs = rstd_of(ssm[r], 1.f / 2048.f);
#pragma unroll
                for (int bj = 0; bj < 2; ++bj)
#pragma unroll
                    for (int n = 0; n < 2; ++n) { const int c = col0 + bj * 128 + n * 16, li = c >> 10, cc = c & 1023; const f32x4 v = acc[ai][bj][m][n] * rs;
                        *(f32x4*)(out + (cc < 512 ? OFF_MK : OFF_MV) + (size_t)(li * 1024 + r) * 512 + (cc & 511)) = v;
                        v2u w; w.x = pk2(v[0], v[1]); w.y = pk2(v[2], v[3]); *(v2u*)(mkv + (size_t)(li * 1024 + r) * 1024 + cc) = w; }
            }
    }
};
struct ToepOrder {
    int G, c;
    __device__ bool next(int i, pg8::Unit& u) const { const int L = i * G + c; if (L >= 2 * NGRP) return false; const int h = L >> 1; u.pm = 2 * h + (L & 1); u.pn = h; return true; }
    __device__ __forceinline__ void a_ready(const pg8::Unit&) const {}
    __device__ __forceinline__ void done(const pg8::Unit&) const {}
};

constexpr int P0_TLD = 130;
constexpr int P0_T0 = 896, P0_T1 = P0_T0 + 512, P0_T2 = P0_T1 + 512, P0_T3 = P0_T2 + 512, P0_T4 = P0_T3 + 288, P0_T5 = P0_T4 + 5504, P0_T6 = P0_T5 + 2752, P0_NTILES = P0_T6 + 512;
struct P0Desc { const float* W; const float* gn; bf16* WT; int K, N, roff, tile; };
struct Args;
__device__ __forceinline__ P0Desc p0_decode(int t, const float* const* in, unsigned char* wsb) {
    P0Desc d; d.gn = nullptr; d.roff = 0;
    if (t < P0_T0) { const int mi = t / 448; d.tile = t - mi * 448; d.W = in[13] + (size_t)mi * D * SGN; d.gn = in[8] + (2 * mi) * D; d.K = D; d.N = SGN; d.WT = (bf16*)(wsb + WS_WSGIN) + (size_t)mi * SGN * D; }
    else if (t < P0_T1) { t -= P0_T0; const int mi = t >> 8; d.tile = t & 255; d.W = in[18] + (size_t)mi * D * D; d.gn = in[8] + (2 * mi + 1) * D; d.K = D; d.N = D; d.WT = (bf16*)(wsb + WS_WSSMIN) + (size_t)mi * D * D; }
    else if (t < P0_T2) { t -= P0_T1; const int mi = t >> 8; d.tile = t & 255; d.W = in[14] + (size_t)mi * D * D; d.K = D; d.N = D; d.WT = (bf16*)(wsb + WS_WSGOUT) + (size_t)mi * D * D; }
    else if (t < P0_T3) { t -= P0_T2; const int mi = t >> 8; d.tile = t & 255; d.W = in[19] + (size_t)mi * D * D; d.K = D; d.N = D; d.WT = (bf16*)(wsb + WS_WSSMOUT) + (size_t)mi * D * D; }
    else if (t < P0_T4) { t -= P0_T3; const int mi = t / 144; d.tile = t - mi * 144; d.W = in[28] + (size_t)mi * TOKW * TOKW; d.K = TOKW; d.N = TOKW; d.WT = (bf16*)(wsb + WS_WGLU) + (size_t)mi * TOKW * TOKW; }
    else if (t < P0_T5) { t -= P0_T4; const int mi = t / 1376; d.tile = t - mi * 1376; d.W = in[30] + (size_t)mi * D * NUP; d.gn = in[9] + mi * D; d.K = D; d.N = NUP; d.WT = (bf16*)(wsb + WS_WUP) + (size_t)mi * NUP * D; }
    else if (t < P0_T6) { t -= P0_T5; const int mi = t / 688; d.tile = t - mi * 688; d.W = in[33] + (size_t)mi * DFF * D; d.K = DFF; d.N = D; d.WT = (bf16*)(wsb + WS_WDOWN) + (size_t)mi * D * DFF; }
    else { t -= P0_T6; const int mi = t >> 7; d.tile = t & 127; d.W = in[12] + (size_t)mi * D * 1024; d.gn = in[10] + mi * D; d.K = D; d.N = 1024; d.WT = (bf16*)(wsb + WS_WMEM); d.roff = mi * 1024; }
    return d;
}
__device__ __forceinline__ void p0_load(const P0Desc& d, f32x4 (&v)[8], int tid) {
    const int nbn = d.N >> 7, kb = d.tile / nbn, nb = d.tile - kb * nbn; const float* p = d.W + (size_t)((kb << 7) + (tid >> 5)) * d.N + (nb << 7) + (tid & 31) * 4;
#pragma unroll
    for (int it = 0; it < 8; ++it) v[it] = *(const f32x4*)(p + (size_t)(16 * it) * d.N);
}
__device__ __forceinline__ void p0_to_lds(const P0Desc& d, const f32x4 (&v)[8], LAS bf16* T, int tid) {
    const int nbn = d.N >> 7, kb = d.tile / nbn, k0 = kb << 7, kq = tid >> 5, n4 = (tid & 31) * 4;
#pragma unroll
    for (int it = 0; it < 8; ++it) { const int kk = kq + 16 * it; const float g = d.gn ? d.gn[k0 + kk] : 1.f;
        LAS unsigned* p = (LAS unsigned*)(T + kk * P0_TLD + n4); p[0] = pk2(v[it][0] * g, v[it][1] * g); p[1] = pk2(v[it][2] * g, v[it][3] * g); }
}
__device__ __forceinline__ void p0_store(const P0Desc& d, const LAS bf16* T, int tid) {
    const int nbn = d.N >> 7, kb = d.tile / nbn, nb = d.tile - kb * nbn, k0 = kb << 7, n0 = nb << 7;
#pragma unroll
    for (int j = 0; j < 4; ++j) { const int p = tid + 512 * j, n = p >> 4, kg = p & 15; const LAS bf16* s_ = T + (kg * 8) * P0_TLD + n;
        v4u o; o.x = (unsigned)s_[0] | ((unsigned)s_[P0_TLD] << 16); o.y = (unsigned)s_[2 * P0_TLD] | ((unsigned)s_[3 * P0_TLD] << 16);
        o.z = (unsigned)s_[4 * P0_TLD] | ((unsigned)s_[5 * P0_TLD] << 16); o.w = (unsigned)s_[6 * P0_TLD] | ((unsigned)s_[7 * P0_TLD] << 16);
        *(v4u*)(d.WT + (size_t)(d.roff + n0 + n) * d.K + k0 + kg * 8) = o; }
}
__device__ __forceinline__ void p0_row(const float* src, float* dstf, bf16* dstb, ssq_t* ssp, int lane) {
    f32x4 v[8]; float s = 0.f;
#pragma unroll
    for (int j = 0; j < 8; ++j) { v[j] = src ? ((const f32x4*)src)[lane + 64 * j] : (f32x4){0.f, 0.f, 0.f, 0.f}; s += dot4(v[j]); }
    s = wave_sum(s);
#pragma unroll
    for (int j = 0; j < 8; ++j) { if (dstf) ((f32x4*)dstf)[lane + 64 * j] = v[j]; v2u w; w.x = pk2(v[j][0], v[j][1]); w.y = pk2(v[j][2], v[j][3]); ((v2u*)dstb)[lane + 64 * j] = w; }
    if (lane == 0) *ssp = ss_fix(s);
}
__device__ __forceinline__ void s5_tables(LAS float* L, int j, int h, const float* lam_re, const float* lam_im, const float* log_dt, const float* b_re, const float* b_im,
                                          const float* c_re, const float* c_im, const float* dvec, bf16* TB, bf16* BT2, float* LBT, float* LB16, float* BBART, int tid) {
    LAS float* PWr = L; LAS float* PWi = L + 1088; LAS float* BBr = L + 2176; LAS float* BBi = L + 3200; LAS float* Cr = L + 4224; LAS float* Ci = L + 5248; LAS float* KM = L + 6272;
    const int gh = j * NGRP + h;
    if (tid < 64) {
        const int p = tid, idx = gh * 64 + p; const float lr = lam_re[idx], li = lam_im[idx], dt = expf(log_dt[gh]);
        const float ar = lr * dt, ai = li * dt, mag = expf(ar); float sn, cs; sincosf(ai, &sn, &cs);
        const float lbr = mag * cs, lbi = mag * sn; const float sh = sinf(0.5f * ai);
        const float nr = expm1f(ar) * cs - 2.f * sh * sh, ni = lbi, den = lr * lr + li * li;
        const float kr = (nr * lr + ni * li) / den, ki = (ni * lr - nr * li) / den;
        float pr = 1.f, pi = 0.f;
#pragma unroll
        for (int n = 0; n < 17; ++n) { PWr[p * 17 + n] = pr; PWi[p * 17 + n] = pi; if (n == 16) { LB16[idx * 2] = pr; LB16[idx * 2 + 1] = pi; } const float t = pr * lbr - pi * lbi; pi = pr * lbi + pi * lbr; pr = t; }
        LBT[idx * 2] = lbr; LBT[idx * 2 + 1] = lbi;
#pragma unroll
        for (int c = 0; c < 16; ++c) { const float br = b_re[(size_t)idx * 16 + c], bi = b_im[(size_t)idx * 16 + c]; const float xr = kr * br - ki * bi, xi = kr * bi + ki * br;
            BBr[p * 16 + c] = xr; BBi[p * 16 + c] = xi; BBART[((size_t)idx * 16 + c) * 2] = xr; BBART[((size_t)idx * 16 + c) * 2 + 1] = xi; }
    }
#pragma unroll
    for (int i = 0; i < 2; ++i) { const int e = tid + 512 * i; Cr[e] = c_re[(size_t)gh * 1024 + e]; Ci[e] = c_im[(size_t)gh * 1024 + e]; }
    __syncthreads();
#pragma unroll 1
    for (int i = 0; i < 8; ++i) {
        const int e = tid * 8 + i, dl = e >> 8, c = (e >> 4) & 15, c2 = e & 15; float s = 0.f;
#pragma unroll 4
        for (int p = 0; p < 64; ++p) { const float wr_ = PWr[p * 17 + dl], wi_ = PWi[p * 17 + dl], xr = BBr[p * 16 + c2], xi = BBi[p * 16 + c2];
            s += Cr[c * 64 + p] * (wr_ * xr - wi_ * xi) - Ci[c * 64 + p] * (wr_ * xi + wi_ * xr); }
        if (dl == 0 && c == c2) s += dvec[j * TOKW + h * 16 + c];
        KM[e] = s;
    }
    __syncthreads();
#pragma unroll 1
    for (int it = 0; it < 24; ++it) {
        const int grp = tid + 512 * it, row = grp / 48, cg = grp % 48, tau = row >> 4, c = row & 15; float v[8];
        if (cg < 32) { const int sg = cg >> 1, c0 = (cg & 1) * 8;
#pragma unroll
            for (int i = 0; i < 8; ++i) v[i] = sg <= tau ? KM[(tau - sg) * 256 + c * 16 + c0 + i] : 0.f; }
        else if (cg < 40) {
#pragma unroll
            for (int i = 0; i < 8; ++i) { const int p = (cg - 32) * 8 + i; v[i] = Cr[c * 64 + p] * PWr[p * 17 + tau + 1] - Ci[c * 64 + p] * PWi[p * 17 + tau + 1]; } }
        else {
#pragma unroll
            for (int i = 0; i < 8; ++i) { const int p = (cg - 40) * 8 + i; v[i] = -(Cr[c * 64 + p] * PWi[p * 17 + tau + 1] + Ci[c * 64 + p] * PWr[p * 17 + tau + 1]); } }
        v4u w; w.x = pk2(v[0], v[1]); w.y = pk2(v[2], v[3]); w.z = pk2(v[4], v[5]); w.w = pk2(v[6], v[7]);
        *(v4u*)(TB + ((size_t)gh * 256 + row) * KH + cg * 8) = w;
    }
#pragma unroll 1
    for (int it = 0; it < 8; ++it) {
        const int grp = tid + 512 * it, row = grp >> 5, cg = grp & 31, ri = row >> 6, p = row & 63, n = 15 - (cg >> 1), c0 = (cg & 1) * 8; float v[8];
        const float wr_ = PWr[p * 17 + n], wi_ = PWi[p * 17 + n];
#pragma unroll
        for (int i = 0; i < 8; ++i) { const float xr = BBr[p * 16 + c0 + i], xi = BBi[p * 16 + c0 + i]; v[i] = ri == 0 ? (wr_ * xr - wi_ * xi) : (wr_ * xi + wi_ * xr); }
        v4u w; w.x = pk2(v[0], v[1]); w.y = pk2(v[2], v[3]); w.z = pk2(v[4], v[5]); w.w = pk2(v[6], v[7]);
        *(v4u*)(BT2 + ((size_t)gh * 128 + row) * 256 + cg * 8) = w;
    }
    __syncthreads();
}

constexpr int KS_LD = 136, VT_LD = 264, VT_OFF = 256 * KS_LD * 2;
__device__ __forceinline__ void attn_prompt_unit(LAS unsigned char* lds, const bf16* q, const bf16* mkv_l, bf16* mix, int unit, int tid) {
    const int b = unit >> 6, hd = (unit >> 4) & 3, qb = unit & 15, lane = tid & 63, w = tid >> 6, fr = lane & 15, fq = lane >> 4;
    LAS bf16* Ks = (LAS bf16*)lds; LAS bf16* Vt = (LAS bf16*)(lds + VT_OFF);
    const bf16* kvb = mkv_l + (size_t)(b * 256) * 1024 + hd * 128;
#pragma unroll
    for (int it = 0; it < 8; ++it) { const int id = tid + 512 * it, key = id >> 4, part = id & 15;
        const v4u kw = *(const v4u*)(kvb + (size_t)key * 1024 + part * 8); *(LAS v4u*)(Ks + key * KS_LD + part * 8) = kw;
        const v4u vw = *(const v4u*)(kvb + (size_t)key * 1024 + 512 + part * 8); LAS bf16* vp = Vt + (part * 8) * VT_LD + key;
        vp[0] = (bf16)(vw.x & 0xffff); vp[VT_LD] = (bf16)(vw.x >> 16); vp[2 * VT_LD] = (bf16)(vw.y & 0xffff); vp[3 * VT_LD] = (bf16)(vw.y >> 16);
        vp[4 * VT_LD] = (bf16)(vw.z & 0xffff); vp[5 * VT_LD] = (bf16)(vw.z >> 16); vp[6 * VT_LD] = (bf16)(vw.w & 0xffff); vp[7 * VT_LD] = (bf16)(vw.w >> 16); }
    const int r = b * SEQ + qb * 128 + w * 16 + fr;
    bf16x8 qf[4];
#pragma unroll
    for (int ks = 0; ks < 4; ++ks) qf[ks] = *(const bf16x8*)(q + (size_t)r * XAW + hd * 128 + ks * 32 + fq * 8);
    __syncthreads();
    f32x4 s[16];
#pragma unroll
    for (int t = 0; t < 16; ++t) { s[t] = (f32x4){0.f, 0.f, 0.f, 0.f};
#pragma unroll
        for (int ks = 0; ks < 4; ++ks) { const bf16x8 kf = *(const LAS bf16x8*)(Ks + (t * 16 + fr) * KS_LD + ks * 32 + fq * 8); s[t] = __builtin_amdgcn_mfma_f32_16x16x32_bf16(kf, qf[ks], s[t], 0, 0, 0); } }
    float mx = -3.0e38f;
#pragma unroll
    for (int t = 0; t < 16; ++t) mx = fmaxf(fmaxf(fmaxf(s[t][0], s[t][1]), fmaxf(s[t][2], s[t][3])), mx);
    mx = fmaxf(mx, __shfl_xor(mx, 16)); mx = fmaxf(mx, __shfl_xor(mx, 32));
    const float sc = 0.08838834764831845f * 1.4426950408889634f; float sum = 0.f;
#pragma unroll
    for (int t = 0; t < 16; ++t) {
#pragma unroll
        for (int jj = 0; jj < 4; ++jj) { const float p = __builtin_amdgcn_exp2f((s[t][jj] - mx) * sc); s[t][jj] = p; sum += p; } }
    sum += __shfl_xor(sum, 16); sum += __shfl_xor(sum, 32);
    f32x4 o[8];
#pragma unroll
    for (int dt = 0; dt < 8; ++dt) o[dt] = (f32x4){0.f, 0.f, 0.f, 0.f};
#pragma unroll
    for (int kk = 0; kk < 8; ++kk) {
        v4u pw; pw.x = pk2(s[2 * kk][0], s[2 * kk][1]); pw.y = pk2(s[2 * kk][2], s[2 * kk][3]); pw.z = pk2(s[2 * kk + 1][0], s[2 * kk + 1][1]); pw.w = pk2(s[2 * kk + 1][2], s[2 * kk + 1][3]);
        const bf16x8 pf = __builtin_bit_cast(bf16x8, pw);
#pragma unroll
        for (int dt = 0; dt < 8; ++dt) { const LAS bf16* vp = Vt + (dt * 16 + fr) * VT_LD + kk * 32 + fq * 4;
            v4u vw; const v2u lo = *(const LAS v2u*)vp, hi = *(const LAS v2u*)(vp + 16); vw.x = lo.x; vw.y = lo.y; vw.z = hi.x; vw.w = hi.y;
            o[dt] = __builtin_amdgcn_mfma_f32_16x16x32_bf16(__builtin_bit_cast(bf16x8, vw), pf, o[dt], 0, 0, 0); } }
    const float inv = 1.f / sum;
#pragma unroll
    for (int dt = 0; dt < 8; ++dt) { v2u w2; w2.x = pk2(o[dt][0] * inv, o[dt][1] * inv); w2.y = pk2(o[dt][2] * inv, o[dt][3] * inv);
        *(v2u*)(mix + (size_t)r * D + TOKW + hd * 128 + dt * 16 + fq * 4) = w2; }
    __syncthreads();
}
__device__ __forceinline__ void attn_sample_unit(LAS unsigned char* lds, const bf16* q, const float* ck, const float* cv, bf16* mix, int li, int unit, int tid) {
    const int b = unit >> 1, hp = unit & 1, lane = tid & 63, w = tid >> 6, hd = 2 * hp + (w >> 2), kq = (w & 3) * 64, dd = lane & 15, kg = lane >> 4;
    LAS float* red = (LAS float*)lds;
    const v4u qw = *(const v4u*)(q + (size_t)(MP + b) * XAW + hd * 128 + dd * 8);
    float qv[8] = {bflo(qw.x), bfhi(qw.x), bflo(qw.y), bfhi(qw.y), bflo(qw.z), bfhi(qw.z), bflo(qw.w), bfhi(qw.w)};
    const size_t base = ((size_t)(li * MS + b) * 256) * 512 + hd * 128 + dd * 8;
    float sc[16];
#pragma unroll
    for (int it = 0; it < 16; ++it) { const int key = kq + 4 * it + kg; const float* kp = ck + base + (size_t)key * 512; const f32x4 k0 = *(const f32x4*)kp, k1 = *(const f32x4*)(kp + 4);
        float d = qv[0] * k0[0] + qv[1] * k0[1] + qv[2] * k0[2] + qv[3] * k0[3] + qv[4] * k1[0] + qv[5] * k1[1] + qv[6] * k1[2] + qv[7] * k1[3];
        d += __shfl_xor(d, 1); d += __shfl_xor(d, 2); d += __shfl_xor(d, 4); d += __shfl_xor(d, 8); sc[it] = d; }
    float mx = sc[0];
#pragma unroll
    for (int it = 1; it < 16; ++it) mx = fmaxf(mx, sc[it]);
    mx = fmaxf(mx, __shfl_xor(mx, 16)); mx = fmaxf(mx, __shfl_xor(mx, 32));
    if (lane == 0) red[w] = mx;
    __syncthreads();
    const int w0 = w & 4; mx = fmaxf(fmaxf(red[w0], red[w0 + 1]), fmaxf(red[w0 + 2], red[w0 + 3]));
    const float scl = 0.08838834764831845f * 1.4426950408889634f; float sum = 0.f;
    float oacc[8] = {0.f, 0.f, 0.f, 0.f, 0.f, 0.f, 0.f, 0.f};
#pragma unroll
    for (int it = 0; it < 16; ++it) { const float p = __builtin_amdgcn_exp2f((sc[it] - mx) * scl); sum += p;
        const int key = kq + 4 * it + kg; const float* vp = cv + base + (size_t)key * 512; const f32x4 v0 = *(const f32x4*)vp, v1 = *(const f32x4*)(vp + 4);
        oacc[0] += p * v0[0]; oacc[1] += p * v0[1]; oacc[2] += p * v0[2]; oacc[3] += p * v0[3]; oacc[4] += p * v1[0]; oacc[5] += p * v1[1]; oacc[6] += p * v1[2]; oacc[7] += p * v1[3]; }
    sum += __shfl_xor(sum, 16); sum += __shfl_xor(sum, 32);
#pragma unroll
    for (int i = 0; i < 8; ++i) { oacc[i] += __shfl_xor(oacc[i], 16); oacc[i] += __shfl_xor(oacc[i], 32); }
    if (lane == 0) red[8 + w] = sum;
    if (lane < 16) {
#pragma unroll
        for (int i = 0; i < 8; ++i) red[16 + w * 128 + dd * 8 + i] = oacc[i]; }
    __syncthreads();
    if ((w & 3) == 0 && lane < 16) {
        const float tot = (red[8 + w] + red[9 + w]) + (red[10 + w] + red[11 + w]), inv = 1.f / tot; float o[8];
#pragma unroll
        for (int i = 0; i < 8; ++i) o[i] = ((red[16 + w * 128 + dd * 8 + i] + red[16 + (w + 1) * 128 + dd * 8 + i]) + (red[16 + (w + 2) * 128 + dd * 8 + i] + red[16 + (w + 3) * 128 + dd * 8 + i])) * inv;
        v4u ow; ow.x = pk2(o[0], o[1]); ow.y = pk2(o[2], o[3]); ow.z = pk2(o[4], o[5]); ow.w = pk2(o[6], o[7]);
        *(v4u*)(mix + (size_t)(MP + b) * D + TOKW + hd * 128 + dd * 8) = ow;
    }
    __syncthreads();
}

constexpr int SG_LD = 136;
__device__ __forceinline__ void sg_unit(LAS unsigned char* lds, const bf16* zu, const bf16* zv, const ssq_t* ssv, const float* g_v, const bf16* wsb, const float* b_s, bf16* mix, int unit, int tid) {
    const int ch = unit / 12, g = unit % 12, row0 = ch * 128, lane = tid & 63, w = tid >> 6, fr = lane & 15, fq = lane >> 4;
    LAS bf16* Vt = (LAS bf16*)lds;
    { const int s = tid & 127, dq = tid >> 7; const float rsv = rstd_of(ssv[row0 + s], 1.f / 1536.f);
#pragma unroll
      for (int it = 0; it < 4; ++it) { const int d0 = (dq + 4 * it) * 8; const v4u vw = *(const v4u*)(zv + (size_t)(row0 + s) * TOKW + g * 128 + d0);
          const f32x4 g0 = *(const f32x4*)(g_v + g * 128 + d0), g1 = *(const f32x4*)(g_v + g * 128 + d0 + 4);
          const unsigned a = pk2(bflo(vw.x) * rsv * g0[0], bfhi(vw.x) * rsv * g0[1]), b2 = pk2(bflo(vw.y) * rsv * g0[2], bfhi(vw.y) * rsv * g0[3]),
                         c2 = pk2(bflo(vw.z) * rsv * g1[0], bfhi(vw.z) * rsv * g1[1]), e2 = pk2(bflo(vw.w) * rsv * g1[2], bfhi(vw.w) * rsv * g1[3]);
          LAS bf16* vp = Vt + d0 * SG_LD + s;
          vp[0] = (bf16)(a & 0xffff); vp[SG_LD] = (bf16)(a >> 16); vp[2 * SG_LD] = (bf16)(b2 & 0xffff); vp[3 * SG_LD] = (bf16)(b2 >> 16);
          vp[4 * SG_LD] = (bf16)(c2 & 0xffff); vp[5 * SG_LD] = (bf16)(c2 >> 16); vp[6 * SG_LD] = (bf16)(e2 & 0xffff); vp[7 * SG_LD] = (bf16)(e2 >> 16); } }
    const int nks = (w >> 1) + 1;
    bf16x8 wf[4];
#pragma unroll
    for (int ks = 0; ks < 4; ++ks) wf[ks] = *(const bf16x8*)(wsb + ((size_t)g * 128 + w * 16 + fr) * 128 + ks * 32 + fq * 8);
    __syncthreads();
    f32x4 acc[8];
#pragma unroll
    for (int dt = 0; dt < 8; ++dt) { acc[dt] = (f32x4){0.f, 0.f, 0.f, 0.f};
#pragma unroll
        for (int ks = 0; ks < 4; ++ks) if (ks < nks) { const bf16x8 vf = *(const LAS bf16x8*)(Vt + (dt * 16 + fr) * SG_LD + ks * 32 + fq * 8); acc[dt] = __builtin_amdgcn_mfma_f32_16x16x32_bf16(vf, wf[ks], acc[dt], 0, 0, 0); } }
    const int t = w * 16 + fr, r = row0 + t; const float bias = b_s[g * 128 + t];
#pragma unroll
    for (int dt = 0; dt < 8; ++dt) { const int c = g * 128 + dt * 16 + fq * 4; const v2u uw = *(const v2u*)(zu + (size_t)r * TOKW + c);
        v2u ow; ow.x = pk2(bflo(uw.x) * (acc[dt][0] + bias), bfhi(uw.x) * (acc[dt][1] + bias)); ow.y = pk2(bflo(uw.y) * (acc[dt][2] + bias), bfhi(uw.y) * (acc[dt][3] + bias));
        *(v2u*)(mix + (size_t)r * D + c) = ow; }
    __syncthreads();
}

__device__ __forceinline__ void s5_state_task(LAS unsigned char* lds, bf16* uh, const bf16* bt2_l, const float* lb16_l, float* out, int j, int task, int tid) {
    const int b = task / NGRP, h = task % NGRP, lane = tid & 63, w = tid >> 6, fr = lane & 15, fq = lane >> 4;
    LAS float* S = (LAS float*)lds;
    bf16x8 af[8];
    const bf16* ap = uh + ((size_t)(h * 512 + b * 128 + w * 16 + fr)) * KH + fq * 8;
#pragma unroll
    for (int ks = 0; ks < 8; ++ks) af[ks] = *(const bf16x8*)(ap + ks * 32);
#pragma unroll
    for (int nt = 0; nt < 8; ++nt) { f32x4 acc = (f32x4){0.f, 0.f, 0.f, 0.f}; const bf16* bp = bt2_l + ((size_t)(h * 128 + nt * 16 + fr)) * 256 + fq * 8;
#pragma unroll
        for (int ks = 0; ks < 8; ++ks) { const bf16x8 bf = *(const bf16x8*)(bp + ks * 32); acc = __builtin_amdgcn_mfma_f32_16x16x32_bf16(af[ks], bf, acc, 0, 0, 0); }
#pragma unroll
        for (int jj = 0; jj < 4; ++jj) S[(w * 16 + fq * 4 + jj) * 129 + nt * 16 + fr] = acc[jj]; }
    __syncthreads();
    if (w == 0) {
        const int p = lane; const float lr = lb16_l[(h * 64 + p) * 2], li = lb16_l[(h * 64 + p) * 2 + 1]; float hr = 0.f, hi = 0.f;
        bf16* up = uh + ((size_t)(h * 512 + b * 128)) * KH + 256 + p;
#pragma unroll 4
        for (int m = 0; m < 128; ++m) { up[(size_t)m * KH] = (bf16)(pk2(hr, 0.f) & 0xffff); up[(size_t)m * KH + 64] = (bf16)(pk2(hi, 0.f) & 0xffff);
            const float sr = S[m * 129 + p], si = S[m * 129 + 64 + p]; const float t = lr * hr - li * hi + sr; hi = lr * hi + li * hr + si; hr = t; }
        out[OFF_SRP + ((size_t)(j * 4 + b) * NGRP + h) * 64 + p] = hr; out[OFF_SIP + ((size_t)(j * 4 + b) * NGRP + h) * 64 + p] = hi;
    }
    __syncthreads();
}
__device__ __forceinline__ void s5_sample_task(const float* us, const float* st_re, const float* st_im, const float* lbt_l, const float* bbar_l, const float* c_re_l, const float* c_im_l, const float* d_l,
                                               float* out, bf16* yb, int j, int task, int lane) {
    const int b = task / NGRP, h = task % NGRP, p = lane;
    float u[16];
#pragma unroll
    for (int c4 = 0; c4 < 4; ++c4) { const f32x4 t = *(const f32x4*)(us + (size_t)b * TOKW + h * 16 + c4 * 4); u[c4 * 4] = t[0]; u[c4 * 4 + 1] = t[1]; u[c4 * 4 + 2] = t[2]; u[c4 * 4 + 3] = t[3]; }
    float xr = 0.f, xi = 0.f; const float* bb = bbar_l + ((size_t)(h * 64 + p)) * 32;
#pragma unroll
    for (int c2 = 0; c2 < 8; ++c2) { const f32x4 t = *(const f32x4*)(bb + c2 * 4); xr += t[0] * u[2 * c2] + t[2] * u[2 * c2 + 1]; xi += t[1] * u[2 * c2] + t[3] * u[2 * c2 + 1]; }
    const size_t si_ = ((size_t)(j * MS + b) * NGRP + h) * 64 + p; const float s0r = st_re[si_], s0i = st_im[si_], lr = lbt_l[(h * 64 + p) * 2], li = lbt_l[(h * 64 + p) * 2 + 1];
    const float hr = lr * s0r - li * s0i + xr, hi = lr * s0i + li * s0r + xi;
    out[OFF_SRS + si_] = hr; out[OFF_SIS + si_] = hi;
    float yv = 0.f;
#pragma unroll
    for (int c = 0; c < 16; ++c) { float t = c_re_l[((size_t)(h * 16 + c)) * 64 + p] * hr - c_im_l[((size_t)(h * 16 + c)) * 64 + p] * hi; t = wave_sum(t); t += d_l[h * 16 + c] * u[c]; yv = (lane == c) ? t : yv; }
    if (lane < 16) yb[(size_t)(MP + b) * TOKW + h * 16 + lane] = (bf16)(pk2(gelu_t(yv), 0.f) & 0xffff);
}

struct SEpiRes {
    float* xres; bf16* xb; ssq_t* ssn;
    __device__ __forceinline__ void operator()(f32x4 v, int m, int c) const {
        const int r = MP + m; float* xp = xres + (size_t)r * D + c; const f32x4 o = *(const f32x4*)xp + v; *(f32x4*)xp = o;
        v2u w; w.x = pk2(o[0], o[1]); w.y = pk2(o[2], o[3]); *(v2u*)(xb + (size_t)r * D + c) = w;
        float sq = dot4(o); sq += __shfl_xor(sq, 1); sq += __shfl_xor(sq, 2); if ((threadIdx.x & 3) == 0) fadd_atomic(ssn + r, sq);
    }
};
struct SEpiSsmIn {
    const ssq_t* ss; float* us; bf16* q;
    __device__ __forceinline__ void operator()(f32x4 v, int m, int c) const {
        const int r = MP + m; v = v * rstd_of(ss[r], 1.f / 2048.f);
        if (c < TOKW) *(f32x4*)(us + (size_t)m * TOKW + c) = v;
        else { v2u w; w.x = pk2(v[0], v[1]); w.y = pk2(v[2], v[3]); *(v2u*)(q + (size_t)r * XAW + (c - TOKW)) = w; }
    }
};
template <class SEpi>
__device__ __forceinline__ void skinny_sample(LAS unsigned char* lds, const bf16* As, const bf16* Bt, int K, const SEpi& E, int blk, int tid) {
    if (blk >= 128) return;
    const int lane = tid & 63, w = __builtin_amdgcn_readfirstlane(tid >> 6), fr = lane & 15, fq = lane >> 4, n0 = blk * 16;
    f32x4 acc[8];
#pragma unroll
    for (int mt = 0; mt < 8; ++mt) acc[mt] = (f32x4){0.f, 0.f, 0.f, 0.f};
    const int nks = K >> 5; const bf16* bp = Bt + (size_t)(n0 + fr) * K + fq * 8; const bf16* ap = As + (size_t)fr * K + fq * 8;
#pragma unroll 2
    for (int ks = w; ks < nks; ks += 8) {
        const bf16x8 bfr = *(const bf16x8*)(bp + ks * 32);
#pragma unroll
        for (int mt = 0; mt < 8; ++mt) { const bf16x8 afr = *(const bf16x8*)(ap + (size_t)(mt * 16) * K + ks * 32); acc[mt] = __builtin_amdgcn_mfma_f32_16x16x32_bf16(bfr, afr, acc[mt], 0, 0, 0); }
    }
    LAS float* red = (LAS float*)lds;
#pragma unroll
    for (int mt = 0; mt < 8; ++mt) *(LAS f32x4*)(red + ((w * 128 + mt * 16 + fr) * 16 + fq * 4)) = acc[mt];
    __syncthreads();
    const int m = tid >> 2, nq = (tid & 3) * 4; f32x4 sum = *(const LAS f32x4*)(red + (m * 16 + nq));
#pragma unroll
    for (int w2 = 1; w2 < 8; ++w2) sum += *(const LAS f32x4*)(red + ((w2 * 128 + m) * 16 + nq));
    E(sum, m, n0 + nq);
    __syncthreads();
}

#define RLX_AGENT __ATOMIC_RELAXED, __HIP_MEMORY_SCOPE_AGENT
struct Args { const float* in[34]; float* out; unsigned char* ws; int lo, hi; };
__global__ void __launch_bounds__(NTHR, 2) trunk_fwd(Args args) {
    extern __shared__ __attribute__((aligned(16))) unsigned char lds_raw[];
    LAS unsigned char* lds = (LAS unsigned char*)lds_raw;
    volatile LAS unsigned* MISC = (volatile LAS unsigned*)(lds + MISC_OFF);
    const int G = gridDim.x, blk = blockIdx.x;
    const Args* ap = &args;
#define ws (ap->ws)
#define out (ap->out)
#define x_prompt (ap->in[0])
#define x_sample (ap->in[1])
#define mem_prompt (ap->in[2])
#define cache_k (ap->in[3])
#define cache_v (ap->in[4])
#define st_re (ap->in[5])
#define st_im (ap->in[6])
#define st_conv (ap->in[7])
#define g_mix (ap->in[8])
#define g_ffn (ap->in[9])
#define g_mem (ap->in[10])
#define g_final (ap->in[11])
#define w_mem_kv (ap->in[12])
#define sg_w_in (ap->in[13])
#define sg_w_out (ap->in[14])
#define sg_g_v (ap->in[15])
#define sg_w_s (ap->in[16])
#define sg_b_s (ap->in[17])
#define ssm_w_in (ap->in[18])
#define ssm_w_out (ap->in[19])
#define lam_re (ap->in[20])
#define lam_im (ap->in[21])
#define log_dt (ap->in[22])
#define b_re (ap->in[23])
#define b_im (ap->in[24])
#define c_re (ap->in[25])
#define c_im (ap->in[26])
#define ssm_d (ap->in[27])
#define w_glu (ap->in[28])
#define b_glu (ap->in[29])
#define w_up (ap->in[30])
#define conv_w (ap->in[31])
#define conv_b (ap->in[32])
#define w_down (ap->in[33])
#define ctl ((unsigned*)(ws + WS_CTL))
#define SSX ((ssq_t*)(ws + CTL_SSX))
#define SSV ((ssq_t*)(ws + CTL_SSV))
#define SSMEM ((ssq_t*)(ws + CTL_SSMEM))
#define W_SGIN ((bf16*)(ws + WS_WSGIN))
#define W_SSMIN ((bf16*)(ws + WS_WSSMIN))
#define W_SGOUT ((bf16*)(ws + WS_WSGOUT))
#define W_SSMOUT ((bf16*)(ws + WS_WSSMOUT))
#define W_GLU ((bf16*)(ws + WS_WGLU))
#define W_UP ((bf16*)(ws + WS_WUP))
#define W_DOWN ((bf16*)(ws + WS_WDOWN))
#define W_MEM ((bf16*)(ws + WS_WMEM))
#define WSB ((bf16*)(ws + WS_WSB))
#define TB ((bf16*)(ws + WS_TB))
#define BT2 ((bf16*)(ws + WS_BT2))
#define LBT ((float*)(ws + WS_LBT))
#define LB16 ((float*)(ws + WS_LB16))
#define BBART ((float*)(ws + WS_BBAR))
#define XRES ((float*)(ws + WS_XRES))
#define XB ((bf16*)(ws + WS_XB))
#define MEMB ((bf16*)(ws + WS_MEMB))
#define MKV ((bf16*)(ws + WS_MKV))
#define ZU ((bf16*)(ws + WS_ZU))
#define ZV ((bf16*)(ws + WS_ZV))
#define QB ((bf16*)(ws + WS_Q))
#define MIX ((bf16*)(ws + WS_MIX))
#define AG ((bf16*)(ws + WS_AG))
#define YF ((bf16*)(ws + WS_Y))
#define UH ((bf16*)(ws + WS_UH))
#define YB ((bf16*)(ws + WS_YB))
#define US ((float*)(ws + WS_US))
    for (int u = threadIdx.x; u < 128; u += NTHR) MISC[u] = 0u;
    __syncthreads();
    XcdBarrier bar = xcd_barrier_post(ctl + CW_BAR, MISC + 8);
    const int lo = args.lo, hi = args.hi; int ph = 0;
#ifndef PHM
#define PHM 0xFFFFFFFFu
#endif
#ifndef DUPM
#define DUPM 0u
#endif
#define PH_BEGIN(k) if (((PHM >> (k)) & 1u) && ph >= lo && ph < hi) for (int rep_ = 0; rep_ < (((DUPM >> (k)) & 1u) ? 2 : 1); ++rep_) { unsigned z_; asm volatile("s_mov_b32 %0, 0" : "=s"(z_)); const Args* ap = (const Args*)((const char*)&args + z_); int tid = threadIdx.x; asm volatile("" : "+v"(tid)); const int lane = tid & 63, wave = __builtin_amdgcn_readfirstlane(tid >> 6); const int gw = blk * NWAVES + wave, NGW = G * NWAVES, gtid = blk * NTHR + tid, NT = G * NTHR; (void)lane; (void)gw; (void)NGW; (void)gtid; (void)NT;
#define PH_END do { if (ph >= lo && ph + 1 < hi) xcd_barrier(bar); ++ph; } while (0)

    PH_BEGIN(0)
        {
            LAS bf16* T = (LAS bf16*)lds; f32x4 v[8]; int t = blk; P0Desc d, dn;
            if (t < P0_NTILES) { d = p0_decode(t, ap->in, ws); p0_load(d, v, tid); }
#pragma unroll 1
            while (t < P0_NTILES) {
                p0_to_lds(d, v, T, tid);
                __syncthreads();
                const int tn = t + G; dn = d;
                if (tn < P0_NTILES) { dn = p0_decode(tn, ap->in, ws); p0_load(dn, v, tid); }
                p0_store(d, T, tid);
                __syncthreads();
                t = tn; d = dn;
            }
        }
        for (int r = gw; r < MT + MMEM; r += NGW) {
            if (r < MT) { const float* src = r < MP ? x_prompt + (size_t)r * D : (r < MREAL ? x_sample + (size_t)(r - MP) * D : nullptr); p0_row(src, XRES + (size_t)r * D, XB + (size_t)r * D, SSX + r, lane); }
            else { const int m = r - MT; p0_row(mem_prompt + (size_t)m * D, nullptr, MEMB + (size_t)m * D, SSMEM + m, lane); }
        }
    }
    PH_END;
    PH_BEGIN(1)
        if (blk < 64 || G <= 64) {
            pg8::Gemm g{MEMB, W_MEM, MMEM, 4096, D}; pg8::StaticOrder S; S.init(MMEM, 4096, G, blk);
            EpiMem E{SSMEM, out, MKV};
            pg8::gemm_phase<EpiMem, pg8::StaticOrder, true, true>(lds, g, S, E);
        }
        if (blk >= 64 || G <= 64) {
            const int b0 = G <= 64 ? blk : blk - 64, gs = G <= 64 ? G : G - 64;
            for (int e = b0 * NTHR + tid; e < 2 * 12 * 128 * 128 / 4; e += gs * NTHR) { const int e4 = e * 4, s = e4 & 127, t = (e4 >> 7) & 127; const f32x4 wv = *(const f32x4*)(sg_w_s + e4);
                v2u o; o.x = pk2(s <= t ? wv[0] : 0.f, s + 1 <= t ? wv[1] : 0.f); o.y = pk2(s + 2 <= t ? wv[2] : 0.f, s + 3 <= t ? wv[3] : 0.f); *(v2u*)(WSB + e4) = o; }
            for (int un = b0; un < 2 * NGRP; un += gs) { const int j = un / NGRP, h = un % NGRP;
                s5_tables((LAS float*)lds, j, h, lam_re, lam_im, log_dt, b_re, b_im, c_re, c_im, ssm_d, TB, BT2, LBT, LB16, BBART, tid); }
        }
    }
    PH_END;
#pragma unroll 1
    for (int li = 0; li < 4; ++li) {
        const int j = li >> 1;
        const ssq_t* ss_mix = SSX + (size_t)(2 * li) * MT; ssq_t* ss_ffn = SSX + (size_t)(2 * li + 1) * MT; ssq_t* ss_next = SSX + (size_t)(2 * li + 2) * MT;
        const bf16* mkv_l = MKV + (size_t)li * 1024 * 1024;
        if ((li & 1) == 0) {
            PH_BEGIN(2)
                pg8::Gemm g{XB, W_SGIN + (size_t)j * SGN * D, MT, SGN, D}; pg8::StaticOrder S; S.init(MT, SGN, G, blk);
                EpiSgIn E{ss_mix, ZU, ZV, QB, SSV + (size_t)j * MT};
                pg8::gemm_phase<EpiSgIn, pg8::StaticOrder, true, true>(lds, g, S, E);
            }
            PH_END;
            PH_BEGIN(3)
                const ssq_t* ssv = SSV + (size_t)j * MT; const float* gv = sg_g_v + j * TOKW;
#pragma unroll 1
                for (int un = blk; un < 768; un += G) sg_unit(lds, ZU, ZV, ssv, gv, WSB + (size_t)j * 12 * 128 * 128, sg_b_s + j * 12 * 128, MIX, un, tid);
#pragma unroll 1
                for (int un = blk; un < 256; un += G) attn_prompt_unit(lds, QB, mkv_l, MIX, un, tid);
#pragma unroll 1
                for (int un = blk; un < 256; un += G) attn_sample_unit(lds, QB, cache_k, cache_v, MIX, li, un, tid);
                for (int e = gtid; e < MS * TOKW / 8; e += NT) { const int b = e / 192, c = (e % 192) * 8, g = c >> 7, r = MP + b;
                    const float rsv = rstd_of(ssv[r], 1.f / 1536.f); const v4u vw = *(const v4u*)(ZV + (size_t)r * TOKW + c), uw = *(const v4u*)(ZU + (size_t)r * TOKW + c);
                    const f32x4 g0 = *(const f32x4*)(gv + c), g1 = *(const f32x4*)(gv + c + 4);
                    const f32x4 n0 = (f32x4){bflo(vw.x) * rsv * g0[0], bfhi(vw.x) * rsv * g0[1], bflo(vw.y) * rsv * g0[2], bfhi(vw.y) * rsv * g0[3]};
                    const f32x4 n1 = (f32x4){bflo(vw.z) * rsv * g1[0], bfhi(vw.z) * rsv * g1[1], bflo(vw.w) * rsv * g1[2], bfhi(vw.w) * rsv * g1[3]};
                    float* so = out + OFF_SGV + (size_t)(j * MS + b) * TOKW + c; *(f32x4*)so = n0; *(f32x4*)(so + 4) = n1;
                    const float w00 = sg_w_s[((size_t)(j * 12 + g) * 128) * 128], bs = sg_b_s[(j * 12 + g) * 128];
                    const f32x4 t0 = (f32x4){bflo(uw.x), bfhi(uw.x), bflo(uw.y), bfhi(uw.y)} * (n0 * w00 + bs), t1 = (f32x4){bflo(uw.z), bfhi(uw.z), bflo(uw.w), bfhi(uw.w)} * (n1 * w00 + bs);
                    *(v4u*)(MIX + (size_t)r * D + c) = pack8(t0, t1); }
            }
            PH_END;
        } else {
            PH_BEGIN(4)
                pg8::Gemm g{XB, W_SSMIN + (size_t)j * D * D, MP, D, D}; pg8::StaticOrder S; S.init(MP, D, G, blk);
                EpiSsmIn E{ss_mix, UH, US, QB};
                pg8::gemm_phase<EpiSsmIn, pg8::StaticOrder, true, true>(lds, g, S, E);
                SEpiSsmIn SE{ss_mix, US, QB}; skinny_sample(lds, XB + (size_t)MP * D, W_SSMIN + (size_t)j * D * D, D, SE, blk, tid);
            }
            PH_END;
            PH_BEGIN(5)
#pragma unroll 1
                for (int tk = blk; tk < 4 * NGRP; tk += G) s5_state_task(lds, UH, BT2 + (size_t)j * NGRP * 128 * 256, LB16 + (size_t)j * NGRP * 64 * 2, out, j, tk, tid);
#pragma unroll 1
                for (int tk = gw; tk < MS * NGRP; tk += NGW)
                    s5_sample_task(US, st_re, st_im, LBT + (size_t)j * NGRP * 64 * 2, BBART + (size_t)j * NGRP * 64 * 32, c_re + (size_t)j * NGRP * 1024, c_im + (size_t)j * NGRP * 1024, ssm_d + j * TOKW, out, YB, j, tk, lane);
#pragma unroll 1
                for (int un = blk; un < 256; un += G) attn_prompt_unit(lds, QB, mkv_l, MIX, un, tid);
#pragma unroll 1
                for (int un = blk; un < 256; un += G) attn_sample_unit(lds, QB, cache_k, cache_v, MIX, li, un, tid);
            }
            PH_END;
            PH_BEGIN(6)
                int kh = KH; asm volatile("" : "+s"(kh)); pg8::Gemm g{UH, TB + (size_t)j * NGRP * 256 * KH, NGRP * 512, NGRP * 256, kh}; ToepOrder S{G, blk};
                EpiToep E{YB};
                pg8::gemm_phase<EpiToep, ToepOrder, true, true>(lds, g, S, E);
            }
            PH_END;
            PH_BEGIN(7)
                pg8::Gemm g{YB, W_GLU + (size_t)j * TOKW * TOKW, MT, TOKW, TOKW}; pg8::StaticOrder S; S.init(MT, TOKW, G, blk);
                EpiGlu E{YB, b_glu + j * TOKW, MIX};
                pg8::gemm_phase<EpiGlu, pg8::StaticOrder, true, true>(lds, g, S, E);
            }
            PH_END;
        }
        PH_BEGIN(8)
            const bf16* wo = (li & 1) ? W_SSMOUT + (size_t)j * D * D : W_SGOUT + (size_t)j * D * D;
            pg8::Gemm g{MIX, wo, MP, D, D}; pg8::StaticOrder S; S.init(MP, D, G, blk);
            EpiRes E{XRES, XB, ss_ffn};
            pg8::gemm_phase<EpiRes, pg8::StaticOrder, true, true>(lds, g, S, E);
            SEpiRes SE{XRES, XB, ss_ffn}; skinny_sample(lds, MIX + (size_t)MP * D, wo, D, SE, blk, tid);
        }
        PH_END;
        PH_BEGIN(9)
            pg8::Gemm g{XB, W_UP + (size_t)li * NUP * D, MT, NUP, D}; pg8::StaticOrder S; S.init(MT, NUP, G, blk);
            EpiUp E{ss_ffn, AG, out, li};
            pg8::gemm_phase<EpiUp, pg8::StaticOrder, true, true>(lds, g, S, E);
        }
        PH_END;
        PH_BEGIN(10)
            const float* cw = conv_w + (size_t)li * 3 * DFF; const float* cb = conv_b + (size_t)li * DFF;
#pragma unroll 1
            for (int e = gtid; e < MT * (DFF / 8); e += NT) {
                const int r = e / (DFF / 8), c = (e % (DFF / 8)) * 8;
                const v4u a0w = *(const v4u*)(AG + (size_t)r * NUP + c), gw_ = *(const v4u*)(AG + (size_t)r * NUP + DFF + c);
                float a1[8], a2[8];
                if (r < MP) { const int t = r & (SEQ - 1); v4u w1 = (v4u){0u, 0u, 0u, 0u}, w2 = (v4u){0u, 0u, 0u, 0u};
                    if (t >= 1) w1 = *(const v4u*)(AG + (size_t)(r - 1) * NUP + c); if (t >= 2) w2 = *(const v4u*)(AG + (size_t)(r - 2) * NUP + c);
                    a1[0] = bflo(w1.x); a1[1] = bfhi(w1.x); a1[2] = bflo(w1.y); a1[3] = bfhi(w1.y); a1[4] = bflo(w1.z); a1[5] = bfhi(w1.z); a1[6] = bflo(w1.w); a1[7] = bfhi(w1.w);
                    a2[0] = bflo(w2.x); a2[1] = bfhi(w2.x); a2[2] = bflo(w2.y); a2[3] = bfhi(w2.y); a2[4] = bflo(w2.z); a2[5] = bfhi(w2.z); a2[6] = bflo(w2.w); a2[7] = bfhi(w2.w); }
                else if (r < MREAL) { const int b = r - MP; const float* p2 = st_conv + ((size_t)(li * MS + b) * 2) * DFF + c; const float* p1 = p2 + DFF;
                    const f32x4 x0 = *(const f32x4*)p2, x1 = *(const f32x4*)(p2 + 4), y0 = *(const f32x4*)p1, y1 = *(const f32x4*)(p1 + 4);
                    a2[0] = x0[0]; a2[1] = x0[1]; a2[2] = x0[2]; a2[3] = x0[3]; a2[4] = x1[0]; a2[5] = x1[1]; a2[6] = x1[2]; a2[7] = x1[3];
                    a1[0] = y0[0]; a1[1] = y0[1]; a1[2] = y0[2]; a1[3] = y0[3]; a1[4] = y1[0]; a1[5] = y1[1]; a1[6] = y1[2]; a1[7] = y1[3];
                    float* co = out + OFF_CONVS + ((size_t)(li * MS + b) * 2) * DFF + c; *(f32x4*)co = y0; *(f32x4*)(co + 4) = y1; }
                else {
#pragma unroll
                    for (int i = 0; i < 8; ++i) { a1[i] = 0.f; a2[i] = 0.f; } }
                const float a0[8] = {bflo(a0w.x), bfhi(a0w.x), bflo(a0w.y), bfhi(a0w.y), bflo(a0w.z), bfhi(a0w.z), bflo(a0w.w), bfhi(a0w.w)};
                const float gg[8] = {bflo(gw_.x), bfhi(gw_.x), bflo(gw_.y), bfhi(gw_.y), bflo(gw_.z), bfhi(gw_.z), bflo(gw_.w), bfhi(gw_.w)};
                float yv[8];
#pragma unroll
                for (int h2 = 0; h2 < 2; ++h2) { const f32x4 k0 = *(const f32x4*)(cw + c + 4 * h2), k1 = *(const f32x4*)(cw + DFF + c + 4 * h2), k2 = *(const f32x4*)(cw + 2 * DFF + c + 4 * h2), kb = *(const f32x4*)(cb + c + 4 * h2);
#pragma unroll
                    for (int i = 0; i < 4; ++i) { const int q = 4 * h2 + i; const float cc = kb[i] + k0[i] * a2[q] + k1[i] * a1[q] + k2[i] * a0[q]; yv[q] = cc * sigmoid_f(cc) * gg[q]; } }
                v4u ow; ow.x = pk2(yv[0], yv[1]); ow.y = pk2(yv[2], yv[3]); ow.z = pk2(yv[4], yv[5]); ow.w = pk2(yv[6], yv[7]);
                *(v4u*)(YF + (size_t)r * DFF + c) = ow;
            }
        }
        PH_END;
        PH_BEGIN(11)
            pg8::Gemm g{YF, W_DOWN + (size_t)li * D * DFF, MP, D, DFF}; pg8::StaticOrder S; S.init(MP, D, G, blk);
            EpiRes E{XRES, XB, ss_next};
            pg8::gemm_phase<EpiRes, pg8::StaticOrder, true, true>(lds, g, S, E);
            SEpiRes SE{XRES, XB, ss_next}; skinny_sample(lds, YF + (size_t)MP * DFF, W_DOWN + (size_t)li * D * DFF, DFF, SE, blk, tid);
        }
        PH_END;
    }
    PH_BEGIN(12)
#pragma unroll 1
        for (int r = gw; r < MREAL; r += NGW) {
            const f32x4* xr = (const f32x4*)(XRES + (size_t)r * D); f32x4 v[8]; float s = 0.f;
#pragma unroll
            for (int jj = 0; jj < 8; ++jj) { v[jj] = xr[lane + 64 * jj]; s += dot4(v[jj]); }
            const float rs = rsqrtf(wave_sum(s) * (1.f / 2048.f) + EPS);
            f32x4* o = (f32x4*)(out + (r < MP ? OFF_YP + (size_t)r * D : OFF_YS + (size_t)(r - MP) * D));
#pragma unroll
            for (int jj = 0; jj < 8; ++jj) o[lane + 64 * jj] = v[jj] * rs * ((const f32x4*)g_final)[lane + 64 * jj];
        }
    }
    PH_END;
#undef PH_BEGIN
#undef PH_END
}
#undef x_prompt
#undef x_sample
#undef mem_prompt
#undef cache_k
#undef cache_v
#undef st_re
#undef st_im
#undef st_conv
#undef g_mix
#undef g_ffn
#undef g_mem
#undef g_final
#undef w_mem_kv
#undef sg_w_in
#undef sg_w_out
#undef sg_g_v
#undef sg_w_s
#undef sg_b_s
#undef ssm_w_in
#undef ssm_w_out
#undef lam_re
#undef lam_im
#undef log_dt
#undef b_re
#undef b_im
#undef c_re
#undef c_im
#undef ssm_d
#undef w_glu
#undef b_glu
#undef w_up
#undef conv_w
#undef conv_b
#undef w_down
#undef ctl
#undef SSX
#undef SSV
#undef SSMEM
#undef W_SGIN
#undef W_SSMIN
#undef W_SGOUT
#undef W_SSMOUT
#undef W_GLU
#undef W_UP
#undef W_DOWN
#undef W_MEM
#undef WSB
#undef TB
#undef BT2
#undef LBT
#undef LB16
#undef BBART
#undef XRES
#undef XB
#undef MEMB
#undef MKV
#undef ZU
#undef ZV
#undef QB
#undef MIX
#undef AG
#undef YF
#undef UH
#undef YB
#undef US
#undef ws
#undef out

#ifndef MK_ONE_LAUNCH
#define MK_ONE_LAUNCH 1
#endif
extern "C" void kernel_launch(void* const* d_in, const int* in_sizes, int n_in, void* d_out, int out_size, void* d_ws, size_t ws_size, hipStream_t stream) {
    static int grid = 0;
    if (grid == 0) {
        if (n_in != 34 || (size_t)out_size != OUT_TOTAL || ws_size < WS_END) { fprintf(stderr, "kernel_launch: unexpected shapes (n_in %d, out %d, ws %zu)\n", n_in, out_size, ws_size); grid = -1; return; }
        int dev = 0, cus = 0;
        if (hipGetDevice(&dev) != hipSuccess || hipDeviceGetAttribute(&cus, hipDeviceAttributeMultiprocessorCount, dev) != hipSuccess) { grid = -1; return; }
        if (hipFuncSetAttribute((const void*)trunk_fwd, hipFuncAttributeMaxDynamicSharedMemorySize, LDS_BYTES) != hipSuccess) { fprintf(stderr, "kernel_launch: hipFuncSetAttribute failed\n"); grid = -1; return; }
        int per_cu = 0;
        if (hipOccupancyMaxActiveBlocksPerMultiprocessor(&per_cu, (const void*)trunk_fwd, NTHR, LDS_BYTES) != hipSuccess || per_cu < 1) fprintf(stderr, "kernel_launch: occupancy query says %d\n", per_cu);
        (void)hipGetLastError();
        grid = cus;
    }
    if (grid < 0) return;
    if (hipMemsetAsync((char*)d_ws + WS_CTL, 0, CTL_ZERO_BYTES, stream) != hipSuccess) return;
    Args a{};
    for (int i = 0; i < 34; ++i) a.in[i] = (const float*)d_in[i];
    a.out = (float*)d_out; a.ws = (unsigned char*)d_ws;
#if MK_ONE_LAUNCH
    a.lo = 0; a.hi = NPHASE;
    hipLaunchKernelGGL(trunk_fwd, dim3(grid), dim3(NTHR), LDS_BYTES, stream, a);
#else
    for (int p = 0; p < NPHASE; ++p) { a.lo = p; a.hi = p + 1; hipLaunchKernelGGL(trunk_fwd, dim3(grid), dim3(NTHR), LDS_BYTES, stream, a); }
#endif
#ifdef OUTMASK
    {
        const size_t offs[12] = {OFF_YP, OFF_YS, OFF_MK, OFF_MV, OFF_SRP, OFF_SIP, OFF_CONVP, OFF_SRS, OFF_SIS, OFF_CONVS, OFF_SGV, OUT_TOTAL};
        for (int i = 0; i < 11; ++i) if (!((OUTMASK >> i) & 1)) (void)hipMemsetAsync((float*)d_out + offs[i], 0, (offs[i + 1] - offs[i]) * 4, stream);
    }
#endif
}
```

```cpp
#include <hip/hip_runtime.h>
#include <cstdio>
#include <cstdint>
namespace pg8 {
#define PG8_LAS __attribute__((address_space(3)))
typedef unsigned short bf16_t;
typedef short bf16x8 __attribute__((ext_vector_type(8)));
typedef float f32x4 __attribute__((ext_vector_type(4)));
typedef unsigned u32x4 __attribute__((ext_vector_type(4)));
constexpr int BM = 256, BK = 64, HALF = 128, HTB = HALF * BK * 2  , STAGE_BYTES = 8 * HTB, NXCD = 8, WGM = 8;

__host__ __device__ __forceinline__ int lds_byte(int r, int c) { const int st = (r >> 4) * 2 + (c >> 5), rr = r & 15, cc = c & 31, ob = rr * 64 + cc * 2; return st * 1024 + (ob ^ (((ob >> 9) & 1) << 5)); }
__host__ __device__ __forceinline__ void stage_rc(int b, int& R, int& C) { const int st = b / 1024, sb = b % 1024, swz = sb ^ (((sb >> 9) & 1) << 5); R = (st >> 1) * 16 + swz / 64; C = (st & 1) * 32 + (swz % 64) / 2; }
__host__ __device__ __forceinline__ int perm32(int rho) { const int n = rho >> 4, i = rho & 15; return 8 * (i >> 2) + 4 * n + (i & 3); }

struct Unit { int pm, pn; };
struct Gemm { const bf16_t* A; const bf16_t* Bt; int M, N, K; };

struct StaticOrder {
    int nM, nN, nwg, G, c;
    __host__ __device__ void init(int M, int N, int G_, int c_) { nM = M / BM; nN = N / BM; nwg = nM * nN; G = G_; c = c_; }
    __host__ __device__ bool next(int i, Unit& u) const {
        const long L = (long)i * G + c; if (L >= nwg) return false;
        int wgid = (int)L; { const int q = nwg / NXCD, r = nwg % NXCD, xcd = wgid % NXCD, off = wgid / NXCD; wgid = (xcd < r ? xcd * (q + 1) : r * (q + 1) + (xcd - r) * q) + off; }
        const int nig = WGM * nN, gid = wgid / nig, fm = gid * WGM, gsz = (nM - fm) < WGM ? (nM - fm) : WGM;
        u.pm = fm + ((wgid % nig) % gsz); u.pn = (wgid % nig) / gsz; return true;
    }
    __device__ __forceinline__ void a_ready(const Unit&) const {}
    __device__ __forceinline__ void done(const Unit&) const {}
};
__device__ __forceinline__ unsigned cvt_pk_bf16(float lo, float hi) { unsigned r; asm volatile("v_cvt_pk_bf16_f32 %0, %1, %2" : "=v"(r) : "v"(lo), "v"(hi)); return r; }
typedef float f32x2 __attribute__((ext_vector_type(2)));
template <class Epi, class Sched, bool ALIGN_EPI = false, bool SP2 = false>
__device__ __forceinline__ void gemm_phase(PG8_LAS unsigned char* lds, const Gemm g, const Sched& S, const Epi& E) {
    int tid = threadIdx.x; asm volatile("" : "+v"(tid)); const int wid = __builtin_amdgcn_readfirstlane(tid >> 6), lane = tid & 63, wr = wid >> 2, wc = wid & 3, fr = lane & 15, fq = lane >> 4;
    const int K = g.K, nt = K / BK;
    unsigned voffA[2], voffB[2];
#pragma unroll
    for (int i = 0; i < 2; ++i) { int R, C; stage_rc(tid * 16 + i * 8192, R, C); const int Rb = Epi::PERM ? ((R & ~31) + perm32(R & 31)) : R;
        voffA[i] = (unsigned)(R * K + C) * 2u; voffB[i] = (unsigned)(Rb * K + C) * 2u; }
    const size_t kstep = (size_t)(BK * 2);
    const size_t hstep = (size_t)HALF * K * 2;
    const size_t tstep = 2 * hstep;
    const unsigned ldsw = (unsigned)wid * 1024u;
    const int aoff = lds_byte(wr * 64 + fr, fq * 8), boff = lds_byte(wc * 32 + fr, fq * 8);
#define PG8_SA(b, h) (((b) * 2 + (h)) * HTB)
#define PG8_SB(b, h) ((4 + (b) * 2 + (h)) * HTB)
#define PG8_STAGE(bufoff, gbase, voff) do { _Pragma("unroll") for (int _i = 0; _i < 2; ++_i) \
        __builtin_amdgcn_global_load_lds((const unsigned*)((const char*)(gbase) + (voff)[_i]), (PG8_LAS unsigned*)(lds + (bufoff) + ldsw + _i * 8192), 16, 0, 0); } while (0)
#define PG8_LDA(dst, b, h) do { _Pragma("unroll") for (int m = 0; m < 4; ++m) _Pragma("unroll") for (int k = 0; k < 2; ++k) dst[m][k] = *(const PG8_LAS bf16x8*)(lds + PG8_SA(b, h) + aoff + m * 2048 + k * 1024); } while (0)
#define PG8_LDB(dst, b, h) do { _Pragma("unroll") for (int n = 0; n < 2; ++n) _Pragma("unroll") for (int k = 0; k < 2; ++k) dst[n][k] = *(const PG8_LAS bf16x8*)(lds + PG8_SB(b, h) + boff + n * 2048 + k * 1024); } while (0)
#define PG8_MMA(ai, bj, At, Bt) do { __builtin_amdgcn_s_setprio(1); _Pragma("unroll") for (int m = 0; m < 4; ++m) _Pragma("unroll") for (int n = 0; n < 2; ++n) _Pragma("unroll") for (int k = 0; k < 2; ++k) \
        acc[ai][bj][m][n] = __builtin_amdgcn_mfma_f32_16x16x32_bf16(Bt[n][k], At[m][k], acc[ai][bj][m][n], 0, 0, 0); __builtin_amdgcn_s_setprio(0); } while (0)
#define PG8_WAIT_V(n) asm volatile("s_waitcnt vmcnt(" #n ")" ::: "memory")
#define PG8_WAIT_L(n) asm volatile("s_waitcnt lgkmcnt(" #n ")" ::: "memory")
#define PG8_BAR __builtin_amdgcn_s_barrier()
#define PG8_SCHED __builtin_amdgcn_sched_barrier(0)
    Unit cur, nxt; int ui = 0;
    if (!S.next(0, cur)) return;
    f32x4 acc[2][2][4][2];
#pragma unroll
    for (int a = 0; a < 2; ++a)
#pragma unroll
        for (int b = 0; b < 2; ++b)
#pragma unroll
            for (int m = 0; m < 4; ++m)
#pragma unroll
                for (int n = 0; n < 2; ++n) acc[a][b][m][n] = (f32x4){0.f, 0.f, 0.f, 0.f};
    bf16x8 At[4][2], B0[2][2], B1[2][2];
    const char* cA = (const char*)g.A + (size_t)cur.pm * tstep; const char* cB = (const char*)g.Bt + (size_t)cur.pn * tstep;
    S.a_ready(cur);
    if constexpr (SP2) {
        PG8_STAGE(PG8_SB(0, 0), cB, voffB); PG8_STAGE(PG8_SB(0, 1), cB + hstep, voffB); PG8_STAGE(PG8_SA(0, 0), cA, voffA); PG8_STAGE(PG8_SA(0, 1), cA + hstep, voffA);
        if (wr == 1) PG8_BAR;
        PG8_WAIT_V(2); PG8_BAR;
        PG8_STAGE(PG8_SB(1, 0), cB + kstep, voffB); PG8_STAGE(PG8_SA(1, 0), cA + kstep, voffA); PG8_STAGE(PG8_SB(1, 1), cB + hstep + kstep, voffB);
        PG8_WAIT_V(6); PG8_BAR;
    } else {
        PG8_STAGE(PG8_SB(0, 0), cB, voffB); PG8_STAGE(PG8_SA(0, 0), cA, voffA); PG8_STAGE(PG8_SB(0, 1), cB + hstep, voffB); PG8_STAGE(PG8_SA(0, 1), cA + hstep, voffA);
        if (wr == 1) PG8_BAR;
        PG8_WAIT_V(4); PG8_BAR;
        PG8_STAGE(PG8_SB(1, 0), cB + kstep, voffB); PG8_STAGE(PG8_SA(1, 0), cA + kstep, voffA); PG8_STAGE(PG8_SB(1, 1), cB + hstep + kstep, voffB);
        PG8_WAIT_V(6); PG8_BAR;
    }
    for (;;) {
        const bool has_next = S.next(ui + 1, nxt);
        const char* nA = has_next ? (const char*)g.A + (size_t)nxt.pm * tstep : cA; const char* nB = has_next ? (const char*)g.Bt + (size_t)nxt.pn * tstep : cB;
        for (int t = 0; t < nt; t += 2) {
            const bool last = (t == nt - 2);
            const char* a1 = cA + (size_t)(t + 1) * kstep;
            const char* a2 = last ? nA : cA + (size_t)(t + 2) * kstep; const char* b2 = last ? nB : cB + (size_t)(t + 2) * kstep;
            const char* a3 = a2 + kstep; const char* b3 = b2 + kstep;
            if (last && has_next) S.a_ready(nxt);
            if constexpr (SP2) {
            PG8_LDB(B0, 0, 0); PG8_LDB(B1, 0, 1); PG8_SCHED; PG8_LDA(At, 0, 0); PG8_STAGE(PG8_SA(1, 1), a1 + hstep, voffA);
            PG8_WAIT_V(8); PG8_WAIT_L(0); PG8_BAR; PG8_MMA(0, 0, At, B0); PG8_MMA(0, 1, At, B1); PG8_BAR; PG8_SCHED;
            PG8_LDA(At, 0, 1); PG8_STAGE(PG8_SB(0, 0), b2, voffB); PG8_STAGE(PG8_SB(0, 1), b2 + hstep, voffB); PG8_STAGE(PG8_SA(0, 0), a2, voffA);
            PG8_WAIT_V(8); PG8_WAIT_L(0); PG8_BAR; PG8_MMA(1, 0, At, B0); PG8_MMA(1, 1, At, B1); PG8_BAR; PG8_SCHED;
            PG8_LDB(B0, 1, 0); PG8_LDB(B1, 1, 1); PG8_SCHED; PG8_LDA(At, 1, 0); PG8_STAGE(PG8_SA(0, 1), a2 + hstep, voffA);
            PG8_WAIT_V(8); PG8_WAIT_L(0); PG8_BAR; PG8_MMA(0, 0, At, B0); PG8_MMA(0, 1, At, B1); PG8_BAR; PG8_SCHED;
            PG8_LDA(At, 1, 1); PG8_STAGE(PG8_SB(1, 0), b3, voffB); PG8_STAGE(PG8_SB(1, 1), b3 + hstep, voffB); PG8_STAGE(PG8_SA(1, 0), a3, voffA);
            PG8_WAIT_V(8); PG8_WAIT_L(0); PG8_BAR; PG8_MMA(1, 0, At, B0); PG8_MMA(1, 1, At, B1); PG8_BAR; PG8_SCHED;
            } else {
            PG8_LDB(B0, 0, 0); PG8_SCHED; PG8_LDA(At, 0, 0); PG8_STAGE(PG8_SA(1, 1), a1 + hstep, voffA);
            PG8_WAIT_L(8); PG8_BAR; PG8_WAIT_L(0); PG8_MMA(0, 0, At, B0); PG8_BAR; PG8_SCHED;
            PG8_LDB(B1, 0, 1); PG8_STAGE(PG8_SB(0, 0), b2, voffB);
            PG8_BAR; PG8_WAIT_L(0); PG8_MMA(0, 1, At, B1); PG8_BAR;
            PG8_LDA(At, 0, 1); PG8_STAGE(PG8_SA(0, 0), a2, voffA);
            PG8_BAR; PG8_WAIT_L(0); PG8_MMA(1, 0, At, B0); PG8_BAR; PG8_SCHED;
            PG8_STAGE(PG8_SB(0, 1), b2 + hstep, voffB);
            PG8_WAIT_V(6); PG8_BAR; PG8_MMA(1, 1, At, B1); PG8_BAR;
            PG8_LDB(B0, 1, 0); PG8_SCHED; PG8_LDA(At, 1, 0); PG8_STAGE(PG8_SA(0, 1), a2 + hstep, voffA);
            PG8_WAIT_L(8); PG8_BAR; PG8_WAIT_L(0); PG8_MMA(0, 0, At, B0); PG8_BAR; PG8_SCHED;
            PG8_LDB(B1, 1, 1); PG8_STAGE(PG8_SB(1, 0), b3, voffB);
            PG8_BAR; PG8_WAIT_L(0); PG8_MMA(0, 1, At, B1); PG8_BAR;
            PG8_LDA(At, 1, 1); PG8_STAGE(PG8_SA(1, 0), a3, voffA);
            PG8_BAR; PG8_WAIT_L(0); PG8_MMA(1, 0, At, B0); PG8_BAR; PG8_SCHED;
            PG8_STAGE(PG8_SB(1, 1), b3 + hstep, voffB);
            PG8_WAIT_V(6); PG8_BAR; PG8_MMA(1, 1, At, B1); PG8_BAR;
            }
        }
        if constexpr (ALIGN_EPI) { if (wr == 0) PG8_BAR; }
        if constexpr (!Epi::AFTER_DRAIN) { E(acc, cur, wr, wc, fr, fq); S.done(cur); }
        if (!has_next) break;
#pragma unroll
        for (int a = 0; a < 2; ++a)
#pragma unroll
            for (int b = 0; b < 2; ++b)
#pragma unroll
                for (int m = 0; m < 4; ++m)
#pragma unroll
                    for (int n = 0; n < 2; ++n) acc[a][b][m][n] = (f32x4){0.f, 0.f, 0.f, 0.f};
        cur = nxt; cA = nA; cB = nB; ++ui;
        if constexpr (ALIGN_EPI) { if (wr == 1) PG8_BAR; }
    }
    PG8_WAIT_V(0);
    if constexpr (!ALIGN_EPI) { if (wr == 0) PG8_BAR; }
    PG8_BAR;
    if constexpr (Epi::AFTER_DRAIN) { E.fused(acc, cur, wr, wc, fr, fq, lds, wid, lane); S.done(cur); }
#undef PG8_SA
#undef PG8_SB
#undef PG8_STAGE
#undef PG8_LDA
#undef PG8_LDB
#undef PG8_MMA
#undef PG8_WAIT_V
#undef PG8_WAIT_L
#undef PG8_BAR
#undef PG8_SCHED
}
}
#define LAS_BAR __attribute__((address_space(3)))
#define XB_TMO      128
#define XB_XCNT(j)  (256  + 64 * (j))
#define XB_XSUB(j)  (1280 + 64 * (j))
#define XB_XGEN(j)  (2304 + 64 * (j))
#define XB_TOP      3328
#define XB_TOPGEN   3392
#define XCD_BAR_WORDS 3456
#define XB_SPIN_CAP (1u << 18)

__device__ __forceinline__ unsigned xb_ld(unsigned* p)              { return __hip_atomic_load(p, __ATOMIC_RELAXED, __HIP_MEMORY_SCOPE_AGENT); }
__device__ __forceinline__ unsigned xb_add(unsigned* p, unsigned v) { return __hip_atomic_fetch_add(p, v, __ATOMIC_RELAXED, __HIP_MEMORY_SCOPE_AGENT); }
__device__ __forceinline__ unsigned xb_xcc_id() { return (unsigned)__builtin_amdgcn_s_getreg((3 << 11) | 20) & 0xFu; }
#define XB_SPIN(cond, bar) do { unsigned _sp = 0; while (cond) { __builtin_amdgcn_s_sleep(1); \
    if ((++_sp & 255u) == 0u) { if (xb_ld(&(bar)[XB_TMO])) break; if (_sp > XB_SPIN_CAP) { atomicAdd(&(bar)[XB_TMO], 1u); break; } } } } while (0)

struct XcdBarrier {
    unsigned* bar; unsigned x;
    volatile LAS_BAR unsigned* st;
};

__device__ __forceinline__ XcdBarrier xcd_barrier_post(unsigned* bar, volatile LAS_BAR unsigned* st) {
    XcdBarrier b; b.bar = bar; b.x = xb_xcc_id(); b.st = st;
    if (threadIdx.x == 0) (void)xb_add(&bar[XB_XCNT(b.x)], 1u);
    return b;
}
__device__ __forceinline__ void xcd_barrier_complete(unsigned* bar, unsigned x, unsigned& nloc, unsigned& nx) {
    const unsigned G = gridDim.x * gridDim.y * gridDim.z;
    unsigned sum, cnt, mine, sp = 0u;
    for (;;) {
        sum = 0u; cnt = 0u; mine = 0u;
#pragma unroll
        for (unsigned j = 0; j < 16; ++j) { const unsigned c = xb_ld(&bar[XB_XCNT(j)]); sum += c; cnt += (c > 0u) ? 1u : 0u; mine = (j == x) ? c : mine; }
        if (sum == G) break;
        __builtin_amdgcn_s_sleep(1);
        if ((++sp & 255u) == 0u) { if (xb_ld(&bar[XB_TMO])) break; if (sp > XB_SPIN_CAP) { atomicAdd(&bar[XB_TMO], 1u); break; } }
    }
    nloc = mine > 0u ? mine : 1u; nx = cnt > 0u ? cnt : 1u;
}

__device__ __forceinline__ void xcd_barrier(const XcdBarrier& b) {
    asm volatile("s_waitcnt vmcnt(0)" ::: "memory");
    __syncthreads();
    if (threadIdx.x == 0) {
        unsigned* bar = b.bar;
        __builtin_amdgcn_s_waitcnt(0);
        unsigned nloc = b.st[0], nx = b.st[1];
        if (nloc == 0u) { xcd_barrier_complete(bar, b.x, nloc, nx); b.st[0] = nloc; b.st[1] = nx; }
        const unsigned old = xb_add(&bar[XB_XSUB(b.x)], 1u);
        const unsigned gen = old / nloc;
        if (old + 1u == (gen + 1u) * nloc) {
            __builtin_amdgcn_fence(__ATOMIC_RELEASE, "agent");
            asm volatile("s_waitcnt vmcnt(0)" ::: "memory");
            const unsigned og = xb_add(&bar[XB_TOP], 1u);
            const unsigned tg = og / nx;
            if (og + 1u == (tg + 1u) * nx) xb_add(&bar[XB_TOPGEN], 1u);
            else XB_SPIN(xb_ld(&bar[XB_TOPGEN]) == tg, bar);
            __builtin_amdgcn_fence(__ATOMIC_ACQUIRE, "agent");
            xb_add(&bar[XB_XGEN(b.x)], 1u);
            asm volatile("s_waitcnt vmcnt(0)" ::: "memory");
        } else {
            XB_SPIN(xb_ld(&bar[XB_XGEN(b.x)]) == gen, bar);
            __builtin_amdgcn_fence(__ATOMIC_ACQUIRE, "agent");
            asm volatile("s_waitcnt vmcnt(0)" ::: "memory");
        }
    }
    __syncthreads();
}
#define GAS __attribute__((address_space(1)))
#define LAS __attribute__((address_space(3)))
typedef unsigned short bf16;
typedef unsigned v4u __attribute__((ext_vector_type(4)));
typedef unsigned v2u __attribute__((ext_vector_type(2)));
typedef float f32x4 __attribute__((ext_vector_type(4)));
typedef short bf16x8 __attribute__((ext_vector_type(8)));
typedef short bf16x4 __attribute__((ext_vector_type(4)));

constexpr int NWAVES = 8, NTHR = 512;
constexpr int D = 2048, SEQ = 2048, MP = 8192, MS = 128, MREAL = 8320, MT = 8448;
constexpr int MMEM = 1024, XAW = 512, TOKW = 1536, SGN = 3584, DFF = 5504, NUP = 11008;
constexpr int NGRP = 96, KH = 384;
constexpr float EPS = 1e-6f;
constexpr int NPHASE = 31;

constexpr size_t OFF_YP = 0, OFF_YS = 16777216, OFF_MK = 17039360, OFF_MV = 19136512, OFF_SRP = 21233664, OFF_SIP = 21282816,
                 OFF_CONVP = 21331968, OFF_SRS = 21508096, OFF_SIS = 23080960, OFF_CONVS = 24653824, OFF_SGV = 30289920, OUT_TOTAL = 30683136;

constexpr size_t MiB = 1u << 20;
constexpr size_t WS_CTL = 0, CTL_ZERO_BYTES = 1 * MiB;
constexpr size_t WS_WSGIN = 1 * MiB;
constexpr size_t WS_WSSMIN = WS_WSGIN + 28 * MiB;
constexpr size_t WS_WSGOUT = WS_WSSMIN + 16 * MiB;
constexpr size_t WS_WSSMOUT = WS_WSGOUT + 16 * MiB;
constexpr size_t WS_WGLU = WS_WSSMOUT + 16 * MiB;
constexpr size_t WS_WUP = WS_WGLU + 9 * MiB;
constexpr size_t WS_WDOWN = WS_WUP + 172 * MiB;
constexpr size_t WS_WMEM = WS_WDOWN + 86 * MiB;
constexpr size_t WS_WSB = WS_WMEM + 16 * MiB;
constexpr size_t WS_TB = WS_WSB + 1 * MiB;
constexpr size_t WS_BT2 = WS_TB + 36 * MiB;
constexpr size_t WS_LBT = WS_BT2 + 12 * MiB;
constexpr size_t WS_LB16 = WS_LBT + 128 * 1024;
constexpr size_t WS_BBAR = WS_LBT + 1 * MiB;
constexpr size_t WS_XRES = WS_BBAR + 2 * MiB;
constexpr size_t WS_XB = WS_XRES + 66 * MiB;
constexpr size_t WS_MEMB = WS_XB + 33 * MiB;
constexpr size_t WS_MKV = WS_MEMB + 4 * MiB;
constexpr size_t WS_ZU = WS_MKV + 8 * MiB;
constexpr size_t WS_ZV = WS_ZU + 25 * MiB;
constexpr size_t WS_Q = WS_ZV + 25 * MiB;
constexpr size_t WS_MIX = WS_Q + 9 * MiB;
constexpr size_t WS_AG = WS_MIX + 33 * MiB;
constexpr size_t WS_Y = WS_AG + 178 * MiB;
constexpr size_t WS_UH = WS_Y + 89 * MiB;
constexpr size_t WS_YB = WS_UH + 36 * MiB;
constexpr size_t WS_US = WS_YB + 25 * MiB;
constexpr size_t WS_FXA = WS_US + 1 * MiB;
constexpr size_t WS_FXG = WS_FXA + 3 * MiB;
constexpr size_t WS_END = WS_FXG + 2 * MiB;
constexpr int CW_BAR = 4096;
typedef unsigned long long ssq_t;
constexpr size_t CTL_SSX = 64 * 1024;
constexpr size_t CTL_SSV = 704 * 1024;
constexpr size_t CTL_SSMEM = 896 * 1024;
static_assert(CTL_SSX + 9 * MT * 8 <= CTL_SSV && CTL_SSV + 2 * MT * 8 <= CTL_SSMEM && CTL_SSMEM + 8192 <= CTL_ZERO_BYTES, "ctl map");

constexpr int LDS_BYTES = 147456, MISC_OFF = LDS_BYTES - 512, HALO_OFF = 131072;

__device__ __forceinline__ unsigned pk2(float lo, float hi) { return pg8::cvt_pk_bf16(lo, hi); }
__device__ __forceinline__ float bflo(unsigned w) { return __uint_as_float(w << 16); }
__device__ __forceinline__ float bfhi(unsigned w) { return __uint_as_float(w & 0xffff0000u); }
__device__ __forceinline__ float gelu_t(float x) { const float e = __builtin_amdgcn_exp2f(x * (-2.3022082f - 0.10294324f * x * x)); return x * __builtin_amdgcn_rcpf(1.f + e); }
__device__ __forceinline__ float sigmoid_f(float x) { return __builtin_amdgcn_rcpf(1.f + __builtin_amdgcn_exp2f(-1.4426950409f * x)); }
__device__ __forceinline__ ssq_t ss_fix(float v) { return (ssq_t)(long long)(v * 1073741824.0f); }
__device__ __forceinline__ float rstd_of(ssq_t ss, float inv_n) { return rsqrtf((float)ss * (1.0f / 1073741824.0f) * inv_n + EPS); }
__device__ __forceinline__ float wave_sum(float v) {
#pragma unroll
    for (int o = 1; o < 64; o <<= 1) v += __shfl_xor(v, o);
    return v;
}
__device__ __forceinline__ float wave_max(float v) {
#pragma unroll
    for (int o = 1; o < 64; o <<= 1) v = fmaxf(v, __shfl_xor(v, o));
    return v;
}
__device__ __forceinline__ void fadd_atomic(ssq_t* p, float v) { atomicAdd(p, ss_fix(v)); }
__device__ __forceinline__ f32x4 gelu4(f32x4 v) { return (f32x4){gelu_t(v[0]), gelu_t(v[1]), gelu_t(v[2]), gelu_t(v[3])}; }
__device__ __forceinline__ v4u pack8(f32x4 a, f32x4 b) { v4u w; w.x = pk2(a[0], a[1]); w.y = pk2(a[2], a[3]); w.z = pk2(b[0], b[1]); w.w = pk2(b[2], b[3]); return w; }
__device__ __forceinline__ float dot4(f32x4 a) { return (a[0] * a[0] + a[1] * a[1]) + (a[2] * a[2] + a[3] * a[3]); }

typedef const f32x4 (&AccRef)[2][2][4][2];
struct EpiSgIn {
    static constexpr bool PERM = true, AFTER_DRAIN = false;
    const ssq_t* ss; bf16* zu; bf16* zv; bf16* q; ssq_t* ssv;
    __device__ __forceinline__ void operator()(AccRef acc, const pg8::Unit& u, int wr, int wc, int fr, int fq) const {
        const int row0 = u.pm * 256 + wr * 64 + fr, colt = u.pn * 256 + wc * 32 + 8 * fq;
        const int kind = u.pn < 6 ? 0 : (u.pn < 12 ? 1 : 2);
#pragma unroll
        for (int ai = 0; ai < 2; ++ai)
#pragma unroll
            for (int m = 0; m < 4; ++m) {
                const int r = row0 + ai * 128 + m * 16; const float rs = rstd_of(ss[r], 1.f / 2048.f); float sq = 0.f;
#pragma unroll
                for (int bj = 0; bj < 2; ++bj) {
                    f32x4 v0 = acc[ai][bj][m][0] * rs, v1 = acc[ai][bj][m][1] * rs; const int c = colt + bj * 128;
                    if (kind < 2) { v0 = gelu4(v0); v1 = gelu4(v1); }
                    if (kind == 1) sq += dot4(v0) + dot4(v1);
                    bf16* dst = kind == 0 ? zu + (size_t)r * TOKW + c : (kind == 1 ? zv + (size_t)r * TOKW + (c - TOKW) : q + (size_t)r * XAW + (c - 2 * TOKW));
                    *(v4u*)dst = pack8(v0, v1);
                }
                if (kind == 1) { sq += __shfl_xor(sq, 16); sq += __shfl_xor(sq, 32); if (fq == 0) fadd_atomic(ssv + r, sq); }
                asm volatile("" ::: "memory");
            }
    }
};
struct EpiRes {
    static constexpr bool PERM = false, AFTER_DRAIN = false;
    float* xres; bf16* xb; ssq_t* ssn;
    __device__ __forceinline__ void operator()(AccRef acc, const pg8::Unit& u, int wr, int wc, int fr, int fq) const {
        const int row0 = u.pm * 256 + wr * 64 + fr, col0 = u.pn * 256 + wc * 32 + 4 * fq;
#pragma unroll
        for (int ai = 0; ai < 2; ++ai)
#pragma unroll
            for (int m = 0; m < 4; ++m) {
                const int r = row0 + ai * 128 + m * 16; float sq = 0.f;
                float* xp = xres + (size_t)r * D + col0; bf16* bp = xb + (size_t)r * D + col0;
#pragma unroll
                for (int bj = 0; bj < 2; ++bj)
#pragma unroll
                    for (int n = 0; n < 2; ++n) { const int off = bj * 128 + n * 16; const f32x4 o = *(const f32x4*)(xp + off) + acc[ai][bj][m][n]; *(f32x4*)(xp + off) = o; sq += dot4(o);
                        v2u w; w.x = pk2(o[0], o[1]); w.y = pk2(o[2], o[3]); *(v2u*)(bp + off) = w; }
                sq += __shfl_xor(sq, 16); sq += __shfl_xor(sq, 32); if (fq == 0) fadd_atomic(ssn + r, sq);
                asm volatile("" ::: "memory");
            }
    }
};
__device__ __forceinline__ float dpp_f(float old, float src, const int ctrl_sel) {
    const int o = __builtin_bit_cast(int, old), v = __builtin_bit_cast(int, src); int r;
    if (ctrl_sel == 0) r = __builtin_amdgcn_update_dpp(o, v, 0x111, 0xf, 0xf, false);
    else if (ctrl_sel == 1) r = __builtin_amdgcn_update_dpp(o, v, 0x112, 0xf, 0xf, false);
    else if (ctrl_sel == 2) r = __builtin_amdgcn_update_dpp(o, v, 0x121, 0xf, 0xf, false);
    else r = __builtin_amdgcn_update_dpp(o, v, 0x122, 0xf, 0xf, false);
    return __builtin_bit_cast(float, r);
}
struct EpiUp {
    static constexpr bool PERM = true, AFTER_DRAIN = false;
    const ssq_t* ss; bf16* yf; float* out; const float* stc; const float* cw; const float* cb; float* fxa; float* fxg; LAS float* halo; int layer;
    __device__ __forceinline__ void operator()(AccRef acc, const pg8::Unit& u, int wr, int wc, int fr, int fq) const {
        const int row0 = u.pm * 256 + wr * 64 + fr, cl = wc * 32 + 8 * fq, c0 = u.pn * 128 + cl;
        float rs[2][4];
#pragma unroll
        for (int ai = 0; ai < 2; ++ai)
#pragma unroll
            for (int m = 0; m < 4; ++m) rs[ai][m] = rstd_of(ss[row0 + ai * 128 + m * 16], 1.f / 2048.f);
        const bool sample = (u.pm == MP / 256);
        if (!sample) {
            if (fr >= 14) {
#pragma unroll
                for (int ai = 0; ai < 2; ++ai)
#pragma unroll
                    for (int n = 0; n < 2; ++n) *(LAS f32x4*)(halo + ((2 * ai + wr) * 2 + (fr - 14)) * 128 + cl + 4 * n) = acc[ai][0][3][n] * rs[ai][3];
            }
            asm volatile("s_waitcnt lgkmcnt(0)" ::: "memory"); __builtin_amdgcn_s_barrier(); asm volatile("" ::: "memory");
        }
#pragma unroll
        for (int n = 0; n < 2; ++n) {
            const int c = c0 + 4 * n;
            const f32x4 k0 = *(const f32x4*)(cw + c), k1 = *(const f32x4*)(cw + DFF + c), k2 = *(const f32x4*)(cw + 2 * DFF + c), kb = *(const f32x4*)(cb + c);
#pragma unroll
            for (int ai = 0; ai < 2; ++ai) {
                f32x4 prev = (f32x4){0.f, 0.f, 0.f, 0.f};
                if (!sample && (ai + wr) > 0 && fr >= 14) prev = *(const LAS f32x4*)(halo + ((2 * ai + wr - 1) * 2 + (fr - 14)) * 128 + cl + 4 * n);
#pragma unroll
                for (int m = 0; m < 4; ++m) {
                    const int r = row0 + ai * 128 + m * 16; const f32x4 a = acc[ai][0][m][n] * rs[ai][m], g = acc[ai][1][m][n] * rs[ai][m];
                    f32x4 p1, p2;
                    if (!sample) {
#pragma unroll
                        for (int i = 0; i < 4; ++i) { p1[i] = dpp_f(dpp_f(0.f, prev[i], 2), a[i], 0); p2[i] = dpp_f(dpp_f(0.f, prev[i], 3), a[i], 1); }
                    } else if (r < MREAL) {
                        const float* sp = stc + ((size_t)(r - MP) * 2) * DFF + c; p2 = *(const f32x4*)sp; p1 = *(const f32x4*)(sp + DFF);
                        float* co = out + OFF_CONVS + ((size_t)(layer * MS + (r - MP)) * 2) * DFF + c; *(f32x4*)co = p1; *(f32x4*)(co + DFF) = a;
                    } else { p1 = prev; p2 = prev; }
                    f32x4 y;
#pragma unroll
                    for (int i = 0; i < 4; ++i) { const float cc = kb[i] + k0[i] * p2[i] + k1[i] * p1[i] + k2[i] * a[i]; y[i] = cc * sigmoid_f(cc) * g[i]; }
                    if (r < MREAL) { v2u w; w.x = pk2(y[0], y[1]); w.y = pk2(y[2], y[3]); *(v2u*)(yf + (size_t)r * DFF + c) = w; }
                    if (!sample) {
                        const int lr = ai * 128 + wr * 64 + m * 16 + fr;
                        if (lr < 2) { *(f32x4*)(fxa + ((size_t)(u.pm * 4 + lr)) * DFF + c) = a; *(f32x4*)(fxg + ((size_t)(u.pm * 2 + lr)) * DFF + c) = g; }
                        if (lr >= 254) { *(f32x4*)(fxa + ((size_t)(u.pm * 4 + lr - 252)) * DFF + c) = a;
                            if ((u.pm & 7) == 7) *(f32x4*)(out + OFF_CONVP + ((size_t)((layer * 4 + (u.pm >> 3)) * 2 + (lr - 254))) * DFF + c) = a; }
                    }
                    prev = a;
                }
            }
        }
    }
};
struct EpiSsmIn {
    static constexpr bool PERM = true, AFTER_DRAIN = false;
    const ssq_t* ss; bf16* uh; float* us; bf16* q;
    __device__ __forceinline__ void operator()(AccRef acc, const pg8::Unit& u, int wr, int wc, int fr, int fq) const {
        const int row0 = u.pm * 256 + wr * 64 + fr, colt = u.pn * 256 + wc * 32 + 8 * fq;
#pragma unroll
        for (int ai = 0; ai < 2; ++ai)
#pragma unroll
            for (int m = 0; m < 4; ++m) {
                const int r = row0 + ai * 128 + m * 16; const float rs = rstd_of(ss[r], 1.f / 2048.f);
#pragma unroll
                for (int bj = 0; bj < 2; ++bj) {
                    const f32x4 v0 = acc[ai][bj][m][0] * rs, v1 = acc[ai][bj][m][1] * rs; const int c = colt + bj * 128;
                    if (u.pn < 6) {
                        if (r < MP) { const int h = c >> 4, c0 = c & 15; *(v4u*)(uh + ((size_t)(h * 512 + (r >> 4)) * KH + (r & 15) * 16 + c0)) = pack8(v0, v1); }
                        else if (r < MREAL) { float* o = us + (size_t)(r - MP) * TOKW + c; *(f32x4*)o = v0; *(f32x4*)(o + 4) = v1; }
                    } else *(v4u*)(q + (size_t)r * XAW + (c - TOKW)) = pack8(v0, v1);
                }
                asm volatile("" ::: "memory");
            }
    }
};
struct EpiToep {
    static constexpr bool PERM = true, AFTER_DRAIN = false;
    bf16* yb;
    __device__ __forceinline__ void operator()(AccRef acc, const pg8::Unit& u, int wr, int wc, int fr, int fq) const {
        const int h = u.pn, mh = u.pm - 2 * h;
#pragma unroll
        for (int ai = 0; ai < 2; ++ai)
#pragma unroll
            for (int m = 0; m < 4; ++m) {
                const int ml = mh * 256 + ai * 128 + wr * 64 + m * 16 + fr;
#pragma unroll
                for (int bj = 0; bj < 2; ++bj) {
                    const int cl = bj * 128 + wc * 32 + 8 * fq, tau = cl >> 4, c0 = cl & 15;
                    *(v4u*)(yb + (size_t)(ml * 16 + tau) * TOKW + h * 16 + c0) = pack8(gelu4(acc[ai][bj][m][0]), gelu4(acc[ai][bj][m][1]));
                    __builtin_amdgcn_sched_barrier(0);
                }
            }
    }
};
struct EpiGlu {
    static constexpr bool PERM = true, AFTER_DRAIN = false;
    const bf16* yb; const float* bias; bf16* mix;
    __device__ __forceinline__ void operator()(AccRef acc, const pg8::Unit& u, int wr, int wc, int fr, int fq) const {
        const int row0 = u.pm * 256 + wr * 64 + fr, colt = u.pn * 256 + wc * 32 + 8 * fq;
#pragma unroll
        for (int ai = 0; ai < 2; ++ai)
#pragma unroll
            for (int m = 0; m < 4; ++m) {
                const int r = row0 + ai * 128 + m * 16;
#pragma unroll
                for (int bj = 0; bj < 2; ++bj) {
                    const int c = colt + bj * 128; const f32x4 b0 = *(const f32x4*)(bias + c), b1 = *(const f32x4*)(bias + c + 4);
                    const v4u yw = *(const v4u*)(yb + (size_t)r * TOKW + c);
                    const f32x4 g0 = acc[ai][bj][m][0] + b0, g1 = acc[ai][bj][m][1] + b1;
                    f32x4 o0, o1;
                    o0[0] = bflo(yw.x) * sigmoid_f(g0[0]); o0[1] = bfhi(yw.x) * sigmoid_f(g0[1]); o0[2] = bflo(yw.y) * sigmoid_f(g0[2]); o0[3] = bfhi(yw.y) * sigmoid_f(g0[3]);
                    o1[0] = bflo(yw.z) * sigmoid_f(g1[0]); o1[1] = bfhi(yw.z) * sigmoid_f(g1[1]); o1[2] = bflo(yw.w) * sigmoid_f(g1[2]); o1[3] = bfhi(yw.w) * sigmoid_f(g1[3]);
                    *(v4u*)(mix + (size_t)r * D + c) = pack8(o0, o1);
                    asm volatile("" ::: "memory");
                }
            }
    }
};
struct EpiMem {
    static constexpr bool PERM = false, AFTER_DRAIN = false;
    const ssq_t* ssm; float* out; bf16* mkv;
    __device__ __forceinline__ void operator()(AccRef acc, const pg8::Unit& u, int wr, int wc, int fr, int fq) const {
        const int row0 = u.pm * 256 + wr * 64 + fr, col0 = u.pn * 256 + wc * 32 + 4 * fq;
#pragma unroll
        for (int ai = 0; ai < 2; ++ai)
#pragma unroll
            for (int m = 0; m < 4; ++m) {
                const int r = row0 + ai * 128 + m * 16; const float rs = rstd_of(ssm[r], 1.f / 2048.f);
#pragma unroll
                for (int bj = 0; bj < 2; ++bj)
#pragma unroll
                    for (int n = 0; n < 2; ++n) { const int c = col0 + bj * 128 + n * 16, li = c >> 10, cc = c & 1023; const f32x4 v = acc[ai][bj][m][n] * rs;
                        *(f32x4*)(out + (cc < 512 ? OFF_MK : OFF_MV) + (size_t)(li * 1024 + r) * 512 + (cc & 511)) = v;
                        v2u w; w.x = pk2(v[0], v[1]); w.y = pk2(v[2], v[3]); *(v2u*)(mkv + (size_t)(li * 1024 + r) * 1024 + cc) = w; }
            }
    }
};
struct ToepOrder {
    int G, c;
    __device__ bool next(int i, pg8::Unit& u) const { const int L = i * G + c; if (L >= 2 * NGRP) return false; const int h = L >> 1; u.pm = 2 * h + (L & 1); u.pn = h; return true; }
    __device__ __forceinline__ void a_ready(const pg8::Unit&) const {}
    __device__ __forceinline__ void done(const pg8::Unit&) const {}
};

constexpr int P0_TLD = 130;
constexpr int P0_T0 = 896, P0_T1 = P0_T0 + 512, P0_T2 = P0_T1 + 512, P0_T3 = P0_T2 + 512, P0_T4 = P0_T3 + 288, P0_T5 = P0_T4 + 5504, P0_T6 = P0_T5 + 2752, P0_NTILES = P0_T6 + 512;
struct P0Desc { const float* W; const float* gn; bf16* WT; int K, N, roff, tile, perm; };
struct Args;
__device__ __forceinline__ P0Desc p0_decode(int t, const float* const* in, unsigned char* wsb) {
    P0Desc d; d.gn = nullptr; d.roff = 0; d.perm = 0;
    if (t < P0_T0) { const int mi = t / 448; d.tile = t - mi * 448; d.W = in[13] + (size_t)mi * D * SGN; d.gn = in[8] + (2 * mi) * D; d.K = D; d.N = SGN; d.WT = (bf16*)(wsb + WS_WSGIN) + (size_t)mi * SGN * D; }
    else if (t < P0_T1) { t -= P0_T0; const int mi = t >> 8; d.tile = t & 255; d.W = in[18] + (size_t)mi * D * D; d.gn = in[8] + (2 * mi + 1) * D; d.K = D; d.N = D; d.WT = (bf16*)(wsb + WS_WSSMIN) + (size_t)mi * D * D; }
    else if (t < P0_T2) { t -= P0_T1; const int mi = t >> 8; d.tile = t & 255; d.W = in[14] + (size_t)mi * D * D; d.K = D; d.N = D; d.WT = (bf16*)(wsb + WS_WSGOUT) + (size_t)mi * D * D; }
    else if (t < P0_T3) { t -= P0_T2; const int mi = t >> 8; d.tile = t & 255; d.W = in[19] + (size_t)mi * D * D; d.K = D; d.N = D; d.WT = (bf16*)(wsb + WS_WSSMOUT) + (size_t)mi * D * D; }
    else if (t < P0_T4) { t -= P0_T3; const int mi = t / 144; d.tile = t - mi * 144; d.W = in[28] + (size_t)mi * TOKW * TOKW; d.K = TOKW; d.N = TOKW; d.WT = (bf16*)(wsb + WS_WGLU) + (size_t)mi * TOKW * TOKW; }
    else if (t < P0_T5) { t -= P0_T4; const int mi = t / 1376; d.tile = t - mi * 1376; d.W = in[30] + (size_t)mi * D * NUP; d.gn = in[9] + mi * D; d.K = D; d.N = NUP; d.WT = (bf16*)(wsb + WS_WUP) + (size_t)mi * NUP * D; d.perm = 1; }
    else if (t < P0_T6) { t -= P0_T5; const int mi = t / 688; d.tile = t - mi * 688; d.W = in[33] + (size_t)mi * DFF * D; d.K = DFF; d.N = D; d.WT = (bf16*)(wsb + WS_WDOWN) + (size_t)mi * D * DFF; }
    else { t -= P0_T6; const int mi = t >> 7; d.tile = t & 127; d.W = in[12] + (size_t)mi * D * 1024; d.gn = in[10] + mi * D; d.K = D; d.N = 1024; d.WT = (bf16*)(wsb + WS_WMEM); d.roff = mi * 1024; }
    return d;
}
__device__ __forceinline__ void p0_load(const P0Desc& d, f32x4 (&v)[8], int tid) {
    const int nbn = d.N >> 7, kb = d.tile / nbn, nb = d.tile - kb * nbn; const float* p = d.W + (size_t)((kb << 7) + (tid >> 5)) * d.N + (nb << 7) + (tid & 31) * 4;
#pragma unroll
    for (int it = 0; it < 8; ++it) v[it] = *(const f32x4*)(p + (size_t)(16 * it) * d.N);
}
__device__ __forceinline__ void p0_to_lds(const P0Desc& d, const f32x4 (&v)[8], LAS bf16* T, int tid) {
    const int nbn = d.N >> 7, kb = d.tile / nbn, k0 = kb << 7, kq = tid >> 5, n4 = (tid & 31) * 4;
#pragma unroll
    for (int it = 0; it < 8; ++it) { const int kk = kq + 16 * it; const float g = d.gn ? d.gn[k0 + kk] : 1.f;
        LAS unsigned* p = (LAS unsigned*)(T + kk * P0_TLD + n4); p[0] = pk2(v[it][0] * g, v[it][1] * g); p[1] = pk2(v[it][2] * g, v[it][3] * g); }
}
__device__ __forceinline__ void p0_store(const P0Desc& d, const LAS bf16* T, int tid) {
    const int nbn = d.N >> 7, kb = d.tile / nbn, nb = d.tile - kb * nbn, k0 = kb << 7, n0 = (d.perm ? (nb < 43 ? 2 * nb : 2 * (nb - 43) + 1) : nb) << 7;
#pragma unroll
    for (int j = 0; j < 4; ++j) { const int p = tid + 512 * j, n = p >> 4, kg = p & 15; const LAS bf16* s_ = T + (kg * 8) * P0_TLD + n;
        v4u o; o.x = (unsigned)s_[0] | ((unsigned)s_[P0_TLD] << 16); o.y = (unsigned)s_[2 * P0_TLD] | ((unsigned)s_[3 * P0_TLD] << 16);
        o.z = (unsigned)s_[4 * P0_TLD] | ((unsigned)s_[5 * P0_TLD] << 16); o.w = (unsigned)s_[6 * P0_TLD] | ((unsigned)s_[7 * P0_TLD] << 16);
        *(v4u*)(d.WT + (size_t)(d.roff + n0 + n) * d.K + k0 + kg * 8) = o; }
}
__device__ __forceinline__ void p0_row(const float* src, float* dstf, bf16* dstb, ssq_t* ssp, int lane) {
    f32x4 v[8]; float s = 0.f;
#pragma unroll
    for (int j = 0; j < 8; ++j) { v[j] = src ? ((const f32x4*)src)[lane + 64 * j] : (f32x4){0.f, 0.f, 0.f, 0.f}; s += dot4(v[j]); }
    s = wave_sum(s);
#pragma unroll
    for (int j = 0; j < 8; ++j) { if (dstf) ((f32x4*)dstf)[lane + 64 * j] = v[j]; v2u w; w.x = pk2(v[j][0], v[j][1]); w.y = pk2(v[j][2], v[j][3]); ((v2u*)dstb)[lane + 64 * j] = w; }
    if (lane == 0) *ssp = ss_fix(s);
}
__device__ __forceinline__ void s5_tables(LAS float* L, int j, int h, const float* lam_re, const float* lam_im, const float* log_dt, const float* b_re, const float* b_im,
                                          const float* c_re, const float* c_im, const float* dvec, bf16* TB, bf16* BT2, float* LBT, float* LB16, float* BBART, int tid) {
    LAS float* PWr = L; LAS float* PWi = L + 1088; LAS float* BBr = L + 2176; LAS float* BBi = L + 3200; LAS float* Cr = L + 4224; LAS float* Ci = L + 5248; LAS float* KM = L + 6272;
    const int gh = j * NGRP + h;
    if (tid < 64) {
        const int p = tid, idx = gh * 64 + p; const float lr = lam_re[idx], li = lam_im[idx], dt = expf(log_dt[gh]);
        const float ar = lr * dt, ai = li * dt, mag = expf(ar); float sn, cs; sincosf(ai, &sn, &cs);
        const float lbr = mag * cs, lbi = mag * sn; const float sh = sinf(0.5f * ai);
        const float nr = expm1f(ar) * cs - 2.f * sh * sh, ni = lbi, den = lr * lr + li * li;
        const float kr = (nr * lr + ni * li) / den, ki = (ni * lr - nr * li) / den;
        float pr = 1.f, pi = 0.f;
#pragma unroll
        for (int n = 0; n < 17; ++n) { PWr[p * 17 + n] = pr; PWi[p * 17 + n] = pi; if (n == 16) { LB16[idx * 2] = pr; LB16[idx * 2 + 1] = pi; } const float t = pr * lbr - pi * lbi; pi = pr * lbi + pi * lbr; pr = t; }
        LBT[idx * 2] = lbr; LBT[idx * 2 + 1] = lbi;
#pragma unroll
        for (int c = 0; c < 16; ++c) { const float br = b_re[(size_t)idx * 16 + c], bi = b_im[(size_t)idx * 16 + c]; const float xr = kr * br - ki * bi, xi = kr * bi + ki * br;
            BBr[p * 16 + c] = xr; BBi[p * 16 + c] = xi; BBART[((size_t)idx * 16 + c) * 2] = xr; BBART[((size_t)idx * 16 + c) * 2 + 1] = xi; }
    }
#pragma unroll
    for (int i = 0; i < 2; ++i) { const int e = tid + 512 * i; Cr[e] = c_re[(size_t)gh * 1024 + e]; Ci[e] = c_im[(size_t)gh * 1024 + e]; }
    __syncthreads();
#pragma unroll 1
    for (int i = 0; i < 8; ++i) {
        const int e = tid * 8 + i, dl = e >> 8, c = (e >> 4) & 15, c2 = e & 15; float s = 0.f;
#pragma unroll 4
        for (int p = 0; p < 64; ++p) { const float wr_ = PWr[p * 17 + dl], wi_ = PWi[p * 17 + dl], xr = BBr[p * 16 + c2], xi = BBi[p * 16 + c2];
            s += Cr[c * 64 + p] * (wr_ * xr - wi_ * xi) - Ci[c * 64 + p] * (wr_ * xi + wi_ * xr); }
        if (dl == 0 && c == c2) s += dvec[j * TOKW + h * 16 + c];
        KM[e] = s;
    }
    __syncthreads();
#pragma unroll 1
    for (int it = 0; it < 24; ++it) {
        const int grp = tid + 512 * it, row = grp / 48, cg = grp % 48, tau = row >> 4, c = row & 15; float v[8];
        if (cg < 32) { const int sg = cg >> 1, c0 = (cg & 1) * 8;
#pragma unroll
            for (int i = 0; i < 8; ++i) v[i] = sg <= tau ? KM[(tau - sg) * 256 + c * 16 + c0 + i] : 0.f; }
        else if (cg < 40) {
#pragma unroll
            for (int i = 0; i < 8; ++i) { const int p = (cg - 32) * 8 + i; v[i] = Cr[c * 64 + p] * PWr[p * 17 + tau + 1] - Ci[c * 64 + p] * PWi[p * 17 + tau + 1]; } }
        else {
#pragma unroll
            for (int i = 0; i < 8; ++i) { const int p = (cg - 40) * 8 + i; v[i] = -(Cr[c * 64 + p] * PWi[p * 17 + tau + 1] + Ci[c * 64 + p] * PWr[p * 17 + tau + 1]); } }
        v4u w; w.x = pk2(v[0], v[1]); w.y = pk2(v[2], v[3]); w.z = pk2(v[4], v[5]); w.w = pk2(v[6], v[7]);
        *(v4u*)(TB + ((size_t)gh * 256 + row) * KH + cg * 8) = w;
    }
#pragma unroll 1
    for (int it = 0; it < 8; ++it) {
        const int grp = tid + 512 * it, row = grp >> 5, cg = grp & 31, ri = row >> 6, p = row & 63, n = 15 - (cg >> 1), c0 = (cg & 1) * 8; float v[8];
        const float wr_ = PWr[p * 17 + n], wi_ = PWi[p * 17 + n];
#pragma unroll
        for (int i = 0; i < 8; ++i) { const float xr = BBr[p * 16 + c0 + i], xi = BBi[p * 16 + c0 + i]; v[i] = ri == 0 ? (wr_ * xr - wi_ * xi) : (wr_ * xi + wi_ * xr); }
        v4u w; w.x = pk2(v[0], v[1]); w.y = pk2(v[2], v[3]); w.z = pk2(v[4], v[5]); w.w = pk2(v[6], v[7]);
        *(v4u*)(BT2 + ((size_t)gh * 128 + row) * 256 + cg * 8) = w;
    }
    __syncthreads();
}

constexpr int KS_LD = 136, VT_LD = 264, VT_OFF = 256 * KS_LD * 2;
__device__ __forceinline__ void attn_prompt_unit(LAS unsigned char* lds, const bf16* q, const bf16* mkv_l, bf16* mix, int unit, int tid) {
    const int b = unit >> 6, hd = (unit >> 4) & 3, qb = unit & 15, lane = tid & 63, w = tid >> 6, fr = lane & 15, fq = lane >> 4;
    LAS bf16* Ks = (LAS bf16*)lds; LAS bf16* Vt = (LAS bf16*)(lds + VT_OFF);
    const bf16* kvb = mkv_l + (size_t)(b * 256) * 1024 + hd * 128;
#pragma unroll
    for (int it = 0; it < 8; ++it) { const int id = tid + 512 * it, key = id >> 4, part = id & 15;
        const v4u kw = *(const v4u*)(kvb + (size_t)key * 1024 + part * 8); *(LAS v4u*)(Ks + key * KS_LD + part * 8) = kw;
        const v4u vw = *(const v4u*)(kvb + (size_t)key * 1024 + 512 + part * 8); LAS bf16* vp = Vt + (part * 8) * VT_LD + key;
        vp[0] = (bf16)(vw.x & 0xffff); vp[VT_LD] = (bf16)(vw.x >> 16); vp[2 * VT_LD] = (bf16)(vw.y & 0xffff); vp[3 * VT_LD] = (bf16)(vw.y >> 16);
        vp[4 * VT_LD] = (bf16)(vw.z & 0xffff); vp[5 * VT_LD] = (bf16)(vw.z >> 16); vp[6 * VT_LD] = (bf16)(vw.w & 0xffff); vp[7 * VT_LD] = (bf16)(vw.w >> 16); }
    const int r = b * SEQ + qb * 128 + w * 16 + fr;
    bf16x8 qf[4];
#pragma unroll
    for (int ks = 0; ks < 4; ++ks) qf[ks] = *(const bf16x8*)(q + (size_t)r * XAW + hd * 128 + ks * 32 + fq * 8);
    __syncthreads();
    f32x4 s[16];
#pragma unroll
    for (int t = 0; t < 16; ++t) { s[t] = (f32x4){0.f, 0.f, 0.f, 0.f};
#pragma unroll
        for (int ks = 0; ks < 4; ++ks) { const bf16x8 kf = *(const LAS bf16x8*)(Ks + (t * 16 + fr) * KS_LD + ks * 32 + fq * 8); s[t] = __builtin_amdgcn_mfma_f32_16x16x32_bf16(kf, qf[ks], s[t], 0, 0, 0); } }
    float mx = -3.0e38f;
#pragma unroll
    for (int t = 0; t < 16; ++t) mx = fmaxf(fmaxf(fmaxf(s[t][0], s[t][1]), fmaxf(s[t][2], s[t][3])), mx);
    mx = fmaxf(mx, __shfl_xor(mx, 16)); mx = fmaxf(mx, __shfl_xor(mx, 32));
    const float sc = 0.08838834764831845f * 1.4426950408889634f; float sum = 0.f;
#pragma unroll
    for (int t = 0; t < 16; ++t) {
#pragma unroll
        for (int jj = 0; jj < 4; ++jj) { const float p = __builtin_amdgcn_exp2f((s[t][jj] - mx) * sc); s[t][jj] = p; sum += p; } }
    sum += __shfl_xor(sum, 16); sum += __shfl_xor(sum, 32);
    f32x4 o[8];
#pragma unroll
    for (int dt = 0; dt < 8; ++dt) o[dt] = (f32x4){0.f, 0.f, 0.f, 0.f};
#pragma unroll
    for (int kk = 0; kk < 8; ++kk) {
        v4u pw; pw.x = pk2(s[2 * kk][0], s[2 * kk][1]); pw.y = pk2(s[2 * kk][2], s[2 * kk][3]); pw.z = pk2(s[2 * kk + 1][0], s[2 * kk + 1][1]); pw.w = pk2(s[2 * kk + 1][2], s[2 * kk + 1][3]);
        const bf16x8 pf = __builtin_bit_cast(bf16x8, pw);
#pragma unroll
        for (int dt = 0; dt < 8; ++dt) { const LAS bf16* vp = Vt + (dt * 16 + fr) * VT_LD + kk * 32 + fq * 4;
            v4u vw; const v2u lo = *(const LAS v2u*)vp, hi = *(const LAS v2u*)(vp + 16); vw.x = lo.x; vw.y = lo.y; vw.z = hi.x; vw.w = hi.y;
            o[dt] = __builtin_amdgcn_mfma_f32_16x16x32_bf16(__builtin_bit_cast(bf16x8, vw), pf, o[dt], 0, 0, 0); } }
    const float inv = 1.f / sum;
#pragma unroll
    for (int dt = 0; dt < 8; ++dt) { v2u w2; w2.x = pk2(o[dt][0] * inv, o[dt][1] * inv); w2.y = pk2(o[dt][2] * inv, o[dt][3] * inv);
        *(v2u*)(mix + (size_t)r * D + TOKW + hd * 128 + dt * 16 + fq * 4) = w2; }
    __syncthreads();
}
__device__ __forceinline__ void attn_sample_unit(LAS unsigned char* lds, const bf16* q, const float* ck, const float* cv, bf16* mix, int li, int unit, int tid) {
    const int b = unit >> 1, hp = unit & 1, lane = tid & 63, w = tid >> 6, hd = 2 * hp + (w >> 2), kq = (w & 3) * 64, dd = lane & 15, kg = lane >> 4;
    LAS float* red = (LAS float*)lds;
    const v4u qw = *(const v4u*)(q + (size_t)(MP + b) * XAW + hd * 128 + dd * 8);
    float qv[8] = {bflo(qw.x), bfhi(qw.x), bflo(qw.y), bfhi(qw.y), bflo(qw.z), bfhi(qw.z), bflo(qw.w), bfhi(qw.w)};
    const size_t base = ((size_t)(li * MS + b) * 256) * 512 + hd * 128 + dd * 8;
    float sc[16];
#pragma unroll
    for (int it = 0; it < 16; ++it) { const int key = kq + 4 * it + kg; const float* kp = ck + base + (size_t)key * 512; const f32x4 k0 = *(const f32x4*)kp, k1 = *(const f32x4*)(kp + 4);
        float d = qv[0] * k0[0] + qv[1] * k0[1] + qv[2] * k0[2] + qv[3] * k0[3] + qv[4] * k1[0] + qv[5] * k1[1] + qv[6] * k1[2] + qv[7] * k1[3];
        d += __shfl_xor(d, 1); d += __shfl_xor(d, 2); d += __shfl_xor(d, 4); d += __shfl_xor(d, 8); sc[it] = d; }
    float mx = sc[0];
#pragma unroll
    for (int it = 1; it < 16; ++it) mx = fmaxf(mx, sc[it]);
    mx = fmaxf(mx, __shfl_xor(mx, 16)); mx = fmaxf(mx, __shfl_xor(mx, 32));
    if (lane == 0) red[w] = mx;
    __syncthreads();
    const int w0 = w & 4; mx = fmaxf(fmaxf(red[w0], red[w0 + 1]), fmaxf(red[w0 + 2], red[w0 + 3]));
    const float scl = 0.08838834764831845f * 1.4426950408889634f; float sum = 0.f;
    float oacc[8] = {0.f, 0.f, 0.f, 0.f, 0.f, 0.f, 0.f, 0.f};
#pragma unroll
    for (int it = 0; it < 16; ++it) { const float p = __builtin_amdgcn_exp2f((sc[it] - mx) * scl); sum += p;
        const int key = kq + 4 * it + kg; const float* vp = cv + base + (size_t)key * 512; const f32x4 v0 = *(const f32x4*)vp, v1 = *(const f32x4*)(vp + 4);
        oacc[0] += p * v0[0]; oacc[1] += p * v0[1]; oacc[2] += p * v0[2]; oacc[3] += p * v0[3]; oacc[4] += p * v1[0]; oacc[5] += p * v1[1]; oacc[6] += p * v1[2]; oacc[7] += p * v1[3]; }
    sum += __shfl_xor(sum, 16); sum += __shfl_xor(sum, 32);
#pragma unroll
    for (int i = 0; i < 8; ++i) { oacc[i] += __shfl_xor(oacc[i], 16); oacc[i] += __shfl_xor(oacc[i], 32); }
    if (lane == 0) red[8 + w] = sum;
    if (lane < 16) {
#pragma unroll
        for (int i = 0; i < 8; ++i) red[16 + w * 128 + dd * 8 + i] = oacc[i]; }
    __syncthreads();
    if ((w & 3) == 0 && lane < 16) {
        const float tot = (red[8 + w] + red[9 + w]) + (red[10 + w] + red[11 + w]), inv = 1.f / tot; float o[8];
#pragma unroll
        for (int i = 0; i < 8; ++i) o[i] = ((red[16 + w * 128 + dd * 8 + i] + red[16 + (w + 1) * 128 + dd * 8 + i]) + (red[16 + (w + 2) * 128 + dd * 8 + i] + red[16 + (w + 3) * 128 + dd * 8 + i])) * inv;
        v4u ow; ow.x = pk2(o[0], o[1]); ow.y = pk2(o[2], o[3]); ow.z = pk2(o[4], o[5]); ow.w = pk2(o[6], o[7]);
        *(v4u*)(mix + (size_t)(MP + b) * D + TOKW + hd * 128 + dd * 8) = ow;
    }
    __syncthreads();
}

constexpr int SG_LD = 136;
__device__ __forceinline__ void sg_unit(LAS unsigned char* lds, const bf16* zu, const bf16* zv, const ssq_t* ssv, const float* g_v, const bf16* wsb, const float* b_s, bf16* mix, int unit, int tid) {
    const int ch = unit / 12, g = unit % 12, row0 = ch * 128, lane = tid & 63, w = tid >> 6, fr = lane & 15, fq = lane >> 4;
    LAS bf16* Vt = (LAS bf16*)lds;
    { const int s = tid & 127, dq = tid >> 7; const float rsv = rstd_of(ssv[row0 + s], 1.f / 1536.f);
#pragma unroll
      for (int it = 0; it < 4; ++it) { const int d0 = (dq + 4 * it) * 8; const v4u vw = *(const v4u*)(zv + (size_t)(row0 + s) * TOKW + g * 128 + d0);
          const f32x4 g0 = *(const f32x4*)(g_v + g * 128 + d0), g1 = *(const f32x4*)(g_v + g * 128 + d0 + 4);
          const unsigned a = pk2(bflo(vw.x) * rsv * g0[0], bfhi(vw.x) * rsv * g0[1]), b2 = pk2(bflo(vw.y) * rsv * g0[2], bfhi(vw.y) * rsv * g0[3]),
                         c2 = pk2(bflo(vw.z) * rsv * g1[0], bfhi(vw.z) * rsv * g1[1]), e2 = pk2(bflo(vw.w) * rsv * g1[2], bfhi(vw.w) * rsv * g1[3]);
          LAS bf16* vp = Vt + d0 * SG_LD + s;
          vp[0] = (bf16)(a & 0xffff); vp[SG_LD] = (bf16)(a >> 16); vp[2 * SG_LD] = (bf16)(b2 & 0xffff); vp[3 * SG_LD] = (bf16)(b2 >> 16);
          vp[4 * SG_LD] = (bf16)(c2 & 0xffff); vp[5 * SG_LD] = (bf16)(c2 >> 16); vp[6 * SG_LD] = (bf16)(e2 & 0xffff); vp[7 * SG_LD] = (bf16)(e2 >> 16); } }
    const int nks = (w >> 1) + 1;
    bf16x8 wf[4];
#pragma unroll
    for (int ks = 0; ks < 4; ++ks) wf[ks] = *(const bf16x8*)(wsb + ((size_t)g * 128 + w * 16 + fr) * 128 + ks * 32 + fq * 8);
    __syncthreads();
    f32x4 acc[8];
#pragma unroll
    for (int dt = 0; dt < 8; ++dt) { acc[dt] = (f32x4){0.f, 0.f, 0.f, 0.f};
#pragma unroll
        for (int ks = 0; ks < 4; ++ks) if (ks < nks) { const bf16x8 vf = *(const LAS bf16x8*)(Vt + (dt * 16 + fr) * SG_LD + ks * 32 + fq * 8); acc[dt] = __builtin_amdgcn_mfma_f32_16x16x32_bf16(vf, wf[ks], acc[dt], 0, 0, 0); } }
    const int t = w * 16 + fr, r = row0 + t; const float bias = b_s[g * 128 + t];
#pragma unroll
    for (int dt = 0; dt < 8; ++dt) { const int c = g * 128 + dt * 16 + fq * 4; const v2u uw = *(const v2u*)(zu + (size_t)r * TOKW + c);
        v2u ow; ow.x = pk2(bflo(uw.x) * (acc[dt][0] + bias), bfhi(uw.x) * (acc[dt][1] + bias)); ow.y = pk2(bflo(uw.y) * (acc[dt][2] + bias), bfhi(uw.y) * (acc[dt][3] + bias));
        *(v2u*)(mix + (size_t)r * D + c) = ow; }
    __syncthreads();
}

__device__ __forceinline__ void s5_state_task(LAS unsigned char* lds, bf16* uh, const bf16* bt2_l, const float* lb16_l, float* out, int j, int task, int tid) {
    const int b = task / NGRP, h = task % NGRP, lane = tid & 63, w = tid >> 6, fr = lane & 15, fq = lane >> 4;
    LAS float* S = (LAS float*)lds;
    bf16x8 af[8];
    const bf16* ap = uh + ((size_t)(h * 512 + b * 128 + w * 16 + fr)) * KH + fq * 8;
#pragma unroll
    for (int ks = 0; ks < 8; ++ks) af[ks] = *(const bf16x8*)(ap + ks * 32);
#pragma unroll
    for (int nt = 0; nt < 8; ++nt) { f32x4 acc = (f32x4){0.f, 0.f, 0.f, 0.f}; const bf16* bp = bt2_l + ((size_t)(h * 128 + nt * 16 + fr)) * 256 + fq * 8;
#pragma unroll
        for (int ks = 0; ks < 8; ++ks) { const bf16x8 bf = *(const bf16x8*)(bp + ks * 32); acc = __builtin_amdgcn_mfma_f32_16x16x32_bf16(af[ks], bf, acc, 0, 0, 0); }
#pragma unroll
        for (int jj = 0; jj < 4; ++jj) S[(w * 16 + fq * 4 + jj) * 129 + nt * 16 + fr] = acc[jj]; }
    __syncthreads();
    if (w == 0) {
        const int p = lane; const float lr = lb16_l[(h * 64 + p) * 2], li = lb16_l[(h * 64 + p) * 2 + 1]; float hr = 0.f, hi = 0.f;
        bf16* up = uh + ((size_t)(h * 512 + b * 128)) * KH + 256 + p;
#pragma unroll 4
        for (int m = 0; m < 128; ++m) { up[(size_t)m * KH] = (bf16)(pk2(hr, 0.f) & 0xffff); up[(size_t)m * KH + 64] = (bf16)(pk2(hi, 0.f) & 0xffff);
            const float sr = S[m * 129 + p], si = S[m * 129 + 64 + p]; const float t = lr * hr - li * hi + sr; hi = lr * hi + li * hr + si; hr = t; }
        out[OFF_SRP + ((size_t)(j * 4 + b) * NGRP + h) * 64 + p] = hr; out[OFF_SIP + ((size_t)(j * 4 + b) * NGRP + h) * 64 + p] = hi;
    }
    __syncthreads();
}
__device__ __forceinline__ void s5_sample_task(const float* us, const float* st_re, const float* st_im, const float* lbt_l, const float* bbar_l, const float* c_re_l, const float* c_im_l, const float* d_l,
                                               float* out, bf16* yb, int j, int task, int lane) {
    const int b = task / NGRP, h = task % NGRP, p = lane;
    float u[16];
#pragma unroll
    for (int c4 = 0; c4 < 4; ++c4) { const f32x4 t = *(const f32x4*)(us + (size_t)b * TOKW + h * 16 + c4 * 4); u[c4 * 4] = t[0]; u[c4 * 4 + 1] = t[1]; u[c4 * 4 + 2] = t[2]; u[c4 * 4 + 3] = t[3]; }
    float xr = 0.f, xi = 0.f; const float* bb = bbar_l + ((size_t)(h * 64 + p)) * 32;
#pragma unroll
    for (int c2 = 0; c2 < 8; ++c2) { const f32x4 t = *(const f32x4*)(bb + c2 * 4); xr += t[0] * u[2 * c2] + t[2] * u[2 * c2 + 1]; xi += t[1] * u[2 * c2] + t[3] * u[2 * c2 + 1]; }
    const size_t si_ = ((size_t)(j * MS + b) * NGRP + h) * 64 + p; const float s0r = st_re[si_], s0i = st_im[si_], lr = lbt_l[(h * 64 + p) * 2], li = lbt_l[(h * 64 + p) * 2 + 1];
    const float hr = lr * s0r - li * s0i + xr, hi = lr * s0i + li * s0r + xi;
    out[OFF_SRS + si_] = hr; out[OFF_SIS + si_] = hi;
    float yv = 0.f;
#pragma unroll
    for (int c = 0; c < 16; ++c) { float t = c_re_l[((size_t)(h * 16 + c)) * 64 + p] * hr - c_im_l[((size_t)(h * 16 + c)) * 64 + p] * hi; t = wave_sum(t); t += d_l[h * 16 + c] * u[c]; yv = (lane == c) ? t : yv; }
    if (lane < 16) yb[(size_t)(MP + b) * TOKW + h * 16 + lane] = (bf16)(pk2(gelu_t(yv), 0.f) & 0xffff);
}

struct SEpiRes {
    float* xres; bf16* xb; ssq_t* ssn;
    __device__ __forceinline__ void operator()(f32x4 v, int m, int c) const {
        const int r = MP + m; float* xp = xres + (size_t)r * D + c; const f32x4 o = *(const f32x4*)xp + v; *(f32x4*)xp = o;
        v2u w; w.x = pk2(o[0], o[1]); w.y = pk2(o[2], o[3]); *(v2u*)(xb + (size_t)r * D + c) = w;
        float sq = dot4(o); sq += __shfl_xor(sq, 1); sq += __shfl_xor(sq, 2); sq += __shfl_xor(sq, 4); if ((threadIdx.x & 7) == 0) fadd_atomic(ssn + r, sq);
    }
};
struct SEpiSsmIn {
    const ssq_t* ss; float* us; bf16* q;
    __device__ __forceinline__ void operator()(f32x4 v, int m, int c) const {
        const int r = MP + m; v = v * rstd_of(ss[r], 1.f / 2048.f);
        if (c < TOKW) *(f32x4*)(us + (size_t)m * TOKW + c) = v;
        else { v2u w; w.x = pk2(v[0], v[1]); w.y = pk2(v[2], v[3]); *(v2u*)(q + (size_t)r * XAW + (c - TOKW)) = w; }
    }
};
template <class SEpi>
__device__ __forceinline__ void skinny_sample(LAS unsigned char* lds, const bf16* As, const bf16* Bt, int K, const SEpi& E, int blk, int tid) {
    if (blk >= 256) return;
    const int lane = tid & 63, w = __builtin_amdgcn_readfirstlane(tid >> 6), fr = lane & 15, fq = lane >> 4, m0 = (blk & 3) * 32, n0 = (blk >> 2) * 32;
    f32x4 acc[2][2];
#pragma unroll
    for (int a = 0; a < 2; ++a)
#pragma unroll
        for (int b = 0; b < 2; ++b) acc[a][b] = (f32x4){0.f, 0.f, 0.f, 0.f};
    const int nks = K >> 5; const bf16* bp = Bt + (size_t)(n0 + fr) * K + fq * 8; const bf16* ap = As + (size_t)(m0 + fr) * K + fq * 8; const size_t r16 = (size_t)16 * K;
#pragma unroll 4
    for (int ks = w; ks < nks; ks += 8) {
        const bf16x8 b0 = *(const bf16x8*)(bp + ks * 32), b1 = *(const bf16x8*)(bp + r16 + ks * 32), a0 = *(const bf16x8*)(ap + ks * 32), a1 = *(const bf16x8*)(ap + r16 + ks * 32);
        acc[0][0] = __builtin_amdgcn_mfma_f32_16x16x32_bf16(b0, a0, acc[0][0], 0, 0, 0); acc[0][1] = __builtin_amdgcn_mfma_f32_16x16x32_bf16(b1, a0, acc[0][1], 0, 0, 0);
        acc[1][0] = __builtin_amdgcn_mfma_f32_16x16x32_bf16(b0, a1, acc[1][0], 0, 0, 0); acc[1][1] = __builtin_amdgcn_mfma_f32_16x16x32_bf16(b1, a1, acc[1][1], 0, 0, 0);
    }
    LAS float* red = (LAS float*)lds;
#pragma unroll
    for (int a = 0; a < 2; ++a)
#pragma unroll
        for (int b = 0; b < 2; ++b) *(LAS f32x4*)(red + ((w * 32 + a * 16 + fr) * 32 + b * 16 + fq * 4)) = acc[a][b];
    __syncthreads();
    if (tid < 256) {
        const int m = tid >> 3, nq = (tid & 7) * 4; f32x4 sum = *(const LAS f32x4*)(red + (m * 32 + nq));
#pragma unroll
        for (int w2 = 1; w2 < 8; ++w2) sum += *(const LAS f32x4*)(red + ((w2 * 32 + m) * 32 + nq));
        E(sum, m0 + m, n0 + nq);
    }
    __syncthreads();
}

#define RLX_AGENT __ATOMIC_RELAXED, __HIP_MEMORY_SCOPE_AGENT
struct Args { const float* in[34]; float* out; unsigned char* ws; int lo, hi; };
__global__ void __launch_bounds__(NTHR, 2) trunk_fwd(Args args) {
    extern __shared__ __attribute__((aligned(16))) unsigned char lds_raw[];
    LAS unsigned char* lds = (LAS unsigned char*)lds_raw;
    volatile LAS unsigned* MISC = (volatile LAS unsigned*)(lds + MISC_OFF);
    const int G = gridDim.x, blk = blockIdx.x;
    const Args* ap = &args;
#define ws (ap->ws)
#define out (ap->out)
#define x_prompt (ap->in[0])
#define x_sample (ap->in[1])
#define mem_prompt (ap->in[2])
#define cache_k (ap->in[3])
#define cache_v (ap->in[4])
#define st_re (ap->in[5])
#define st_im (ap->in[6])
#define st_conv (ap->in[7])
#define g_mix (ap->in[8])
#define g_ffn (ap->in[9])
#define g_mem (ap->in[10])
#define g_final (ap->in[11])
#define w_mem_kv (ap->in[12])
#define sg_w_in (ap->in[13])
#define sg_w_out (ap->in[14])
#define sg_g_v (ap->in[15])
#define sg_w_s (ap->in[16])
#define sg_b_s (ap->in[17])
#define ssm_w_in (ap->in[18])
#define ssm_w_out (ap->in[19])
#define lam_re (ap->in[20])
#define lam_im (ap->in[21])
#define log_dt (ap->in[22])
#define b_re (ap->in[23])
#define b_im (ap->in[24])
#define c_re (ap->in[25])
#define c_im (ap->in[26])
#define ssm_d (ap->in[27])
#define w_glu (ap->in[28])
#define b_glu (ap->in[29])
#define w_up (ap->in[30])
#define conv_w (ap->in[31])
#define conv_b (ap->in[32])
#define w_down (ap->in[33])
#define ctl ((unsigned*)(ws + WS_CTL))
#define SSX ((ssq_t*)(ws + CTL_SSX))
#define SSV ((ssq_t*)(ws + CTL_SSV))
#define SSMEM ((ssq_t*)(ws + CTL_SSMEM))
#define W_SGIN ((bf16*)(ws + WS_WSGIN))
#define W_SSMIN ((bf16*)(ws + WS_WSSMIN))
#define W_SGOUT ((bf16*)(ws + WS_WSGOUT))
#define W_SSMOUT ((bf16*)(ws + WS_WSSMOUT))
#define W_GLU ((bf16*)(ws + WS_WGLU))
#define W_UP ((bf16*)(ws + WS_WUP))
#define W_DOWN ((bf16*)(ws + WS_WDOWN))
#define W_MEM ((bf16*)(ws + WS_WMEM))
#define WSB ((bf16*)(ws + WS_WSB))
#define TB ((bf16*)(ws + WS_TB))
#define BT2 ((bf16*)(ws + WS_BT2))
#define LBT ((float*)(ws + WS_LBT))
#define LB16 ((float*)(ws + WS_LB16))
#define BBART ((float*)(ws + WS_BBAR))
#define XRES ((float*)(ws + WS_XRES))
#define XB ((bf16*)(ws + WS_XB))
#define MEMB ((bf16*)(ws + WS_MEMB))
#define MKV ((bf16*)(ws + WS_MKV))
#define ZU ((bf16*)(ws + WS_ZU))
#define ZV ((bf16*)(ws + WS_ZV))
#define QB ((bf16*)(ws + WS_Q))
#define MIX ((bf16*)(ws + WS_MIX))
#define AG ((bf16*)(ws + WS_AG))
#define YF ((bf16*)(ws + WS_Y))
#define UH ((bf16*)(ws + WS_UH))
#define YB ((bf16*)(ws + WS_YB))
#define US ((float*)(ws + WS_US))
#define FXA ((float*)(ws + WS_FXA))
#define FXG ((float*)(ws + WS_FXG))
    for (int u = threadIdx.x; u < 128; u += NTHR) MISC[u] = 0u;
    __syncthreads();
    XcdBarrier bar = xcd_barrier_post(ctl + CW_BAR, MISC + 8);
    const int lo = args.lo, hi = args.hi; int ph = 0;
#ifndef PHM
#define PHM 0xFFFFFFFFu
#endif
#ifndef DUPM
#define DUPM 0u
#endif
#define PH_BEGIN(k) if (((PHM >> (k)) & 1u) && ph >= lo && ph < hi) for (int rep_ = 0; rep_ < (((DUPM >> (k)) & 1u) ? 2 : 1); ++rep_) { unsigned z_; asm volatile("s_mov_b32 %0, 0" : "=s"(z_)); const Args* ap = (const Args*)((const char*)&args + z_); int tid = threadIdx.x; asm volatile("" : "+v"(tid)); const int lane = tid & 63, wave = __builtin_amdgcn_readfirstlane(tid >> 6); const int gw = blk * NWAVES + wave, NGW = G * NWAVES, gtid = blk * NTHR + tid, NT = G * NTHR; (void)lane; (void)gw; (void)NGW; (void)gtid; (void)NT;
#define PH_END do { if (ph >= lo && ph + 1 < hi) xcd_barrier(bar); ++ph; } while (0)

    PH_BEGIN(0)
        {
            LAS bf16* T = (LAS bf16*)lds; f32x4 v[8]; int t = blk; P0Desc d, dn;
            if (t < P0_NTILES) { d = p0_decode(t, ap->in, ws); p0_load(d, v, tid); }
#pragma unroll 1
            while (t < P0_NTILES) {
                p0_to_lds(d, v, T, tid);
                __syncthreads();
                const int tn = t + G; dn = d;
                if (tn < P0_NTILES) { dn = p0_decode(tn, ap->in, ws); p0_load(dn, v, tid); }
                p0_store(d, T, tid);
                __syncthreads();
                t = tn; d = dn;
            }
        }
        for (int r = gw; r < MT + MMEM; r += NGW) {
            if (r < MT) { const float* src = r < MP ? x_prompt + (size_t)r * D : (r < MREAL ? x_sample + (size_t)(r - MP) * D : nullptr); p0_row(src, XRES + (size_t)r * D, XB + (size_t)r * D, SSX + r, lane); }
            else { const int m = r - MT; p0_row(mem_prompt + (size_t)m * D, nullptr, MEMB + (size_t)m * D, SSMEM + m, lane); }
        }
    }
    PH_END;
    PH_BEGIN(1)
        if (blk < 64 || G <= 64) {
            pg8::Gemm g{MEMB, W_MEM, MMEM, 4096, D}; pg8::StaticOrder S; S.init(MMEM, 4096, G, blk);
            EpiMem E{SSMEM, out, MKV};
            pg8::gemm_phase<EpiMem, pg8::StaticOrder, true, true>(lds, g, S, E);
        }
        if (blk >= 64 || G <= 64) {
            const int b0 = G <= 64 ? blk : blk - 64, gs = G <= 64 ? G : G - 64;
            for (int e = b0 * NTHR + tid; e < 2 * 12 * 128 * 128 / 4; e += gs * NTHR) { const int e4 = e * 4, s = e4 & 127, t = (e4 >> 7) & 127; const f32x4 wv = *(const f32x4*)(sg_w_s + e4);
                v2u o; o.x = pk2(s <= t ? wv[0] : 0.f, s + 1 <= t ? wv[1] : 0.f); o.y = pk2(s + 2 <= t ? wv[2] : 0.f, s + 3 <= t ? wv[3] : 0.f); *(v2u*)(WSB + e4) = o; }
            for (int un = b0; un < 2 * NGRP; un += gs) { const int j = un / NGRP, h = un % NGRP;
                s5_tables((LAS float*)lds, j, h, lam_re, lam_im, log_dt, b_re, b_im, c_re, c_im, ssm_d, TB, BT2, LBT, LB16, BBART, tid); }
        }
    }
    PH_END;
#pragma unroll 1
    for (int li = 0; li < 4; ++li) {
        const int j = li >> 1;
        const ssq_t* ss_mix = SSX + (size_t)(2 * li) * MT; ssq_t* ss_ffn = SSX + (size_t)(2 * li + 1) * MT; ssq_t* ss_next = SSX + (size_t)(2 * li + 2) * MT;
        const bf16* mkv_l = MKV + (size_t)li * 1024 * 1024;
        if ((li & 1) == 0) {
            PH_BEGIN(2)
                pg8::Gemm g{XB, W_SGIN + (size_t)j * SGN * D, MT, SGN, D}; pg8::StaticOrder S; S.init(MT, SGN, G, blk);
                EpiSgIn E{ss_mix, ZU, ZV, QB, SSV + (size_t)j * MT};
                pg8::gemm_phase<EpiSgIn, pg8::StaticOrder, true, true>(lds, g, S, E);
            }
            PH_END;
            PH_BEGIN(3)
                const ssq_t* ssv = SSV + (size_t)j * MT; const float* gv = sg_g_v + j * TOKW;
#pragma unroll 1
                for (int un = blk; un < 768; un += G) sg_unit(lds, ZU, ZV, ssv, gv, WSB + (size_t)j * 12 * 128 * 128, sg_b_s + j * 12 * 128, MIX, un, tid);
#pragma unroll 1
                for (int un = blk; un < 256; un += G) attn_prompt_unit(lds, QB, mkv_l, MIX, un, tid);
#pragma unroll 1
                for (int un = blk; un < 256; un += G) attn_sample_unit(lds, QB, cache_k, cache_v, MIX, li, un, tid);
                for (int e = gtid; e < MS * TOKW / 8; e += NT) { const int b = e / 192, c = (e % 192) * 8, g = c >> 7, r = MP + b;
                    const float rsv = rstd_of(ssv[r], 1.f / 1536.f); const v4u vw = *(const v4u*)(ZV + (size_t)r * TOKW + c), uw = *(const v4u*)(ZU + (size_t)r * TOKW + c);
                    const f32x4 g0 = *(const f32x4*)(gv + c), g1 = *(const f32x4*)(gv + c + 4);
                    const f32x4 n0 = (f32x4){bflo(vw.x) * rsv * g0[0], bfhi(vw.x) * rsv * g0[1], bflo(vw.y) * rsv * g0[2], bfhi(vw.y) * rsv * g0[3]};
                    const f32x4 n1 = (f32x4){bflo(vw.z) * rsv * g1[0], bfhi(vw.z) * rsv * g1[1], bflo(vw.w) * rsv * g1[2], bfhi(vw.w) * rsv * g1[3]};
                    float* so = out + OFF_SGV + (size_t)(j * MS + b) * TOKW + c; *(f32x4*)so = n0; *(f32x4*)(so + 4) = n1;
                    const float w00 = sg_w_s[((size_t)(j * 12 + g) * 128) * 128], bs = sg_b_s[(j * 12 + g) * 128];
                    const f32x4 t0 = (f32x4){bflo(uw.x), bfhi(uw.x), bflo(uw.y), bfhi(uw.y)} * (n0 * w00 + bs), t1 = (f32x4){bflo(uw.z), bfhi(uw.z), bflo(uw.w), bfhi(uw.w)} * (n1 * w00 + bs);
                    *(v4u*)(MIX + (size_t)r * D + c) = pack8(t0, t1); }
            }
            PH_END;
        } else {
            PH_BEGIN(4)
                pg8::Gemm g{XB, W_SSMIN + (size_t)j * D * D, MP, D, D}; pg8::StaticOrder S; S.init(MP, D, G, blk);
                EpiSsmIn E{ss_mix, UH, US, QB};
                pg8::gemm_phase<EpiSsmIn, pg8::StaticOrder, true, true>(lds, g, S, E);
                SEpiSsmIn SE{ss_mix, US, QB}; skinny_sample(lds, XB + (size_t)MP * D, W_SSMIN + (size_t)j * D * D, D, SE, blk, tid);
            }
            PH_END;
            PH_BEGIN(5)
#pragma unroll 1
                for (int tk = blk; tk < 4 * NGRP; tk += G) s5_state_task(lds, UH, BT2 + (size_t)j * NGRP * 128 * 256, LB16 + (size_t)j * NGRP * 64 * 2, out, j, tk, tid);
#pragma unroll 1
                for (int tk = gw; tk < MS * NGRP; tk += NGW)
                    s5_sample_task(US, st_re, st_im, LBT + (size_t)j * NGRP * 64 * 2, BBART + (size_t)j * NGRP * 64 * 32, c_re + (size_t)j * NGRP * 1024, c_im + (size_t)j * NGRP * 1024, ssm_d + j * TOKW, out, YB, j, tk, lane);
#pragma unroll 1
                for (int un = blk; un < 256; un += G) attn_prompt_unit(lds, QB, mkv_l, MIX, un, tid);
#pragma unroll 1
                for (int un = blk; un < 256; un += G) attn_sample_unit(lds, QB, cache_k, cache_v, MIX, li, un, tid);
            }
            PH_END;
            PH_BEGIN(6)
                int kh = KH; asm volatile("" : "+s"(kh)); pg8::Gemm g{UH, TB + (size_t)j * NGRP * 256 * KH, NGRP * 512, NGRP * 256, kh}; ToepOrder S{G, blk};
                EpiToep E{YB};
                pg8::gemm_phase<EpiToep, ToepOrder, true, true>(lds, g, S, E);
            }
            PH_END;
            PH_BEGIN(7)
                pg8::Gemm g{YB, W_GLU + (size_t)j * TOKW * TOKW, MT, TOKW, TOKW}; pg8::StaticOrder S; S.init(MT, TOKW, G, blk);
                EpiGlu E{YB, b_glu + j * TOKW, MIX};
                pg8::gemm_phase<EpiGlu, pg8::StaticOrder, true, true>(lds, g, S, E);
            }
            PH_END;
        }
        PH_BEGIN(8)
            const bf16* wo = (li & 1) ? W_SSMOUT + (size_t)j * D * D : W_SGOUT + (size_t)j * D * D;
            pg8::Gemm g{MIX, wo, MP, D, D}; pg8::StaticOrder S; S.init(MP, D, G, blk);
            EpiRes E{XRES, XB, ss_ffn};
            pg8::gemm_phase<EpiRes, pg8::StaticOrder, true, true>(lds, g, S, E);
            SEpiRes SE{XRES, XB, ss_ffn}; skinny_sample(lds, MIX + (size_t)MP * D, wo, D, SE, blk, tid);
        }
        PH_END;
        PH_BEGIN(9)
            pg8::Gemm g{XB, W_UP + (size_t)li * NUP * D, MT, NUP, D}; pg8::StaticOrder S; S.init(MT, NUP, G, blk);
            EpiUp E{ss_ffn, YF, out, st_conv + (size_t)li * MS * 2 * DFF, conv_w + (size_t)li * 3 * DFF, conv_b + (size_t)li * DFF, FXA, FXG, (LAS float*)(lds + HALO_OFF), li};
            pg8::gemm_phase<EpiUp, pg8::StaticOrder, true, true>(lds, g, S, E);
        }
        PH_END;
        PH_BEGIN(10)
            const float* cw = conv_w + (size_t)li * 3 * DFF; const float* cb = conv_b + (size_t)li * DFF;
            for (int e = gtid; e < 32 * (DFF / 4); e += NT) {
                const int pm = e / (DFF / 4), c = (e % (DFF / 4)) * 4; if ((pm & 7) == 0) continue;
                const f32x4 am2 = *(const f32x4*)(FXA + ((size_t)((pm - 1) * 4 + 2)) * DFF + c), am1 = *(const f32x4*)(FXA + ((size_t)((pm - 1) * 4 + 3)) * DFF + c);
                const f32x4 a0 = *(const f32x4*)(FXA + ((size_t)(pm * 4)) * DFF + c), a1 = *(const f32x4*)(FXA + ((size_t)(pm * 4 + 1)) * DFF + c);
                const f32x4 g0 = *(const f32x4*)(FXG + ((size_t)(pm * 2)) * DFF + c), g1 = *(const f32x4*)(FXG + ((size_t)(pm * 2 + 1)) * DFF + c);
                const f32x4 k0 = *(const f32x4*)(cw + c), k1 = *(const f32x4*)(cw + DFF + c), k2 = *(const f32x4*)(cw + 2 * DFF + c), kb = *(const f32x4*)(cb + c);
                f32x4 y0, y1;
#pragma unroll
                for (int i = 0; i < 4; ++i) { const float c0_ = kb[i] + k0[i] * am2[i] + k1[i] * am1[i] + k2[i] * a0[i], c1_ = kb[i] + k0[i] * am1[i] + k1[i] * a0[i] + k2[i] * a1[i];
                    y0[i] = c0_ * sigmoid_f(c0_) * g0[i]; y1[i] = c1_ * sigmoid_f(c1_) * g1[i]; }
                v2u w0, w1; w0.x = pk2(y0[0], y0[1]); w0.y = pk2(y0[2], y0[3]); w1.x = pk2(y1[0], y1[1]); w1.y = pk2(y1[2], y1[3]);
                *(v2u*)(YF + (size_t)(pm * 256) * DFF + c) = w0; *(v2u*)(YF + (size_t)(pm * 256 + 1) * DFF + c) = w1;
            }
        }
        PH_END;
        PH_BEGIN(11)
            pg8::Gemm g{YF, W_DOWN + (size_t)li * D * DFF, MP, D, DFF}; pg8::StaticOrder S; S.init(MP, D, G, blk);
            EpiRes E{XRES, XB, ss_next};
            pg8::gemm_phase<EpiRes, pg8::StaticOrder, true, true>(lds, g, S, E);
            SEpiRes SE{XRES, XB, ss_next}; skinny_sample(lds, YF + (size_t)MP * DFF, W_DOWN + (size_t)li * D * DFF, DFF, SE, blk, tid);
        }
        PH_END;
    }
    PH_BEGIN(12)
#pragma unroll 1
        for (int r = gw; r < MREAL; r += NGW) {
            const f32x4* xr = (const f32x4*)(XRES + (size_t)r * D); f32x4 v[8]; float s = 0.f;
#pragma unroll
            for (int jj = 0; jj < 8; ++jj) { v[jj] = xr[lane + 64 * jj]; s += dot4(v[jj]); }
            const float rs = rsqrtf(wave_sum(s) * (1.f / 2048.f) + EPS);
            f32x4* o = (f32x4*)(out + (r < MP ? OFF_YP + (size_t)r * D : OFF_YS + (size_t)(r - MP) * D));
#pragma unroll
            for (int jj = 0; jj < 8; ++jj) o[lane + 64 * jj] = v[jj] * rs * ((const f32x4*)g_final)[lane + 64 * jj];
        }
    }
    PH_END;
#undef PH_BEGIN
#undef PH_END
}
#undef x_prompt
#undef x_sample
#undef mem_prompt
#undef cache_k
#undef cache_v
#undef st_re
#undef st_im
#undef st_conv
#undef g_mix
#undef g_ffn
#undef g_mem
#undef g_final
#undef w_mem_kv
#undef sg_w_in
#undef sg_w_out
#undef sg_g_v
#undef sg_w_s
#undef sg_b_s
#undef ssm_w_in
#undef ssm_w_out
#undef lam_re
#undef lam_im
#undef log_dt
#undef b_re
#undef b_im
#undef c_re
#undef c_im
#undef ssm_d
#undef w_glu
#undef b_glu
#undef w_up
#undef conv_w
#undef conv_b
#undef w_down
#undef ctl
#undef SSX
#undef SSV
#undef SSMEM
#undef W_SGIN
#undef W_SSMIN
#undef W_SGOUT
#undef W_SSMOUT
#undef W_GLU
#undef W_UP
#undef W_DOWN
#undef W_MEM
#undef WSB
#undef TB
#undef BT2
#undef LBT
#undef LB16
#undef BBART
#undef XRES
#undef XB
#undef MEMB
#undef MKV
#undef ZU
#undef ZV
#undef QB
#undef MIX
#undef AG
#undef YF
#undef UH
#undef YB
#undef US
#undef FXA
#undef FXG
#undef ws
#undef out

#ifndef MK_ONE_LAUNCH
#define MK_ONE_LAUNCH 1
#endif
extern "C" void kernel_launch(void* const* d_in, const int* in_sizes, int n_in, void* d_out, int out_size, void* d_ws, size_t ws_size, hipStream_t stream) {
    static int grid = 0;
    if (grid == 0) {
        if (n_in != 34 || (size_t)out_size != OUT_TOTAL || ws_size < WS_END) { fprintf(stderr, "kernel_launch: unexpected shapes (n_in %d, out %d, ws %zu)\n", n_in, out_size, ws_size); grid = -1; return; }
        int dev = 0, cus = 0;
        if (hipGetDevice(&dev) != hipSuccess || hipDeviceGetAttribute(&cus, hipDeviceAttributeMultiprocessorCount, dev) != hipSuccess) { grid = -1; return; }
        if (hipFuncSetAttribute((const void*)trunk_fwd, hipFuncAttributeMaxDynamicSharedMemorySize, LDS_BYTES) != hipSuccess) { fprintf(stderr, "kernel_launch: hipFuncSetAttribute failed\n"); grid = -1; return; }
        int per_cu = 0;
        if (hipOccupancyMaxActiveBlocksPerMultiprocessor(&per_cu, (const void*)trunk_fwd, NTHR, LDS_BYTES) != hipSuccess || per_cu < 1) fprintf(stderr, "kernel_launch: occupancy query says %d\n", per_cu);
        (void)hipGetLastError();
        grid = cus;
    }
    if (grid < 0) return;
    if (hipMemsetAsync((char*)d_ws + WS_CTL, 0, CTL_ZERO_BYTES, stream) != hipSuccess) return;
    Args a{};
    for (int i = 0; i < 34; ++i) a.in[i] = (const float*)d_in[i];
    a.out = (float*)d_out; a.ws = (unsigned char*)d_ws;
#if MK_ONE_LAUNCH
    a.lo = 0; a.hi = NPHASE;
    hipLaunchKernelGGL(trunk_fwd, dim3(grid), dim3(NTHR), LDS_BYTES, stream, a);
#else
    for (int p = 0; p < NPHASE; ++p) { a.lo = p; a.hi = p + 1; hipLaunchKernelGGL(trunk_fwd, dim3(grid), dim3(NTHR), LDS_BYTES, stream, a); }
#endif
#ifdef OUTMASK
    {
        const size_t offs[12] = {OFF_YP, OFF_YS, OFF_MK, OFF_MV, OFF_SRP, OFF_SIP, OFF_CONVP, OFF_SRS, OFF_SIS, OFF_CONVS, OFF_SGV, OUT_TOTAL};
        for (int i = 0; i < 11; ++i) if (!((OUTMASK >> i) & 1)) (void)hipMemsetAsync((float*)d_out + offs[i], 0, (offs[i + 1] - offs[i]) * 4, stream);
    }
#endif
}
```

```cpp
#include <hip/hip_runtime.h>
#include <cstdio>
#include <cstdint>
namespace pg8 {
#define PG8_LAS __attribute__((address_space(3)))
typedef unsigned short bf16_t;
typedef short bf16x8 __attribute__((ext_vector_type(8)));
typedef float f32x4 __attribute__((ext_vector_type(4)));
typedef unsigned u32x4 __attribute__((ext_vector_type(4)));
constexpr int BM = 256, BK = 64, HALF = 128, HTB = HALF * BK * 2  , STAGE_BYTES = 8 * HTB, NXCD = 8, WGM = 8;

__host__ __device__ __forceinline__ int lds_byte(int r, int c) { const int st = (r >> 4) * 2 + (c >> 5), rr = r & 15, cc = c & 31, ob = rr * 64 + cc * 2; return st * 1024 + (ob ^ (((ob >> 9) & 1) << 5)); }
__host__ __device__ __forceinline__ void stage_rc(int b, int& R, int& C) { const int st = b / 1024, sb = b % 1024, swz = sb ^ (((sb >> 9) & 1) << 5); R = (st >> 1) * 16 + swz / 64; C = (st & 1) * 32 + (swz % 64) / 2; }
__host__ __device__ __forceinline__ int perm32(int rho) { const int n = rho >> 4, i = rho & 15; return 8 * (i >> 2) + 4 * n + (i & 3); }

struct Unit { int pm, pn; };
struct Gemm { const bf16_t* A; const bf16_t* Bt; int M, N, K; };

struct StaticOrder {
    int nM, nN, nwg, G, c;
    __host__ __device__ void init(int M, int N, int G_, int c_) { nM = M / BM; nN = N / BM; nwg = nM * nN; G = G_; c = c_; }
    __host__ __device__ bool next(int i, Unit& u) const {
        const long L = (long)i * G + c; if (L >= nwg) return false;
        int wgid = (int)L; { const int q = nwg / NXCD, r = nwg % NXCD, xcd = wgid % NXCD, off = wgid / NXCD; wgid = (xcd < r ? xcd * (q + 1) : r * (q + 1) + (xcd - r) * q) + off; }
        const int nig = WGM * nN, gid = wgid / nig, fm = gid * WGM, gsz = (nM - fm) < WGM ? (nM - fm) : WGM;
        u.pm = fm + ((wgid % nig) % gsz); u.pn = (wgid % nig) / gsz; return true;
    }
    __device__ __forceinline__ void a_ready(const Unit&) const {}
    __device__ __forceinline__ void done(const Unit&) const {}
};
__device__ __forceinline__ unsigned cvt_pk_bf16(float lo, float hi) { unsigned r; asm volatile("v_cvt_pk_bf16_f32 %0, %1, %2" : "=v"(r) : "v"(lo), "v"(hi)); return r; }
typedef float f32x2 __attribute__((ext_vector_type(2)));
template <class Epi, class Sched, bool ALIGN_EPI = false, bool SP2 = false>
__device__ __forceinline__ void gemm_phase(PG8_LAS unsigned char* lds, const Gemm g, const Sched& S, const Epi& E) {
    int tid = threadIdx.x; asm volatile("" : "+v"(tid)); const int wid = __builtin_amdgcn_readfirstlane(tid >> 6), lane = tid & 63, wr = wid >> 2, wc = wid & 3, fr = lane & 15, fq = lane >> 4;
    const int K = g.K, nt = K / BK;
    unsigned voffA[2], voffB[2];
#pragma unroll
    for (int i = 0; i < 2; ++i) { int R, C; stage_rc(tid * 16 + i * 8192, R, C); const int Rb = Epi::PERM ? ((R & ~31) + perm32(R & 31)) : R;
        voffA[i] = (unsigned)(R * K + C) * 2u; voffB[i] = (unsigned)(Rb * K + C) * 2u; }
    const size_t kstep = (size_t)(BK * 2);
    const size_t hstep = (size_t)HALF * K * 2;
    const size_t tstep = 2 * hstep;
    const unsigned ldsw = (unsigned)wid * 1024u;
    const int aoff = lds_byte(wr * 64 + fr, fq * 8), boff = lds_byte(wc * 32 + fr, fq * 8);
#define PG8_SA(b, h) (((b) * 2 + (h)) * HTB)
#define PG8_SB(b, h) ((4 + (b) * 2 + (h)) * HTB)
#define PG8_STAGE(bufoff, gbase, voff) do { _Pragma("unroll") for (int _i = 0; _i < 2; ++_i) \
        __builtin_amdgcn_global_load_lds((const unsigned*)((const char*)(gbase) + (voff)[_i]), (PG8_LAS unsigned*)(lds + (bufoff) + ldsw + _i * 8192), 16, 0, 0); } while (0)
#define PG8_LDA(dst, b, h) do { _Pragma("unroll") for (int m = 0; m < 4; ++m) _Pragma("unroll") for (int k = 0; k < 2; ++k) dst[m][k] = *(const PG8_LAS bf16x8*)(lds + PG8_SA(b, h) + aoff + m * 2048 + k * 1024); } while (0)
#define PG8_LDB(dst, b, h) do { _Pragma("unroll") for (int n = 0; n < 2; ++n) _Pragma("unroll") for (int k = 0; k < 2; ++k) dst[n][k] = *(const PG8_LAS bf16x8*)(lds + PG8_SB(b, h) + boff + n * 2048 + k * 1024); } while (0)
#define PG8_MMA(ai, bj, At, Bt) do { __builtin_amdgcn_s_setprio(1); _Pragma("unroll") for (int m = 0; m < 4; ++m) _Pragma("unroll") for (int n = 0; n < 2; ++n) _Pragma("unroll") for (int k = 0; k < 2; ++k) \
        acc[ai][bj][m][n] = __builtin_amdgcn_mfma_f32_16x16x32_bf16(Bt[n][k], At[m][k], acc[ai][bj][m][n], 0, 0, 0); __builtin_amdgcn_s_setprio(0); } while (0)
#define PG8_WAIT_V(n) asm volatile("s_waitcnt vmcnt(" #n ")" ::: "memory")
#define PG8_WAIT_L(n) asm volatile("s_waitcnt lgkmcnt(" #n ")" ::: "memory")
#define PG8_BAR __builtin_amdgcn_s_barrier()
#define PG8_SCHED __builtin_amdgcn_sched_barrier(0)
    Unit cur, nxt; int ui = 0;
    if (!S.next(0, cur)) return;
    f32x4 acc[2][2][4][2];
#pragma unroll
    for (int a = 0; a < 2; ++a)
#pragma unroll
        for (int b = 0; b < 2; ++b)
#pragma unroll
            for (int m = 0; m < 4; ++m)
#pragma unroll
                for (int n = 0; n < 2; ++n) acc[a][b][m][n] = (f32x4){0.f, 0.f, 0.f, 0.f};
    bf16x8 At[4][2], B0[2][2], B1[2][2];
    const char* cA = (const char*)g.A + (size_t)cur.pm * tstep; const char* cB = (const char*)g.Bt + (size_t)cur.pn * tstep;
    S.a_ready(cur);
    if constexpr (SP2) {
        PG8_STAGE(PG8_SB(0, 0), cB, voffB); PG8_STAGE(PG8_SB(0, 1), cB + hstep, voffB); PG8_STAGE(PG8_SA(0, 0), cA, voffA); PG8_STAGE(PG8_SA(0, 1), cA + hstep, voffA);
        if (wr == 1) PG8_BAR;
        PG8_WAIT_V(2); PG8_BAR;
        PG8_STAGE(PG8_SB(1, 0), cB + kstep, voffB); PG8_STAGE(PG8_SA(1, 0), cA + kstep, voffA); PG8_STAGE(PG8_SB(1, 1), cB + hstep + kstep, voffB);
        PG8_WAIT_V(6); PG8_BAR;
    } else {
        PG8_STAGE(PG8_SB(0, 0), cB, voffB); PG8_STAGE(PG8_SA(0, 0), cA, voffA); PG8_STAGE(PG8_SB(0, 1), cB + hstep, voffB); PG8_STAGE(PG8_SA(0, 1), cA + hstep, voffA);
        if (wr == 1) PG8_BAR;
        PG8_WAIT_V(4); PG8_BAR;
        PG8_STAGE(PG8_SB(1, 0), cB + kstep, voffB); PG8_STAGE(PG8_SA(1, 0), cA + kstep, voffA); PG8_STAGE(PG8_SB(1, 1), cB + hstep + kstep, voffB);
        PG8_WAIT_V(6); PG8_BAR;
    }
    for (;;) {
        const bool has_next = S.next(ui + 1, nxt);
        const char* nA = has_next ? (const char*)g.A + (size_t)nxt.pm * tstep : cA; const char* nB = has_next ? (const char*)g.Bt + (size_t)nxt.pn * tstep : cB;
        for (int t = 0; t < nt; t += 2) {
            const bool last = (t == nt - 2);
            const char* a1 = cA + (size_t)(t + 1) * kstep;
            const char* a2 = last ? nA : cA + (size_t)(t + 2) * kstep; const char* b2 = last ? nB : cB + (size_t)(t + 2) * kstep;
            const char* a3 = a2 + kstep; const char* b3 = b2 + kstep;
            if (last && has_next) S.a_ready(nxt);
            if constexpr (SP2) {
            PG8_LDB(B0, 0, 0); PG8_LDB(B1, 0, 1); PG8_SCHED; PG8_LDA(At, 0, 0); PG8_STAGE(PG8_SA(1, 1), a1 + hstep, voffA);
            PG8_WAIT_V(8); PG8_WAIT_L(0); PG8_BAR; PG8_MMA(0, 0, At, B0); PG8_MMA(0, 1, At, B1); PG8_BAR; PG8_SCHED;
            PG8_LDA(At, 0, 1); PG8_STAGE(PG8_SB(0, 0), b2, voffB); PG8_STAGE(PG8_SB(0, 1), b2 + hstep, voffB); PG8_STAGE(PG8_SA(0, 0), a2, voffA);
            PG8_WAIT_V(8); PG8_WAIT_L(0); PG8_BAR; PG8_MMA(1, 0, At, B0); PG8_MMA(1, 1, At, B1); PG8_BAR; PG8_SCHED;
            PG8_LDB(B0, 1, 0); PG8_LDB(B1, 1, 1); PG8_SCHED; PG8_LDA(At, 1, 0); PG8_STAGE(PG8_SA(0, 1), a2 + hstep, voffA);
            PG8_WAIT_V(8); PG8_WAIT_L(0); PG8_BAR; PG8_MMA(0, 0, At, B0); PG8_MMA(0, 1, At, B1); PG8_BAR; PG8_SCHED;
            PG8_LDA(At, 1, 1); PG8_STAGE(PG8_SB(1, 0), b3, voffB); PG8_STAGE(PG8_SB(1, 1), b3 + hstep, voffB); PG8_STAGE(PG8_SA(1, 0), a3, voffA);
            PG8_WAIT_V(8); PG8_WAIT_L(0); PG8_BAR; PG8_MMA(1, 0, At, B0); PG8_MMA(1, 1, At, B1); PG8_BAR; PG8_SCHED;
            } else {
            PG8_LDB(B0, 0, 0); PG8_SCHED; PG8_LDA(At, 0, 0); PG8_STAGE(PG8_SA(1, 1), a1 + hstep, voffA);
            PG8_WAIT_L(8); PG8_BAR; PG8_WAIT_L(0); PG8_MMA(0, 0, At, B0); PG8_BAR; PG8_SCHED;
            PG8_LDB(B1, 0, 1); PG8_STAGE(PG8_SB(0, 0), b2, voffB);
            PG8_BAR; PG8_WAIT_L(0); PG8_MMA(0, 1, At, B1); PG8_BAR;
            PG8_LDA(At, 0, 1); PG8_STAGE(PG8_SA(0, 0), a2, voffA);
            PG8_BAR; PG8_WAIT_L(0); PG8_MMA(1, 0, At, B0); PG8_BAR; PG8_SCHED;
            PG8_STAGE(PG8_SB(0, 1), b2 + hstep, voffB);
            PG8_WAIT_V(6); PG8_BAR; PG8_MMA(1, 1, At, B1); PG8_BAR;
            PG8_LDB(B0, 1, 0); PG8_SCHED; PG8_LDA(At, 1, 0); PG8_STAGE(PG8_SA(0, 1), a2 + hstep, voffA);
            PG8_WAIT_L(8); PG8_BAR; PG8_WAIT_L(0); PG8_MMA(0, 0, At, B0); PG8_BAR; PG8_SCHED;
            PG8_LDB(B1, 1, 1); PG8_STAGE(PG8_SB(1, 0), b3, voffB);
            PG8_BAR; PG8_WAIT_L(0); PG8_MMA(0, 1, At, B1); PG8_BAR;
            PG8_LDA(At, 1, 1); PG8_STAGE(PG8_SA(1, 0), a3, voffA);
            PG8_BAR; PG8_WAIT_L(0); PG8_MMA(1, 0, At, B0); PG8_BAR; PG8_SCHED;
            PG8_STAGE(PG8_SB(1, 1), b3 + hstep, voffB);
            PG8_WAIT_V(6); PG8_BAR; PG8_MMA(1, 1, At, B1); PG8_BAR;
            }
        }
        if constexpr (ALIGN_EPI) { if (wr == 0) PG8_BAR; }
        if constexpr (!Epi::AFTER_DRAIN) { E(acc, cur, wr, wc, fr, fq); S.done(cur); }
        if (!has_next) break;
#pragma unroll
        for (int a = 0; a < 2; ++a)
#pragma unroll
            for (int b = 0; b < 2; ++b)
#pragma unroll
                for (int m = 0; m < 4; ++m)
#pragma unroll
                    for (int n = 0; n < 2; ++n) acc[a][b][m][n] = (f32x4){0.f, 0.f, 0.f, 0.f};
        cur = nxt; cA = nA; cB = nB; ++ui;
        if constexpr (ALIGN_EPI) { if (wr == 1) PG8_BAR; }
    }
    PG8_WAIT_V(0);
    if constexpr (!ALIGN_EPI) { if (wr == 0) PG8_BAR; }
    PG8_BAR;
    if constexpr (Epi::AFTER_DRAIN) { E.fused(acc, cur, wr, wc, fr, fq, lds, wid, lane); S.done(cur); }
#undef PG8_SA
#undef PG8_SB
#undef PG8_STAGE
#undef PG8_LDA
#undef PG8_LDB
#undef PG8_MMA
#undef PG8_WAIT_V
#undef PG8_WAIT_L
#undef PG8_BAR
#undef PG8_SCHED
}
}
#define LAS_BAR __attribute__((address_space(3)))
#define XB_TMO      128
#define XB_XCNT(j)  (256  + 64 * (j))
#define XB_XSUB(j)  (1280 + 64 * (j))
#define XB_XGEN(j)  (2304 + 64 * (j))
#define XB_TOP      3328
#define XB_TOPGEN   3392
#define XCD_BAR_WORDS 3456
#define XB_SPIN_CAP (1u << 18)

__device__ __forceinline__ unsigned xb_ld(unsigned* p)              { return __hip_atomic_load(p, __ATOMIC_RELAXED, __HIP_MEMORY_SCOPE_AGENT); }
__device__ __forceinline__ unsigned xb_add(unsigned* p, unsigned v) { return __hip_atomic_fetch_add(p, v, __ATOMIC_RELAXED, __HIP_MEMORY_SCOPE_AGENT); }
__device__ __forceinline__ unsigned xb_xcc_id() { return (unsigned)__builtin_amdgcn_s_getreg((3 << 11) | 20) & 0xFu; }
#define XB_SPIN(cond, bar) do { unsigned _sp = 0; while (cond) { __builtin_amdgcn_s_sleep(1); \
    if ((++_sp & 255u) == 0u) { if (xb_ld(&(bar)[XB_TMO])) break; if (_sp > XB_SPIN_CAP) { atomicAdd(&(bar)[XB_TMO], 1u); break; } } } } while (0)

struct XcdBarrier {
    unsigned* bar; unsigned x;
    volatile LAS_BAR unsigned* st;
};

__device__ __forceinline__ XcdBarrier xcd_barrier_post(unsigned* bar, volatile LAS_BAR unsigned* st) {
    XcdBarrier b; b.bar = bar; b.x = xb_xcc_id(); b.st = st;
    if (threadIdx.x == 0) (void)xb_add(&bar[XB_XCNT(b.x)], 1u);
    return b;
}
__device__ __forceinline__ void xcd_barrier_complete(unsigned* bar, unsigned x, unsigned& nloc, unsigned& nx) {
    const unsigned G = gridDim.x * gridDim.y * gridDim.z;
    unsigned sum, cnt, mine, sp = 0u;
    for (;;) {
        sum = 0u; cnt = 0u; mine = 0u;
#pragma unroll
        for (unsigned j = 0; j < 16; ++j) { const unsigned c = xb_ld(&bar[XB_XCNT(j)]); sum += c; cnt += (c > 0u) ? 1u : 0u; mine = (j == x) ? c : mine; }
        if (sum == G) break;
        __builtin_amdgcn_s_sleep(1);
        if ((++sp & 255u) == 0u) { if (xb_ld(&bar[XB_TMO])) break; if (sp > XB_SPIN_CAP) { atomicAdd(&bar[XB_TMO], 1u); break; } }
    }
    nloc = mine > 0u ? mine : 1u; nx = cnt > 0u ? cnt : 1u;
}

__device__ __forceinline__ void xcd_barrier(const XcdBarrier& b) {
    asm volatile("s_waitcnt vmcnt(0)" ::: "memory");
    __syncthreads();
    if (threadIdx.x == 0) {
        unsigned* bar = b.bar;
        __builtin_amdgcn_s_waitcnt(0);
        unsigned nloc = b.st[0], nx = b.st[1];
        if (nloc == 0u) { xcd_barrier_complete(bar, b.x, nloc, nx); b.st[0] = nloc; b.st[1] = nx; }
        const unsigned old = xb_add(&bar[XB_XSUB(b.x)], 1u);
        const unsigned gen = old / nloc;
        if (old + 1u == (gen + 1u) * nloc) {
            __builtin_amdgcn_fence(__ATOMIC_RELEASE, "agent");
            asm volatile("s_waitcnt vmcnt(0)" ::: "memory");
            const unsigned og = xb_add(&bar[XB_TOP], 1u);
            const unsigned tg = og / nx;
            if (og + 1u == (tg + 1u) * nx) xb_add(&bar[XB_TOPGEN], 1u);
            else XB_SPIN(xb_ld(&bar[XB_TOPGEN]) == tg, bar);
            __builtin_amdgcn_fence(__ATOMIC_ACQUIRE, "agent");
            xb_add(&bar[XB_XGEN(b.x)], 1u);
            asm volatile("s_waitcnt vmcnt(0)" ::: "memory");
        } else {
            XB_SPIN(xb_ld(&bar[XB_XGEN(b.x)]) == gen, bar);
            __builtin_amdgcn_fence(__ATOMIC_ACQUIRE, "agent");
            asm volatile("s_waitcnt vmcnt(0)" ::: "memory");
        }
    }
    __syncthreads();
}
#define GAS __attribute__((address_space(1)))
#define LAS __attribute__((address_space(3)))
typedef unsigned short bf16;
typedef unsigned v4u __attribute__((ext_vector_type(4)));
typedef unsigned v2u __attribute__((ext_vector_type(2)));
typedef float f32x4 __attribute__((ext_vector_type(4)));
typedef short bf16x8 __attribute__((ext_vector_type(8)));
typedef short bf16x4 __attribute__((ext_vector_type(4)));

constexpr int NWAVES = 8, NTHR = 512;
constexpr int D = 2048, SEQ = 2048, MP = 8192, MS = 128, MREAL = 8320, MT = 8448;
constexpr int MMEM = 1024, XAW = 512, TOKW = 1536, SGN = 3584, DFF = 5504, NUP = 11008;
constexpr int NGRP = 96, KH = 384;
constexpr float EPS = 1e-6f;
constexpr int NPHASE = 31;

constexpr size_t OFF_YP = 0, OFF_YS = 16777216, OFF_MK = 17039360, OFF_MV = 19136512, OFF_SRP = 21233664, OFF_SIP = 21282816,
                 OFF_CONVP = 21331968, OFF_SRS = 21508096, OFF_SIS = 23080960, OFF_CONVS = 24653824, OFF_SGV = 30289920, OUT_TOTAL = 30683136;

constexpr size_t MiB = 1u << 20;
constexpr size_t WS_CTL = 0, CTL_ZERO_BYTES = 1 * MiB;
constexpr size_t WS_WSGIN = 1 * MiB;
constexpr size_t WS_WSSMIN = WS_WSGIN + 28 * MiB;
constexpr size_t WS_WSGOUT = WS_WSSMIN + 16 * MiB;
constexpr size_t WS_WSSMOUT = WS_WSGOUT + 16 * MiB;
constexpr size_t WS_WGLU = WS_WSSMOUT + 16 * MiB;
constexpr size_t WS_WUP = WS_WGLU + 9 * MiB;
constexpr size_t WS_WDOWN = WS_WUP + 172 * MiB;
constexpr size_t WS_WMEM = WS_WDOWN + 86 * MiB;
constexpr size_t WS_WSB = WS_WMEM + 16 * MiB;
constexpr size_t WS_TB = WS_WSB + 1 * MiB;
constexpr size_t WS_BT2 = WS_TB + 36 * MiB;
constexpr size_t WS_LBT = WS_BT2 + 12 * MiB;
constexpr size_t WS_LB16 = WS_LBT + 128 * 1024;
constexpr size_t WS_BBAR = WS_LBT + 1 * MiB;
constexpr size_t WS_XRES = WS_BBAR + 2 * MiB;
constexpr size_t WS_XB = WS_XRES + 66 * MiB;
constexpr size_t WS_MEMB = WS_XB + 33 * MiB;
constexpr size_t WS_MKV = WS_MEMB + 4 * MiB;
constexpr size_t WS_ZU = WS_MKV + 8 * MiB;
constexpr size_t WS_ZV = WS_ZU + 25 * MiB;
constexpr size_t WS_Q = WS_ZV + 25 * MiB;
constexpr size_t WS_MIX = WS_Q + 9 * MiB;
constexpr size_t WS_AG = WS_MIX + 33 * MiB;
constexpr size_t WS_Y = WS_AG + 178 * MiB;
constexpr size_t WS_UH = WS_Y + 89 * MiB;
constexpr size_t WS_YB = WS_UH + 36 * MiB;
constexpr size_t WS_US = WS_YB + 25 * MiB;
constexpr size_t WS_FXA = WS_US + 1 * MiB;
constexpr size_t WS_FXG = WS_FXA + 3 * MiB;
constexpr size_t WS_END = WS_FXG + 2 * MiB;
constexpr int CW_BAR = 4096;
typedef unsigned long long ssq_t;
constexpr size_t CTL_SSX = 64 * 1024;
constexpr size_t CTL_SSV = 704 * 1024;
constexpr size_t CTL_SSMEM = 896 * 1024;
static_assert(CTL_SSX + 9 * MT * 8 <= CTL_SSV && CTL_SSV + 2 * MT * 8 <= CTL_SSMEM && CTL_SSMEM + 8192 <= CTL_ZERO_BYTES, "ctl map");

constexpr int LDS_BYTES = 147456, MISC_OFF = LDS_BYTES - 512, HALO_OFF = 131072;

__device__ __forceinline__ unsigned pk2(float lo, float hi) { return pg8::cvt_pk_bf16(lo, hi); }
__device__ __forceinline__ float bflo(unsigned w) { return __uint_as_float(w << 16); }
__device__ __forceinline__ float bfhi(unsigned w) { return __uint_as_float(w & 0xffff0000u); }
__device__ __forceinline__ float gelu_t(float x) { const float e = __builtin_amdgcn_exp2f(x * (-2.3022082f - 0.10294324f * x * x)); return x * __builtin_amdgcn_rcpf(1.f + e); }
__device__ __forceinline__ float sigmoid_f(float x) { return __builtin_amdgcn_rcpf(1.f + __builtin_amdgcn_exp2f(-1.4426950409f * x)); }
__device__ __forceinline__ ssq_t ss_fix(float v) { return (ssq_t)(long long)(v * 1073741824.0f); }
__device__ __forceinline__ float rstd_of(ssq_t ss, float inv_n) { return rsqrtf((float)ss * (1.0f / 1073741824.0f) * inv_n + EPS); }
__device__ __forceinline__ float wave_sum(float v) {
#pragma unroll
    for (int o = 1; o < 64; o <<= 1) v += __shfl_xor(v, o);
    return v;
}
__device__ __forceinline__ float wave_max(float v) {
#pragma unroll
    for (int o = 1; o < 64; o <<= 1) v = fmaxf(v, __shfl_xor(v, o));
    return v;
}
__device__ __forceinline__ void fadd_atomic(ssq_t* p, float v) { atomicAdd(p, ss_fix(v)); }
__device__ __forceinline__ f32x4 gelu4(f32x4 v) { return (f32x4){gelu_t(v[0]), gelu_t(v[1]), gelu_t(v[2]), gelu_t(v[3])}; }
__device__ __forceinline__ v4u pack8(f32x4 a, f32x4 b) { v4u w; w.x = pk2(a[0], a[1]); w.y = pk2(a[2], a[3]); w.z = pk2(b[0], b[1]); w.w = pk2(b[2], b[3]); return w; }
__device__ __forceinline__ float dot4(f32x4 a) { return (a[0] * a[0] + a[1] * a[1]) + (a[2] * a[2] + a[3] * a[3]); }

typedef const f32x4 (&AccRef)[2][2][4][2];
struct EpiSgIn {
    static constexpr bool PERM = true, AFTER_DRAIN = false;
    const ssq_t* ss; bf16* zu; bf16* zv; bf16* q; ssq_t* ssv;
    __device__ __forceinline__ void operator()(AccRef acc, const pg8::Unit& u, int wr, int wc, int fr, int fq) const {
        const int row0 = u.pm * 256 + wr * 64 + fr, colt = u.pn * 256 + wc * 32 + 8 * fq;
        const int kind = u.pn < 6 ? 0 : (u.pn < 12 ? 1 : 2);
#pragma unroll
        for (int ai = 0; ai < 2; ++ai)
#pragma unroll
            for (int m = 0; m < 4; ++m) {
                const int r = row0 + ai * 128 + m * 16; const float rs = rstd_of(ss[r], 1.f / 2048.f); float sq = 0.f;
#pragma unroll
                for (int bj = 0; bj < 2; ++bj) {
                    f32x4 v0 = acc[ai][bj][m][0] * rs, v1 = acc[ai][bj][m][1] * rs; const int c = colt + bj * 128;
                    if (kind < 2) { v0 = gelu4(v0); v1 = gelu4(v1); }
                    if (kind == 1) sq += dot4(v0) + dot4(v1);
                    bf16* dst = kind == 0 ? zu + (size_t)r * TOKW + c : (kind == 1 ? zv + (size_t)r * TOKW + (c - TOKW) : q + (size_t)r * XAW + (c - 2 * TOKW));
                    *(v4u*)dst = pack8(v0, v1);
                }
                if (kind == 1) { sq += __shfl_xor(sq, 16); sq += __shfl_xor(sq, 32); if (fq == 0) fadd_atomic(ssv + r, sq); }
                asm volatile("" ::: "memory");
            }
    }
};
struct EpiRes {
    static constexpr bool PERM = true, AFTER_DRAIN = false;
    bf16* xb; ssq_t* ssn;
    __device__ __forceinline__ void operator()(AccRef acc, const pg8::Unit& u, int wr, int wc, int fr, int fq) const {
        const int row0 = u.pm * 256 + wr * 64 + fr, col0 = u.pn * 256 + wc * 32 + 8 * fq;
#pragma unroll
        for (int ai = 0; ai < 2; ++ai)
#pragma unroll
            for (int m = 0; m < 4; ++m) {
                const int r = row0 + ai * 128 + m * 16; float sq = 0.f; bf16* bp = xb + (size_t)r * D + col0;
#pragma unroll
                for (int bj = 0; bj < 2; ++bj) { const v4u xw = *(const v4u*)(bp + bj * 128);
                    const f32x4 o0 = (f32x4){bflo(xw.x), bfhi(xw.x), bflo(xw.y), bfhi(xw.y)} + acc[ai][bj][m][0], o1 = (f32x4){bflo(xw.z), bfhi(xw.z), bflo(xw.w), bfhi(xw.w)} + acc[ai][bj][m][1];
                    sq += dot4(o0) + dot4(o1); *(v4u*)(bp + bj * 128) = pack8(o0, o1); }
                sq += __shfl_xor(sq, 16); sq += __shfl_xor(sq, 32); if (fq == 0) fadd_atomic(ssn + r, sq);
                asm volatile("" ::: "memory");
            }
    }
};
__device__ __forceinline__ float dpp_f(float old, float src, const int ctrl_sel) {
    const int o = __builtin_bit_cast(int, old), v = __builtin_bit_cast(int, src); int r;
    if (ctrl_sel == 0) r = __builtin_amdgcn_update_dpp(o, v, 0x111, 0xf, 0xf, false);
    else if (ctrl_sel == 1) r = __builtin_amdgcn_update_dpp(o, v, 0x112, 0xf, 0xf, false);
    else if (ctrl_sel == 2) r = __builtin_amdgcn_update_dpp(o, v, 0x121, 0xf, 0xf, false);
    else r = __builtin_amdgcn_update_dpp(o, v, 0x122, 0xf, 0xf, false);
    return __builtin_bit_cast(float, r);
}
struct EpiUp {
    static constexpr bool PERM = true, AFTER_DRAIN = false;
    const ssq_t* ss; bf16* yf; float* out; const float* stc; const float* cw; const float* cb; float* fxa; float* fxg; LAS float* halo; int layer;
    __device__ __forceinline__ void operator()(AccRef acc, const pg8::Unit& u, int wr, int wc, int fr, int fq) const {
        const int row0 = u.pm * 256 + wr * 64 + fr, cl = wc * 32 + 8 * fq, c0 = u.pn * 128 + cl;
        float rs[2][4];
#pragma unroll
        for (int ai = 0; ai < 2; ++ai)
#pragma unroll
            for (int m = 0; m < 4; ++m) rs[ai][m] = rstd_of(ss[row0 + ai * 128 + m * 16], 1.f / 2048.f);
        const bool sample = (u.pm == MP / 256);
        if (!sample) {
            if (fr >= 14) {
#pragma unroll
                for (int ai = 0; ai < 2; ++ai)
#pragma unroll
                    for (int n = 0; n < 2; ++n) *(LAS f32x4*)(halo + ((2 * ai + wr) * 2 + (fr - 14)) * 128 + cl + 4 * n) = acc[ai][0][3][n] * rs[ai][3];
            }
            asm volatile("s_waitcnt lgkmcnt(0)" ::: "memory"); __builtin_amdgcn_s_barrier(); asm volatile("" ::: "memory");
        }
#pragma unroll
        for (int n = 0; n < 2; ++n) {
            const int c = c0 + 4 * n;
            const f32x4 k0 = *(const f32x4*)(cw + c), k1 = *(const f32x4*)(cw + DFF + c), k2 = *(const f32x4*)(cw + 2 * DFF + c), kb = *(const f32x4*)(cb + c);
#pragma unroll
            for (int ai = 0; ai < 2; ++ai) {
                f32x4 prev = (f32x4){0.f, 0.f, 0.f, 0.f};
                if (!sample && (ai + wr) > 0 && fr >= 14) prev = *(const LAS f32x4*)(halo + ((2 * ai + wr - 1) * 2 + (fr - 14)) * 128 + cl + 4 * n);
#pragma unroll
                for (int m = 0; m < 4; ++m) {
                    const int r = row0 + ai * 128 + m * 16; const f32x4 a = acc[ai][0][m][n] * rs[ai][m], g = acc[ai][1][m][n] * rs[ai][m];
                    f32x4 p1, p2;
                    if (!sample) {
#pragma unroll
                        for (int i = 0; i < 4; ++i) { p1[i] = dpp_f(dpp_f(0.f, prev[i], 2), a[i], 0); p2[i] = dpp_f(dpp_f(0.f, prev[i], 3), a[i], 1); }
                    } else if (r < MREAL) {
                        const float* sp = stc + ((size_t)(r - MP) * 2) * DFF + c; p2 = *(const f32x4*)sp; p1 = *(const f32x4*)(sp + DFF);
                        float* co = out + OFF_CONVS + ((size_t)(layer * MS + (r - MP)) * 2) * DFF + c; *(f32x4*)co = p1; *(f32x4*)(co + DFF) = a;
                    } else { p1 = prev; p2 = prev; }
                    f32x4 y;
#pragma unroll
                    for (int i = 0; i < 4; ++i) { const float cc = kb[i] + k0[i] * p2[i] + k1[i] * p1[i] + k2[i] * a[i]; y[i] = cc * sigmoid_f(cc) * g[i]; }
                    if (r < MREAL) { v2u w; w.x = pk2(y[0], y[1]); w.y = pk2(y[2], y[3]); *(v2u*)(yf + (size_t)r * DFF + c) = w; }
                    if (!sample) {
                        const int lr = ai * 128 + wr * 64 + m * 16 + fr;
                        if (lr < 2) { *(f32x4*)(fxa + ((size_t)(u.pm * 4 + lr)) * DFF + c) = a; *(f32x4*)(fxg + ((size_t)(u.pm * 2 + lr)) * DFF + c) = g; }
                        if (lr >= 254) { *(f32x4*)(fxa + ((size_t)(u.pm * 4 + lr - 252)) * DFF + c) = a;
                            if ((u.pm & 7) == 7) *(f32x4*)(out + OFF_CONVP + ((size_t)((layer * 4 + (u.pm >> 3)) * 2 + (lr - 254))) * DFF + c) = a; }
                    }
                    prev = a;
                }
            }
        }
    }
};
struct EpiSsmIn {
    static constexpr bool PERM = true, AFTER_DRAIN = false;
    const ssq_t* ss; bf16* uh; float* us; bf16* q;
    __device__ __forceinline__ void operator()(AccRef acc, const pg8::Unit& u, int wr, int wc, int fr, int fq) const {
        const int row0 = u.pm * 256 + wr * 64 + fr, colt = u.pn * 256 + wc * 32 + 8 * fq;
#pragma unroll
        for (int ai = 0; ai < 2; ++ai)
#pragma unroll
            for (int m = 0; m < 4; ++m) {
                const int r = row0 + ai * 128 + m * 16; const float rs = rstd_of(ss[r], 1.f / 2048.f);
#pragma unroll
                for (int bj = 0; bj < 2; ++bj) {
                    const f32x4 v0 = acc[ai][bj][m][0] * rs, v1 = acc[ai][bj][m][1] * rs; const int c = colt + bj * 128;
                    if (u.pn < 6) {
                        if (r < MP) { const int h = c >> 4, c0 = c & 15; *(v4u*)(uh + ((size_t)(h * 512 + (r >> 4)) * KH + (r & 15) * 16 + c0)) = pack8(v0, v1); }
                        else if (r < MREAL) { float* o = us + (size_t)(r - MP) * TOKW + c; *(f32x4*)o = v0; *(f32x4*)(o + 4) = v1; }
                    } else *(v4u*)(q + (size_t)r * XAW + (c - TOKW)) = pack8(v0, v1);
                }
                asm volatile("" ::: "memory");
            }
    }
};
struct EpiToep {
    static constexpr bool PERM = true, AFTER_DRAIN = false;
    bf16* yb;
    __device__ __forceinline__ void operator()(AccRef acc, const pg8::Unit& u, int wr, int wc, int fr, int fq) const {
        const int h = u.pn, mh = u.pm - 2 * h;
#pragma unroll
        for (int ai = 0; ai < 2; ++ai)
#pragma unroll
            for (int m = 0; m < 4; ++m) {
                const int ml = mh * 256 + ai * 128 + wr * 64 + m * 16 + fr;
#pragma unroll
                for (int bj = 0; bj < 2; ++bj) {
                    const int cl = bj * 128 + wc * 32 + 8 * fq, tau = cl >> 4, c0 = cl & 15;
                    *(v4u*)(yb + (size_t)(ml * 16 + tau) * TOKW + h * 16 + c0) = pack8(gelu4(acc[ai][bj][m][0]), gelu4(acc[ai][bj][m][1]));
                    __builtin_amdgcn_sched_barrier(0);
                }
            }
    }
};
struct EpiGlu {
    static constexpr bool PERM = true, AFTER_DRAIN = false;
    const bf16* yb; const float* bias; bf16* mix;
    __device__ __forceinline__ void operator()(AccRef acc, const pg8::Unit& u, int wr, int wc, int fr, int fq) const {
        const int row0 = u.pm * 256 + wr * 64 + fr, colt = u.pn * 256 + wc * 32 + 8 * fq;
#pragma unroll
        for (int ai = 0; ai < 2; ++ai)
#pragma unroll
            for (int m = 0; m < 4; ++m) {
                const int r = row0 + ai * 128 + m * 16;
#pragma unroll
                for (int bj = 0; bj < 2; ++bj) {
                    const int c = colt + bj * 128; const f32x4 b0 = *(const f32x4*)(bias + c), b1 = *(const f32x4*)(bias + c + 4);
                    const v4u yw = *(const v4u*)(yb + (size_t)r * TOKW + c);
                    const f32x4 g0 = acc[ai][bj][m][0] + b0, g1 = acc[ai][bj][m][1] + b1;
                    f32x4 o0, o1;
                    o0[0] = bflo(yw.x) * sigmoid_f(g0[0]); o0[1] = bfhi(yw.x) * sigmoid_f(g0[1]); o0[2] = bflo(yw.y) * sigmoid_f(g0[2]); o0[3] = bfhi(yw.y) * sigmoid_f(g0[3]);
                    o1[0] = bflo(yw.z) * sigmoid_f(g1[0]); o1[1] = bfhi(yw.z) * sigmoid_f(g1[1]); o1[2] = bflo(yw.w) * sigmoid_f(g1[2]); o1[3] = bfhi(yw.w) * sigmoid_f(g1[3]);
                    *(v4u*)(mix + (size_t)r * D + c) = pack8(o0, o1);
                    asm volatile("" ::: "memory");
                }
            }
    }
};
struct EpiMem {
    static constexpr bool PERM = false, AFTER_DRAIN = false;
    const ssq_t* ssm; float* out; bf16* mkv;
    __device__ __forceinline__ void operator()(AccRef acc, const pg8::Unit& u, int wr, int wc, int fr, int fq) const {
        const int row0 = u.pm * 256 + wr * 64 + fr, col0 = u.pn * 256 + wc * 32 + 4 * fq;
#pragma unroll
        for (int ai = 0; ai < 2; ++ai)
#pragma unroll
            for (int m = 0; m < 4; ++m) {
                const int r = row0 + ai * 128 + m * 16; const float rs = rstd_of(ssm[r], 1.f / 2048.f);
#pragma unroll
                for (int bj = 0; bj < 2; ++bj)
#pragma unroll
                    for (int n = 0; n < 2; ++n) { const int c = col0 + bj * 128 + n * 16, li = c >> 10, cc = c & 1023; const f32x4 v = acc[ai][bj][m][n] * rs;
                        *(f32x4*)(out + (cc < 512 ? OFF_MK : OFF_MV) + (size_t)(li * 1024 + r) * 512 + (cc & 511)) = v;
                        v2u w; w.x = pk2(v[0], v[1]); w.y = pk2(v[2], v[3]); *(v2u*)(mkv + (size_t)(li * 1024 + r) * 1024 + cc) = w; }
            }
    }
};
struct ToepOrder {
    int G, c;
    __device__ bool next(int i, pg8::Unit& u) const { const int L = i * G + c; if (L >= 2 * NGRP) return false; const int h = L >> 1; u.pm = 2 * h + (L & 1); u.pn = h; return true; }
    __device__ __forceinline__ void a_ready(const pg8::Unit&) const {}
    __device__ __forceinline__ void done(const pg8::Unit&) const {}
};

constexpr int P0_TLD = 130;
constexpr int P0_T0 = 896, P0_T1 = P0_T0 + 512, P0_T2 = P0_T1 + 512, P0_T3 = P0_T2 + 512, P0_T4 = P0_T3 + 288, P0_T5 = P0_T4 + 5504, P0_T6 = P0_T5 + 2752, P0_NTILES = P0_T6 + 512;
struct P0Desc { const float* W; const float* gn; bf16* WT; int K, N, roff, tile, perm; };
struct Args;
__device__ __forceinline__ P0Desc p0_decode(int t, const float* const* in, unsigned char* wsb) {
    P0Desc d; d.gn = nullptr; d.roff = 0; d.perm = 0;
    if (t < P0_T0) { const int mi = t / 448; d.tile = t - mi * 448; d.W = in[13] + (size_t)mi * D * SGN; d.gn = in[8] + (2 * mi) * D; d.K = D; d.N = SGN; d.WT = (bf16*)(wsb + WS_WSGIN) + (size_t)mi * SGN * D; }
    else if (t < P0_T1) { t -= P0_T0; const int mi = t >> 8; d.tile = t & 255; d.W = in[18] + (size_t)mi * D * D; d.gn = in[8] + (2 * mi + 1) * D; d.K = D; d.N = D; d.WT = (bf16*)(wsb + WS_WSSMIN) + (size_t)mi * D * D; }
    else if (t < P0_T2) { t -= P0_T1; const int mi = t >> 8; d.tile = t & 255; d.W = in[14] + (size_t)mi * D * D; d.K = D; d.N = D; d.WT = (bf16*)(wsb + WS_WSGOUT) + (size_t)mi * D * D; }
    else if (t < P0_T3) { t -= P0_T2; const int mi = t >> 8; d.tile = t & 255; d.W = in[19] + (size_t)mi * D * D; d.K = D; d.N = D; d.WT = (bf16*)(wsb + WS_WSSMOUT) + (size_t)mi * D * D; }
    else if (t < P0_T4) { t -= P0_T3; const int mi = t / 144; d.tile = t - mi * 144; d.W = in[28] + (size_t)mi * TOKW * TOKW; d.K = TOKW; d.N = TOKW; d.WT = (bf16*)(wsb + WS_WGLU) + (size_t)mi * TOKW * TOKW; }
    else if (t < P0_T5) { t -= P0_T4; const int mi = t / 1376; d.tile = t - mi * 1376; d.W = in[30] + (size_t)mi * D * NUP; d.gn = in[9] + mi * D; d.K = D; d.N = NUP; d.WT = (bf16*)(wsb + WS_WUP) + (size_t)mi * NUP * D; d.perm = 1; }
    else if (t < P0_T6) { t -= P0_T5; const int mi = t / 688; d.tile = t - mi * 688; d.W = in[33] + (size_t)mi * DFF * D; d.K = DFF; d.N = D; d.WT = (bf16*)(wsb + WS_WDOWN) + (size_t)mi * D * DFF; }
    else { t -= P0_T6; const int mi = t >> 7; d.tile = t & 127; d.W = in[12] + (size_t)mi * D * 1024; d.gn = in[10] + mi * D; d.K = D; d.N = 1024; d.WT = (bf16*)(wsb + WS_WMEM); d.roff = mi * 1024; }
    return d;
}
__device__ __forceinline__ void p0_load(const P0Desc& d, f32x4 (&v)[8], int tid) {
    const int nbn = d.N >> 7, kb = d.tile / nbn, nb = d.tile - kb * nbn; const float* p = d.W + (size_t)((kb << 7) + (tid >> 5)) * d.N + (nb << 7) + (tid & 31) * 4;
#pragma unroll
    for (int it = 0; it < 8; ++it) v[it] = *(const f32x4*)(p + (size_t)(16 * it) * d.N);
}
__device__ __forceinline__ void p0_to_lds(const P0Desc& d, const f32x4 (&v)[8], LAS bf16* T, int tid) {
    const int nbn = d.N >> 7, kb = d.tile / nbn, k0 = kb << 7, kq = tid >> 5, n4 = (tid & 31) * 4;
#pragma unroll
    for (int it = 0; it < 8; ++it) { const int kk = kq + 16 * it; const float g = d.gn ? d.gn[k0 + kk] : 1.f;
        LAS unsigned* p = (LAS unsigned*)(T + kk * P0_TLD + n4); p[0] = pk2(v[it][0] * g, v[it][1] * g); p[1] = pk2(v[it][2] * g, v[it][3] * g); }
}
__device__ __forceinline__ void p0_store(const P0Desc& d, const LAS bf16* T, int tid) {
    const int nbn = d.N >> 7, kb = d.tile / nbn, nb = d.tile - kb * nbn, k0 = kb << 7, n0 = (d.perm ? (nb < 43 ? 2 * nb : 2 * (nb - 43) + 1) : nb) << 7;
#pragma unroll
    for (int j = 0; j < 4; ++j) { const int p = tid + 512 * j, n = p >> 4, kg = p & 15; const LAS bf16* s_ = T + (kg * 8) * P0_TLD + n;
        v4u o; o.x = (unsigned)s_[0] | ((unsigned)s_[P0_TLD] << 16); o.y = (unsigned)s_[2 * P0_TLD] | ((unsigned)s_[3 * P0_TLD] << 16);
        o.z = (unsigned)s_[4 * P0_TLD] | ((unsigned)s_[5 * P0_TLD] << 16); o.w = (unsigned)s_[6 * P0_TLD] | ((unsigned)s_[7 * P0_TLD] << 16);
        *(v4u*)(d.WT + (size_t)(d.roff + n0 + n) * d.K + k0 + kg * 8) = o; }
}
__device__ __forceinline__ void p0_row(const float* src, float* dstf, bf16* dstb, ssq_t* ssp, int lane) {
    f32x4 v[8]; float s = 0.f;
#pragma unroll
    for (int j = 0; j < 8; ++j) { v[j] = src ? ((const f32x4*)src)[lane + 64 * j] : (f32x4){0.f, 0.f, 0.f, 0.f}; s += dot4(v[j]); }
    s = wave_sum(s);
#pragma unroll
    for (int j = 0; j < 8; ++j) { if (dstf) ((f32x4*)dstf)[lane + 64 * j] = v[j]; v2u w; w.x = pk2(v[j][0], v[j][1]); w.y = pk2(v[j][2], v[j][3]); ((v2u*)dstb)[lane + 64 * j] = w; }
    if (lane == 0) *ssp = ss_fix(s);
}
__device__ __forceinline__ void s5_tables(LAS float* L, int j, int h, const float* lam_re, const float* lam_im, const float* log_dt, const float* b_re, const float* b_im,
                                          const float* c_re, const float* c_im, const float* dvec, bf16* TB, bf16* BT2, float* LBT, float* LB16, float* BBART, int tid) {
    LAS float* PWr = L; LAS float* PWi = L + 1088; LAS float* BBr = L + 2176; LAS float* BBi = L + 3200; LAS float* Cr = L + 4224; LAS float* Ci = L + 5248; LAS float* KM = L + 6272;
    const int gh = j * NGRP + h;
    if (tid < 64) {
        const int p = tid, idx = gh * 64 + p; const float lr = lam_re[idx], li = lam_im[idx], dt = expf(log_dt[gh]);
        const float ar = lr * dt, ai = li * dt, mag = expf(ar); float sn, cs; sincosf(ai, &sn, &cs);
        const float lbr = mag * cs, lbi = mag * sn; const float sh = sinf(0.5f * ai);
        const float nr = expm1f(ar) * cs - 2.f * sh * sh, ni = lbi, den = lr * lr + li * li;
        const float kr = (nr * lr + ni * li) / den, ki = (ni * lr - nr * li) / den;
        float pr = 1.f, pi = 0.f;
#pragma unroll
        for (int n = 0; n < 17; ++n) { PWr[p * 17 + n] = pr; PWi[p * 17 + n] = pi; if (n == 16) { LB16[idx * 2] = pr; LB16[idx * 2 + 1] = pi; } const float t = pr * lbr - pi * lbi; pi = pr * lbi + pi * lbr; pr = t; }
        LBT[idx * 2] = lbr; LBT[idx * 2 + 1] = lbi;
#pragma unroll
        for (int c = 0; c < 16; ++c) { const float br = b_re[(size_t)idx * 16 + c], bi = b_im[(size_t)idx * 16 + c]; const float xr = kr * br - ki * bi, xi = kr * bi + ki * br;
            BBr[p * 16 + c] = xr; BBi[p * 16 + c] = xi; BBART[((size_t)idx * 16 + c) * 2] = xr; BBART[((size_t)idx * 16 + c) * 2 + 1] = xi; }
    }
#pragma unroll
    for (int i = 0; i < 2; ++i) { const int e = tid + 512 * i; Cr[e] = c_re[(size_t)gh * 1024 + e]; Ci[e] = c_im[(size_t)gh * 1024 + e]; }
    __syncthreads();
#pragma unroll 1
    for (int i = 0; i < 8; ++i) {
        const int e = tid * 8 + i, dl = e >> 8, c = (e >> 4) & 15, c2 = e & 15; float s = 0.f;
#pragma unroll 4
        for (int p = 0; p < 64; ++p) { const float wr_ = PWr[p * 17 + dl], wi_ = PWi[p * 17 + dl], xr = BBr[p * 16 + c2], xi = BBi[p * 16 + c2];
            s += Cr[c * 64 + p] * (wr_ * xr - wi_ * xi) - Ci[c * 64 + p] * (wr_ * xi + wi_ * xr); }
        if (dl == 0 && c == c2) s += dvec[j * TOKW + h * 16 + c];
        KM[e] = s;
    }
    __syncthreads();
#pragma unroll 1
    for (int it = 0; it < 24; ++it) {
        const int grp = tid + 512 * it, row = grp / 48, cg = grp % 48, tau = row >> 4, c = row & 15; float v[8];
        if (cg < 32) { const int sg = cg >> 1, c0 = (cg & 1) * 8;
#pragma unroll
            for (int i = 0; i < 8; ++i) v[i] = sg <= tau ? KM[(tau - sg) * 256 + c * 16 + c0 + i] : 0.f; }
        else if (cg < 40) {
#pragma unroll
            for (int i = 0; i < 8; ++i) { const int p = (cg - 32) * 8 + i; v[i] = Cr[c * 64 + p] * PWr[p * 17 + tau + 1] - Ci[c * 64 + p] * PWi[p * 17 + tau + 1]; } }
        else {
#pragma unroll
            for (int i = 0; i < 8; ++i) { const int p = (cg - 40) * 8 + i; v[i] = -(Cr[c * 64 + p] * PWi[p * 17 + tau + 1] + Ci[c * 64 + p] * PWr[p * 17 + tau + 1]); } }
        v4u w; w.x = pk2(v[0], v[1]); w.y = pk2(v[2], v[3]); w.z = pk2(v[4], v[5]); w.w = pk2(v[6], v[7]);
        *(v4u*)(TB + ((size_t)gh * 256 + row) * KH + cg * 8) = w;
    }
#pragma unroll 1
    for (int it = 0; it < 8; ++it) {
        const int grp = tid + 512 * it, row = grp >> 5, cg = grp & 31, ri = row >> 6, p = row & 63, n = 15 - (cg >> 1), c0 = (cg & 1) * 8; float v[8];
        const float wr_ = PWr[p * 17 + n], wi_ = PWi[p * 17 + n];
#pragma unroll
        for (int i = 0; i < 8; ++i) { const float xr = BBr[p * 16 + c0 + i], xi = BBi[p * 16 + c0 + i]; v[i] = ri == 0 ? (wr_ * xr - wi_ * xi) : (wr_ * xi + wi_ * xr); }
        v4u w; w.x = pk2(v[0], v[1]); w.y = pk2(v[2], v[3]); w.z = pk2(v[4], v[5]); w.w = pk2(v[6], v[7]);
        *(v4u*)(BT2 + ((size_t)gh * 128 + row) * 256 + cg * 8) = w;
    }
    __syncthreads();
}

constexpr int KS_LD = 136, VT_LD = 264, VT_OFF = 256 * KS_LD * 2;
__device__ __forceinline__ void attn_prompt_unit(LAS unsigned char* lds, const bf16* q, const bf16* mkv_l, bf16* mix, int unit, int tid) {
    const int b = unit >> 6, hd = (unit >> 4) & 3, qb = unit & 15, lane = tid & 63, w = tid >> 6, fr = lane & 15, fq = lane >> 4;
    LAS bf16* Ks = (LAS bf16*)lds; LAS bf16* Vt = (LAS bf16*)(lds + VT_OFF);
    const bf16* kvb = mkv_l + (size_t)(b * 256) * 1024 + hd * 128;
#pragma unroll
    for (int it = 0; it < 8; ++it) { const int id = tid + 512 * it, key = id >> 4, part = id & 15;
        const v4u kw = *(const v4u*)(kvb + (size_t)key * 1024 + part * 8); *(LAS v4u*)(Ks + key * KS_LD + part * 8) = kw;
        const v4u vw = *(const v4u*)(kvb + (size_t)key * 1024 + 512 + part * 8); LAS bf16* vp = Vt + (part * 8) * VT_LD + key;
        vp[0] = (bf16)(vw.x & 0xffff); vp[VT_LD] = (bf16)(vw.x >> 16); vp[2 * VT_LD] = (bf16)(vw.y & 0xffff); vp[3 * VT_LD] = (bf16)(vw.y >> 16);
        vp[4 * VT_LD] = (bf16)(vw.z & 0xffff); vp[5 * VT_LD] = (bf16)(vw.z >> 16); vp[6 * VT_LD] = (bf16)(vw.w & 0xffff); vp[7 * VT_LD] = (bf16)(vw.w >> 16); }
    const int r = b * SEQ + qb * 128 + w * 16 + fr;
    bf16x8 qf[4];
#pragma unroll
    for (int ks = 0; ks < 4; ++ks) qf[ks] = *(const bf16x8*)(q + (size_t)r * XAW + hd * 128 + ks * 32 + fq * 8);
    __syncthreads();
    f32x4 s[16];
#pragma unroll
    for (int t = 0; t < 16; ++t) { s[t] = (f32x4){0.f, 0.f, 0.f, 0.f};
#pragma unroll
        for (int ks = 0; ks < 4; ++ks) { const bf16x8 kf = *(const LAS bf16x8*)(Ks + (t * 16 + fr) * KS_LD + ks * 32 + fq * 8); s[t] = __builtin_amdgcn_mfma_f32_16x16x32_bf16(kf, qf[ks], s[t], 0, 0, 0); } }
    float mx = -3.0e38f;
#pragma unroll
    for (int t = 0; t < 16; ++t) mx = fmaxf(fmaxf(fmaxf(s[t][0], s[t][1]), fmaxf(s[t][2], s[t][3])), mx);
    mx = fmaxf(mx, __shfl_xor(mx, 16)); mx = fmaxf(mx, __shfl_xor(mx, 32));
    const float sc = 0.08838834764831845f * 1.4426950408889634f; float sum = 0.f;
#pragma unroll
    for (int t = 0; t < 16; ++t) {
#pragma unroll
        for (int jj = 0; jj < 4; ++jj) { const float p = __builtin_amdgcn_exp2f((s[t][jj] - mx) * sc); s[t][jj] = p; sum += p; } }
    sum += __shfl_xor(sum, 16); sum += __shfl_xor(sum, 32);
    f32x4 o[8];
#pragma unroll
    for (int dt = 0; dt < 8; ++dt) o[dt] = (f32x4){0.f, 0.f, 0.f, 0.f};
#pragma unroll
    for (int kk = 0; kk < 8; ++kk) {
        v4u pw; pw.x = pk2(s[2 * kk][0], s[2 * kk][1]); pw.y = pk2(s[2 * kk][2], s[2 * kk][3]); pw.z = pk2(s[2 * kk + 1][0], s[2 * kk + 1][1]); pw.w = pk2(s[2 * kk + 1][2], s[2 * kk + 1][3]);
        const bf16x8 pf = __builtin_bit_cast(bf16x8, pw);
#pragma unroll
        for (int dt = 0; dt < 8; ++dt) { const LAS bf16* vp = Vt + (dt * 16 + fr) * VT_LD + kk * 32 + fq * 4;
            v4u vw; const v2u lo = *(const LAS v2u*)vp, hi = *(const LAS v2u*)(vp + 16); vw.x = lo.x; vw.y = lo.y; vw.z = hi.x; vw.w = hi.y;
            o[dt] = __builtin_amdgcn_mfma_f32_16x16x32_bf16(__builtin_bit_cast(bf16x8, vw), pf, o[dt], 0, 0, 0); } }
    const float inv = 1.f / sum;
#pragma unroll
    for (int dt = 0; dt < 8; ++dt) { v2u w2; w2.x = pk2(o[dt][0] * inv, o[dt][1] * inv); w2.y = pk2(o[dt][2] * inv, o[dt][3] * inv);
        *(v2u*)(mix + (size_t)r * D + TOKW + hd * 128 + dt * 16 + fq * 4) = w2; }
    __syncthreads();
}
__device__ __forceinline__ void attn_sample_unit(LAS unsigned char* lds, const bf16* q, const float* ck, const float* cv, bf16* mix, int li, int unit, int tid) {
    const int b = unit >> 1, hp = unit & 1, lane = tid & 63, w = tid >> 6, hd = 2 * hp + (w >> 2), kq = (w & 3) * 64, dd = lane & 15, kg = lane >> 4;
    LAS float* red = (LAS float*)lds;
    const v4u qw = *(const v4u*)(q + (size_t)(MP + b) * XAW + hd * 128 + dd * 8);
    float qv[8] = {bflo(qw.x), bfhi(qw.x), bflo(qw.y), bfhi(qw.y), bflo(qw.z), bfhi(qw.z), bflo(qw.w), bfhi(qw.w)};
    const size_t base = ((size_t)(li * MS + b) * 256) * 512 + hd * 128 + dd * 8;
    float sc[16];
#pragma unroll
    for (int it = 0; it < 16; ++it) { const int key = kq + 4 * it + kg; const float* kp = ck + base + (size_t)key * 512; const f32x4 k0 = *(const f32x4*)kp, k1 = *(const f32x4*)(kp + 4);
        float d = qv[0] * k0[0] + qv[1] * k0[1] + qv[2] * k0[2] + qv[3] * k0[3] + qv[4] * k1[0] + qv[5] * k1[1] + qv[6] * k1[2] + qv[7] * k1[3];
        d += __shfl_xor(d, 1); d += __shfl_xor(d, 2); d += __shfl_xor(d, 4); d += __shfl_xor(d, 8); sc[it] = d; }
    float mx = sc[0];
#pragma unroll
    for (int it = 1; it < 16; ++it) mx = fmaxf(mx, sc[it]);
    mx = fmaxf(mx, __shfl_xor(mx, 16)); mx = fmaxf(mx, __shfl_xor(mx, 32));
    if (lane == 0) red[w] = mx;
    __syncthreads();
    const int w0 = w & 4; mx = fmaxf(fmaxf(red[w0], red[w0 + 1]), fmaxf(red[w0 + 2], red[w0 + 3]));
    const float scl = 0.08838834764831845f * 1.4426950408889634f; float sum = 0.f;
    float oacc[8] = {0.f, 0.f, 0.f, 0.f, 0.f, 0.f, 0.f, 0.f};
#pragma unroll
    for (int it = 0; it < 16; ++it) { const float p = __builtin_amdgcn_exp2f((sc[it] - mx) * scl); sum += p;
        const int key = kq + 4 * it + kg; const float* vp = cv + base + (size_t)key * 512; const f32x4 v0 = *(const f32x4*)vp, v1 = *(const f32x4*)(vp + 4);
        oacc[0] += p * v0[0]; oacc[1] += p * v0[1]; oacc[2] += p * v0[2]; oacc[3] += p * v0[3]; oacc[4] += p * v1[0]; oacc[5] += p * v1[1]; oacc[6] += p * v1[2]; oacc[7] += p * v1[3]; }
    sum += __shfl_xor(sum, 16); sum += __shfl_xor(sum, 32);
#pragma unroll
    for (int i = 0; i < 8; ++i) { oacc[i] += __shfl_xor(oacc[i], 16); oacc[i] += __shfl_xor(oacc[i], 32); }
    if (lane == 0) red[8 + w] = sum;
    if (lane < 16) {
#pragma unroll
        for (int i = 0; i < 8; ++i) red[16 + w * 128 + dd * 8 + i] = oacc[i]; }
    __syncthreads();
    if ((w & 3) == 0 && lane < 16) {
        const float tot = (red[8 + w] + red[9 + w]) + (red[10 + w] + red[11 + w]), inv = 1.f / tot; float o[8];
#pragma unroll
        for (int i = 0; i < 8; ++i) o[i] = ((red[16 + w * 128 + dd * 8 + i] + red[16 + (w + 1) * 128 + dd * 8 + i]) + (red[16 + (w + 2) * 128 + dd * 8 + i] + red[16 + (w + 3) * 128 + dd * 8 + i])) * inv;
        v4u ow; ow.x = pk2(o[0], o[1]); ow.y = pk2(o[2], o[3]); ow.z = pk2(o[4], o[5]); ow.w = pk2(o[6], o[7]);
        *(v4u*)(mix + (size_t)(MP + b) * D + TOKW + hd * 128 + dd * 8) = ow;
    }
    __syncthreads();
}

constexpr int SG_LD = 136;
__device__ __forceinline__ void sg_unit(LAS unsigned char* lds, const bf16* zu, const bf16* zv, const ssq_t* ssv, const float* g_v, const bf16* wsb, const float* b_s, bf16* mix, int unit, int tid) {
    const int ch = unit / 12, g = unit % 12, row0 = ch * 128, lane = tid & 63, w = tid >> 6, fr = lane & 15, fq = lane >> 4;
    LAS bf16* Vt = (LAS bf16*)lds;
    { const int s = tid & 127, dq = tid >> 7; const float rsv = rstd_of(ssv[row0 + s], 1.f / 1536.f);
#pragma unroll
      for (int it = 0; it < 4; ++it) { const int d0 = (dq + 4 * it) * 8; const v4u vw = *(const v4u*)(zv + (size_t)(row0 + s) * TOKW + g * 128 + d0);
          const f32x4 g0 = *(const f32x4*)(g_v + g * 128 + d0), g1 = *(const f32x4*)(g_v + g * 128 + d0 + 4);
          const unsigned a = pk2(bflo(vw.x) * rsv * g0[0], bfhi(vw.x) * rsv * g0[1]), b2 = pk2(bflo(vw.y) * rsv * g0[2], bfhi(vw.y) * rsv * g0[3]),
                         c2 = pk2(bflo(vw.z) * rsv * g1[0], bfhi(vw.z) * rsv * g1[1]), e2 = pk2(bflo(vw.w) * rsv * g1[2], bfhi(vw.w) * rsv * g1[3]);
          LAS bf16* vp = Vt + d0 * SG_LD + s;
          vp[0] = (bf16)(a & 0xffff); vp[SG_LD] = (bf16)(a >> 16); vp[2 * SG_LD] = (bf16)(b2 & 0xffff); vp[3 * SG_LD] = (bf16)(b2 >> 16);
          vp[4 * SG_LD] = (bf16)(c2 & 0xffff); vp[5 * SG_LD] = (bf16)(c2 >> 16); vp[6 * SG_LD] = (bf16)(e2 & 0xffff); vp[7 * SG_LD] = (bf16)(e2 >> 16); } }
    const int nks = (w >> 1) + 1;
    bf16x8 wf[4];
#pragma unroll
    for (int ks = 0; ks < 4; ++ks) wf[ks] = *(const bf16x8*)(wsb + ((size_t)g * 128 + w * 16 + fr) * 128 + ks * 32 + fq * 8);
    __syncthreads();
    f32x4 acc[8];
#pragma unroll
    for (int dt = 0; dt < 8; ++dt) { acc[dt] = (f32x4){0.f, 0.f, 0.f, 0.f};
#pragma unroll
        for (int ks = 0; ks < 4; ++ks) if (ks < nks) { const bf16x8 vf = *(const LAS bf16x8*)(Vt + (dt * 16 + fr) * SG_LD + ks * 32 + fq * 8); acc[dt] = __builtin_amdgcn_mfma_f32_16x16x32_bf16(vf, wf[ks], acc[dt], 0, 0, 0); } }
    const int t = w * 16 + fr, r = row0 + t; const float bias = b_s[g * 128 + t];
#pragma unroll
    for (int dt = 0; dt < 8; ++dt) { const int c = g * 128 + dt * 16 + fq * 4; const v2u uw = *(const v2u*)(zu + (size_t)r * TOKW + c);
        v2u ow; ow.x = pk2(bflo(uw.x) * (acc[dt][0] + bias), bfhi(uw.x) * (acc[dt][1] + bias)); ow.y = pk2(bflo(uw.y) * (acc[dt][2] + bias), bfhi(uw.y) * (acc[dt][3] + bias));
        *(v2u*)(mix + (size_t)r * D + c) = ow; }
    __syncthreads();
}

__device__ __forceinline__ void s5_state_task(LAS unsigned char* lds, bf16* uh, const bf16* bt2_l, const float* lb16_l, float* out, int j, int task, int tid) {
    const int b = task / NGRP, h = task % NGRP, lane = tid & 63, w = tid >> 6, fr = lane & 15, fq = lane >> 4;
    LAS float* S = (LAS float*)lds;
    bf16x8 af[8];
    const bf16* ap = uh + ((size_t)(h * 512 + b * 128 + w * 16 + fr)) * KH + fq * 8;
#pragma unroll
    for (int ks = 0; ks < 8; ++ks) af[ks] = *(const bf16x8*)(ap + ks * 32);
#pragma unroll
    for (int nt = 0; nt < 8; ++nt) { f32x4 acc = (f32x4){0.f, 0.f, 0.f, 0.f}; const bf16* bp = bt2_l + ((size_t)(h * 128 + nt * 16 + fr)) * 256 + fq * 8;
#pragma unroll
        for (int ks = 0; ks < 8; ++ks) { const bf16x8 bf = *(const bf16x8*)(bp + ks * 32); acc = __builtin_amdgcn_mfma_f32_16x16x32_bf16(af[ks], bf, acc, 0, 0, 0); }
#pragma unroll
        for (int jj = 0; jj < 4; ++jj) S[(w * 16 + fq * 4 + jj) * 129 + nt * 16 + fr] = acc[jj]; }
    __syncthreads();
    {
        const int p = lane; const float lr = lb16_l[(h * 64 + p) * 2], li = lb16_l[(h * 64 + p) * 2 + 1];
        LAS float* Tb = S + 128 * 129;
        float tr = 0.f, ti = 0.f;
#pragma unroll
        for (int k = 0; k < 16; ++k) { const int m = w * 16 + k; const float sr = S[m * 129 + p], si = S[m * 129 + 64 + p]; const float t = lr * tr - li * ti + sr; ti = lr * ti + li * tr + si; tr = t; }
        Tb[w * 128 + p] = tr; Tb[w * 128 + 64 + p] = ti;
        float Lr = lr, Li = li;
#pragma unroll
        for (int q = 0; q < 4; ++q) { const float t = Lr * Lr - Li * Li; Li = 2.f * Lr * Li; Lr = t; }
        __syncthreads();
        float hr = 0.f, hi = 0.f;
        for (int w2 = 0; w2 < w; ++w2) { const float t = Lr * hr - Li * hi + Tb[w2 * 128 + p]; hi = Lr * hi + Li * hr + Tb[w2 * 128 + 64 + p]; hr = t; }
        bf16* up = uh + ((size_t)(h * 512 + b * 128 + w * 16)) * KH + 256 + p;
#pragma unroll
        for (int k = 0; k < 16; ++k) { const int m = w * 16 + k; up[(size_t)k * KH] = (bf16)(pk2(hr, 0.f) & 0xffff); up[(size_t)k * KH + 64] = (bf16)(pk2(hi, 0.f) & 0xffff);
            const float sr = S[m * 129 + p], si = S[m * 129 + 64 + p]; const float t = lr * hr - li * hi + sr; hi = lr * hi + li * hr + si; hr = t; }
        if (w == 7) { out[OFF_SRP + ((size_t)(j * 4 + b) * NGRP + h) * 64 + p] = hr; out[OFF_SIP + ((size_t)(j * 4 + b) * NGRP + h) * 64 + p] = hi; }
    }
    __syncthreads();
}
__device__ __forceinline__ void s5_sample_task(const float* us, const float* st_re, const float* st_im, const float* lbt_l, const float* bbar_l, const float* c_re_l, const float* c_im_l, const float* d_l,
                                               float* out, bf16* yb, int j, int task, int lane) {
    const int h = task >> 4, b0 = (task & 15) * 8, p = lane, co = lane >> 2;
    float bbr[16], bbi[16], cr[16], ci[16];
    const float* bb = bbar_l + ((size_t)(h * 64 + p)) * 32;
#pragma unroll
    for (int c2 = 0; c2 < 8; ++c2) { const f32x4 t = *(const f32x4*)(bb + c2 * 4); bbr[2 * c2] = t[0]; bbi[2 * c2] = t[1]; bbr[2 * c2 + 1] = t[2]; bbi[2 * c2 + 1] = t[3]; }
#pragma unroll
    for (int c = 0; c < 16; ++c) { cr[c] = c_re_l[((size_t)(h * 16 + c)) * 64 + p]; ci[c] = c_im_l[((size_t)(h * 16 + c)) * 64 + p]; }
    const float lr = lbt_l[(h * 64 + p) * 2], li = lbt_l[(h * 64 + p) * 2 + 1], dd = d_l[h * 16 + co];
    const bool b5 = (lane & 32) != 0, b4 = (lane & 16) != 0, b3 = (lane & 8) != 0, b2 = (lane & 4) != 0;
#pragma unroll 1
    for (int bi_ = 0; bi_ < 8; ++bi_) {
        const int b = b0 + bi_; float u[16];
#pragma unroll
        for (int c4 = 0; c4 < 4; ++c4) { const f32x4 t = *(const f32x4*)(us + (size_t)b * TOKW + h * 16 + c4 * 4); u[c4 * 4] = t[0]; u[c4 * 4 + 1] = t[1]; u[c4 * 4 + 2] = t[2]; u[c4 * 4 + 3] = t[3]; }
        const float uco = us[(size_t)b * TOKW + h * 16 + co];
        float xr = 0.f, xi = 0.f;
#pragma unroll
        for (int c = 0; c < 16; ++c) { xr += bbr[c] * u[c]; xi += bbi[c] * u[c]; }
        const size_t si_ = ((size_t)(j * MS + b) * NGRP + h) * 64 + p; const float s0r = st_re[si_], s0i = st_im[si_];
        const float hr = lr * s0r - li * s0i + xr, hi = lr * s0i + li * s0r + xi;
        out[OFF_SRS + si_] = hr; out[OFF_SIS + si_] = hi;
        float w8[8], w4[4], w2[2], w1;
#pragma unroll
        for (int i = 0; i < 8; ++i) { const float va = cr[i] * hr - ci[i] * hi, vb = cr[i + 8] * hr - ci[i + 8] * hi; w8[i] = (b5 ? vb : va) + __shfl_xor(b5 ? va : vb, 32); }
#pragma unroll
        for (int i = 0; i < 4; ++i) w4[i] = (b4 ? w8[i + 4] : w8[i]) + __shfl_xor(b4 ? w8[i] : w8[i + 4], 16);
#pragma unroll
        for (int i = 0; i < 2; ++i) w2[i] = (b3 ? w4[i + 2] : w4[i]) + __shfl_xor(b3 ? w4[i] : w4[i + 2], 8);
        w1 = (b2 ? w2[1] : w2[0]) + __shfl_xor(b2 ? w2[0] : w2[1], 4);
        w1 += __shfl_xor(w1, 2); w1 += __shfl_xor(w1, 1);
        const float yv = w1 + dd * uco;
        if ((lane & 3) == 0) yb[(size_t)(MP + b) * TOKW + h * 16 + co] = (bf16)(pk2(gelu_t(yv), 0.f) & 0xffff);
    }
}

struct SEpiRes {
    bf16* xb; ssq_t* ssn;
    __device__ __forceinline__ void operator()(f32x4 v, int m, int c) const {
        const int r = MP + m; bf16* bp = xb + (size_t)r * D + c; const v2u xw = *(const v2u*)bp; const f32x4 o = (f32x4){bflo(xw.x), bfhi(xw.x), bflo(xw.y), bfhi(xw.y)} + v;
        v2u w; w.x = pk2(o[0], o[1]); w.y = pk2(o[2], o[3]); *(v2u*)bp = w;
        float sq = dot4(o); sq += __shfl_xor(sq, 1); sq += __shfl_xor(sq, 2); sq += __shfl_xor(sq, 4); if ((threadIdx.x & 7) == 0) fadd_atomic(ssn + r, sq);
    }
};
struct SEpiSsmIn {
    const ssq_t* ss; float* us; bf16* q;
    __device__ __forceinline__ void operator()(f32x4 v, int m, int c) const {
        const int r = MP + m; v = v * rstd_of(ss[r], 1.f / 2048.f);
        if (c < TOKW) *(f32x4*)(us + (size_t)m * TOKW + c) = v;
        else { v2u w; w.x = pk2(v[0], v[1]); w.y = pk2(v[2], v[3]); *(v2u*)(q + (size_t)r * XAW + (c - TOKW)) = w; }
    }
};
template <class SEpi>
__device__ __forceinline__ void skinny_sample(LAS unsigned char* lds, const bf16* As, const bf16* Bt, int K, const SEpi& E, int blk, int tid) {
    if (blk >= 256) return;
    const int lane = tid & 63, w = __builtin_amdgcn_readfirstlane(tid >> 6), fr = lane & 15, fq = lane >> 4, m0 = (blk & 3) * 32, n0 = (blk >> 2) * 32;
    f32x4 acc[2][2];
#pragma unroll
    for (int a = 0; a < 2; ++a)
#pragma unroll
        for (int b = 0; b < 2; ++b) acc[a][b] = (f32x4){0.f, 0.f, 0.f, 0.f};
    const int nks = K >> 5; const bf16* bp = Bt + (size_t)(n0 + fr) * K + fq * 8; const bf16* ap = As + (size_t)(m0 + fr) * K + fq * 8; const size_t r16 = (size_t)16 * K;
#pragma unroll 4
    for (int ks = w; ks < nks; ks += 8) {
        const bf16x8 b0 = *(const bf16x8*)(bp + ks * 32), b1 = *(const bf16x8*)(bp + r16 + ks * 32), a0 = *(const bf16x8*)(ap + ks * 32), a1 = *(const bf16x8*)(ap + r16 + ks * 32);
        acc[0][0] = __builtin_amdgcn_mfma_f32_16x16x32_bf16(b0, a0, acc[0][0], 0, 0, 0); acc[0][1] = __builtin_amdgcn_mfma_f32_16x16x32_bf16(b1, a0, acc[0][1], 0, 0, 0);
        acc[1][0] = __builtin_amdgcn_mfma_f32_16x16x32_bf16(b0, a1, acc[1][0], 0, 0, 0); acc[1][1] = __builtin_amdgcn_mfma_f32_16x16x32_bf16(b1, a1, acc[1][1], 0, 0, 0);
    }
    LAS float* red = (LAS float*)lds;
#pragma unroll
    for (int a = 0; a < 2; ++a)
#pragma unroll
        for (int b = 0; b < 2; ++b) *(LAS f32x4*)(red + ((w * 32 + a * 16 + fr) * 32 + b * 16 + fq * 4)) = acc[a][b];
    __syncthreads();
    if (tid < 256) {
        const int m = tid >> 3, nq = (tid & 7) * 4; f32x4 sum = *(const LAS f32x4*)(red + (m * 32 + nq));
#pragma unroll
        for (int w2 = 1; w2 < 8; ++w2) sum += *(const LAS f32x4*)(red + ((w2 * 32 + m) * 32 + nq));
        E(sum, m0 + m, n0 + nq);
    }
    __syncthreads();
}

#define RLX_AGENT __ATOMIC_RELAXED, __HIP_MEMORY_SCOPE_AGENT
struct Args { const float* in[34]; float* out; unsigned char* ws; int lo, hi; };
__global__ void __launch_bounds__(NTHR, 2) trunk_fwd(Args args) {
    extern __shared__ __attribute__((aligned(16))) unsigned char lds_raw[];
    LAS unsigned char* lds = (LAS unsigned char*)lds_raw;
    volatile LAS unsigned* MISC = (volatile LAS unsigned*)(lds + MISC_OFF);
    const int G = gridDim.x, blk = blockIdx.x;
    const Args* ap = &args;
#define ws (ap->ws)
#define out (ap->out)
#define x_prompt (ap->in[0])
#define x_sample (ap->in[1])
#define mem_prompt (ap->in[2])
#define cache_k (ap->in[3])
#define cache_v (ap->in[4])
#define st_re (ap->in[5])
#define st_im (ap->in[6])
#define st_conv (ap->in[7])
#define g_mix (ap->in[8])
#define g_ffn (ap->in[9])
#define g_mem (ap->in[10])
#define g_final (ap->in[11])
#define w_mem_kv (ap->in[12])
#define sg_w_in (ap->in[13])
#define sg_w_out (ap->in[14])
#define sg_g_v (ap->in[15])
#define sg_w_s (ap->in[16])
#define sg_b_s (ap->in[17])
#define ssm_w_in (ap->in[18])
#define ssm_w_out (ap->in[19])
#define lam_re (ap->in[20])
#define lam_im (ap->in[21])
#define log_dt (ap->in[22])
#define b_re (ap->in[23])
#define b_im (ap->in[24])
#define c_re (ap->in[25])
#define c_im (ap->in[26])
#define ssm_d (ap->in[27])
#define w_glu (ap->in[28])
#define b_glu (ap->in[29])
#define w_up (ap->in[30])
#define conv_w (ap->in[31])
#define conv_b (ap->in[32])
#define w_down (ap->in[33])
#define ctl ((unsigned*)(ws + WS_CTL))
#define SSX ((ssq_t*)(ws + CTL_SSX))
#define SSV ((ssq_t*)(ws + CTL_SSV))
#define SSMEM ((ssq_t*)(ws + CTL_SSMEM))
#define W_SGIN ((bf16*)(ws + WS_WSGIN))
#define W_SSMIN ((bf16*)(ws + WS_WSSMIN))
#define W_SGOUT ((bf16*)(ws + WS_WSGOUT))
#define W_SSMOUT ((bf16*)(ws + WS_WSSMOUT))
#define W_GLU ((bf16*)(ws + WS_WGLU))
#define W_UP ((bf16*)(ws + WS_WUP))
#define W_DOWN ((bf16*)(ws + WS_WDOWN))
#define W_MEM ((bf16*)(ws + WS_WMEM))
#define WSB ((bf16*)(ws + WS_WSB))
#define TB ((bf16*)(ws + WS_TB))
#define BT2 ((bf16*)(ws + WS_BT2))
#define LBT ((float*)(ws + WS_LBT))
#define LB16 ((float*)(ws + WS_LB16))
#define BBART ((float*)(ws + WS_BBAR))
#define XRES ((float*)(ws + WS_XRES))
#define XB ((bf16*)(ws + WS_XB))
#define MEMB ((bf16*)(ws + WS_MEMB))
#define MKV ((bf16*)(ws + WS_MKV))
#define ZU ((bf16*)(ws + WS_ZU))
#define ZV ((bf16*)(ws + WS_ZV))
#define QB ((bf16*)(ws + WS_Q))
#define MIX ((bf16*)(ws + WS_MIX))
#define AG ((bf16*)(ws + WS_AG))
#define YF ((bf16*)(ws + WS_Y))
#define UH ((bf16*)(ws + WS_UH))
#define YB ((bf16*)(ws + WS_YB))
#define US ((float*)(ws + WS_US))
#define FXA ((float*)(ws + WS_FXA))
#define FXG ((float*)(ws + WS_FXG))
    for (int u = threadIdx.x; u < 128; u += NTHR) MISC[u] = 0u;
    __syncthreads();
    XcdBarrier bar = xcd_barrier_post(ctl + CW_BAR, MISC + 8);
    const int lo = args.lo, hi = args.hi; int ph = 0;
#ifndef PHM
#define PHM 0xFFFFFFFFu
#endif
#ifndef DUPM
#define DUPM 0u
#endif
#ifndef DUPSUB
#define DUPSUB 0u
#endif
#define SUBREP(k) for (int srep_ = 0; srep_ < (((DUPSUB >> (k)) & 1u) ? 2 : 1); ++srep_)
#define PH_BEGIN(k) if (((PHM >> (k)) & 1u) && ph >= lo && ph < hi) for (int rep_ = 0; rep_ < (((DUPM >> (k)) & 1u) ? 2 : 1); ++rep_) { unsigned z_; asm volatile("s_mov_b32 %0, 0" : "=s"(z_)); const Args* ap = (const Args*)((const char*)&args + z_); int tid = threadIdx.x; asm volatile("" : "+v"(tid)); const int lane = tid & 63, wave = __builtin_amdgcn_readfirstlane(tid >> 6); const int gw = blk * NWAVES + wave, NGW = G * NWAVES, gtid = blk * NTHR + tid, NT = G * NTHR; (void)lane; (void)gw; (void)NGW; (void)gtid; (void)NT;
#define PH_END do { if (ph >= lo && ph + 1 < hi) xcd_barrier(bar); ++ph; } while (0)

    PH_BEGIN(0)
        {
            LAS bf16* T = (LAS bf16*)lds; f32x4 v[8]; int t = blk; P0Desc d, dn;
            if (t < P0_NTILES) { d = p0_decode(t, ap->in, ws); p0_load(d, v, tid); }
#pragma unroll 1
            while (t < P0_NTILES) {
                p0_to_lds(d, v, T, tid);
                __syncthreads();
                const int tn = t + G; dn = d;
                if (tn < P0_NTILES) { dn = p0_decode(tn, ap->in, ws); p0_load(dn, v, tid); }
                p0_store(d, T, tid);
                __syncthreads();
                t = tn; d = dn;
            }
        }
        for (int r = gw; r < MT + MMEM; r += NGW) {
            if (r < MT) { const float* src = r < MP ? x_prompt + (size_t)r * D : (r < MREAL ? x_sample + (size_t)(r - MP) * D : nullptr); p0_row(src, nullptr, XB + (size_t)r * D, SSX + r, lane); }
            else { const int m = r - MT; p0_row(mem_prompt + (size_t)m * D, nullptr, MEMB + (size_t)m * D, SSMEM + m, lane); }
        }
    }
    PH_END;
    PH_BEGIN(1)
        if (blk < 64 || G <= 64) {
            pg8::Gemm g{MEMB, W_MEM, MMEM, 4096, D}; pg8::StaticOrder S; S.init(MMEM, 4096, G, blk);
            EpiMem E{SSMEM, out, MKV};
            pg8::gemm_phase<EpiMem, pg8::StaticOrder, true, true>(lds, g, S, E);
        }
        if (blk >= 64 || G <= 64) {
            const int b0 = G <= 64 ? blk : blk - 64, gs = G <= 64 ? G : G - 64;
            for (int e = b0 * NTHR + tid; e < 2 * 12 * 128 * 128 / 4; e += gs * NTHR) { const int e4 = e * 4, s = e4 & 127, t = (e4 >> 7) & 127; const f32x4 wv = *(const f32x4*)(sg_w_s + e4);
                v2u o; o.x = pk2(s <= t ? wv[0] : 0.f, s + 1 <= t ? wv[1] : 0.f); o.y = pk2(s + 2 <= t ? wv[2] : 0.f, s + 3 <= t ? wv[3] : 0.f); *(v2u*)(WSB + e4) = o; }
            for (int un = b0; un < 2 * NGRP; un += gs) { const int j = un / NGRP, h = un % NGRP;
                s5_tables((LAS float*)lds, j, h, lam_re, lam_im, log_dt, b_re, b_im, c_re, c_im, ssm_d, TB, BT2, LBT, LB16, BBART, tid); }
        }
    }
    PH_END;
#pragma unroll 1
    for (int li = 0; li < 4; ++li) {
        const int j = li >> 1;
        const ssq_t* ss_mix = SSX + (size_t)(2 * li) * MT; ssq_t* ss_ffn = SSX + (size_t)(2 * li + 1) * MT; ssq_t* ss_next = SSX + (size_t)(2 * li + 2) * MT;
        const bf16* mkv_l = MKV + (size_t)li * 1024 * 1024;
        if ((li & 1) == 0) {
            PH_BEGIN(2)
                pg8::Gemm g{XB, W_SGIN + (size_t)j * SGN * D, MT, SGN, D}; pg8::StaticOrder S; S.init(MT, SGN, G, blk);
                EpiSgIn E{ss_mix, ZU, ZV, QB, SSV + (size_t)j * MT};
                pg8::gemm_phase<EpiSgIn, pg8::StaticOrder, true, true>(lds, g, S, E);
            }
            PH_END;
            PH_BEGIN(3)
                const ssq_t* ssv = SSV + (size_t)j * MT; const float* gv = sg_g_v + j * TOKW;
                SUBREP(0)
#pragma unroll 1
                for (int un = blk; un < 768; un += G) sg_unit(lds, ZU, ZV, ssv, gv, WSB + (size_t)j * 12 * 128 * 128, sg_b_s + j * 12 * 128, MIX, un, tid);
                SUBREP(1)
#pragma unroll 1
                for (int un = blk; un < 256; un += G) attn_prompt_unit(lds, QB, mkv_l, MIX, un, tid);
                SUBREP(2)
#pragma unroll 1
                for (int un = blk; un < 256; un += G) attn_sample_unit(lds, QB, cache_k, cache_v, MIX, li, un, tid);
                for (int e = gtid; e < MS * TOKW / 8; e += NT) { const int b = e / 192, c = (e % 192) * 8, g = c >> 7, r = MP + b;
                    const float rsv = rstd_of(ssv[r], 1.f / 1536.f); const v4u vw = *(const v4u*)(ZV + (size_t)r * TOKW + c), uw = *(const v4u*)(ZU + (size_t)r * TOKW + c);
                    const f32x4 g0 = *(const f32x4*)(gv + c), g1 = *(const f32x4*)(gv + c + 4);
                    const f32x4 n0 = (f32x4){bflo(vw.x) * rsv * g0[0], bfhi(vw.x) * rsv * g0[1], bflo(vw.y) * rsv * g0[2], bfhi(vw.y) * rsv * g0[3]};
                    const f32x4 n1 = (f32x4){bflo(vw.z) * rsv * g1[0], bfhi(vw.z) * rsv * g1[1], bflo(vw.w) * rsv * g1[2], bfhi(vw.w) * rsv * g1[3]};
                    float* so = out + OFF_SGV + (size_t)(j * MS + b) * TOKW + c; *(f32x4*)so = n0; *(f32x4*)(so + 4) = n1;
                    const float w00 = sg_w_s[((size_t)(j * 12 + g) * 128) * 128], bs = sg_b_s[(j * 12 + g) * 128];
                    const f32x4 t0 = (f32x4){bflo(uw.x), bfhi(uw.x), bflo(uw.y), bfhi(uw.y)} * (n0 * w00 + bs), t1 = (f32x4){bflo(uw.z), bfhi(uw.z), bflo(uw.w), bfhi(uw.w)} * (n1 * w00 + bs);
                    *(v4u*)(MIX + (size_t)r * D + c) = pack8(t0, t1); }
            }
            PH_END;
        } else {
            PH_BEGIN(4)
                pg8::Gemm g{XB, W_SSMIN + (size_t)j * D * D, MP, D, D}; pg8::StaticOrder S; S.init(MP, D, G, blk);
                EpiSsmIn E{ss_mix, UH, US, QB};
                pg8::gemm_phase<EpiSsmIn, pg8::StaticOrder, true, true>(lds, g, S, E);
                SEpiSsmIn SE{ss_mix, US, QB}; skinny_sample(lds, XB + (size_t)MP * D, W_SSMIN + (size_t)j * D * D, D, SE, blk, tid);
            }
            PH_END;
            PH_BEGIN(5)
                SUBREP(3)
#pragma unroll 1
                for (int tk = blk; tk < 4 * NGRP; tk += G) s5_state_task(lds, UH, BT2 + (size_t)j * NGRP * 128 * 256, LB16 + (size_t)j * NGRP * 64 * 2, out, j, tk, tid);
                SUBREP(4)
#pragma unroll 1
                for (int tk = gw; tk < NGRP * 16; tk += NGW)
                    s5_sample_task(US, st_re, st_im, LBT + (size_t)j * NGRP * 64 * 2, BBART + (size_t)j * NGRP * 64 * 32, c_re + (size_t)j * NGRP * 1024, c_im + (size_t)j * NGRP * 1024, ssm_d + j * TOKW, out, YB, j, tk, lane);
                SUBREP(1)
#pragma unroll 1
                for (int un = blk; un < 256; un += G) attn_prompt_unit(lds, QB, mkv_l, MIX, un, tid);
                SUBREP(2)
#pragma unroll 1
                for (int un = blk; un < 256; un += G) attn_sample_unit(lds, QB, cache_k, cache_v, MIX, li, un, tid);
            }
            PH_END;
            PH_BEGIN(6)
                int kh = KH; asm volatile("" : "+s"(kh)); pg8::Gemm g{UH, TB + (size_t)j * NGRP * 256 * KH, NGRP * 512, NGRP * 256, kh}; ToepOrder S{G, blk};
                EpiToep E{YB};
                pg8::gemm_phase<EpiToep, ToepOrder, true, true>(lds, g, S, E);
            }
            PH_END;
            PH_BEGIN(7)
                pg8::Gemm g{YB, W_GLU + (size_t)j * TOKW * TOKW, MT, TOKW, TOKW}; pg8::StaticOrder S; S.init(MT, TOKW, G, blk);
                EpiGlu E{YB, b_glu + j * TOKW, MIX};
                pg8::gemm_phase<EpiGlu, pg8::StaticOrder, true, true>(lds, g, S, E);
            }
            PH_END;
        }
        PH_BEGIN(8)
            const bf16* wo = (li & 1) ? W_SSMOUT + (size_t)j * D * D : W_SGOUT + (size_t)j * D * D;
            pg8::Gemm g{MIX, wo, MP, D, D}; pg8::StaticOrder S; S.init(MP, D, G, blk);
            EpiRes E{XB, ss_ffn};
            pg8::gemm_phase<EpiRes, pg8::StaticOrder, true, true>(lds, g, S, E);
            SEpiRes SE{XB, ss_ffn}; skinny_sample(lds, MIX + (size_t)MP * D, wo, D, SE, blk, tid);
        }
        PH_END;
        PH_BEGIN(9)
            pg8::Gemm g{XB, W_UP + (size_t)li * NUP * D, MT, NUP, D}; pg8::StaticOrder S; S.init(MT, NUP, G, blk);
            EpiUp E{ss_ffn, YF, out, st_conv + (size_t)li * MS * 2 * DFF, conv_w + (size_t)li * 3 * DFF, conv_b + (size_t)li * DFF, FXA, FXG, (LAS float*)(lds + HALO_OFF), li};
            pg8::gemm_phase<EpiUp, pg8::StaticOrder, true, true>(lds, g, S, E);
        }
        PH_END;
        PH_BEGIN(10)
            const float* cw = conv_w + (size_t)li * 3 * DFF; const float* cb = conv_b + (size_t)li * DFF;
            for (int e = gtid; e < 32 * (DFF / 4); e += NT) {
                const int pm = e / (DFF / 4), c = (e % (DFF / 4)) * 4; if ((pm & 7) == 0) continue;
                const f32x4 am2 = *(const f32x4*)(FXA + ((size_t)((pm - 1) * 4 + 2)) * DFF + c), am1 = *(const f32x4*)(FXA + ((size_t)((pm - 1) * 4 + 3)) * DFF + c);
                const f32x4 a0 = *(const f32x4*)(FXA + ((size_t)(pm * 4)) * DFF + c), a1 = *(const f32x4*)(FXA + ((size_t)(pm * 4 + 1)) * DFF + c);
                const f32x4 g0 = *(const f32x4*)(FXG + ((size_t)(pm * 2)) * DFF + c), g1 = *(const f32x4*)(FXG + ((size_t)(pm * 2 + 1)) * DFF + c);
                const f32x4 k0 = *(const f32x4*)(cw + c), k1 = *(const f32x4*)(cw + DFF + c), k2 = *(const f32x4*)(cw + 2 * DFF + c), kb = *(const f32x4*)(cb + c);
                f32x4 y0, y1;
#pragma unroll
                for (int i = 0; i < 4; ++i) { const float c0_ = kb[i] + k0[i] * am2[i] + k1[i] * am1[i] + k2[i] * a0[i], c1_ = kb[i] + k0[i] * am1[i] + k1[i] * a0[i] + k2[i] * a1[i];
                    y0[i] = c0_ * sigmoid_f(c0_) * g0[i]; y1[i] = c1_ * sigmoid_f(c1_) * g1[i]; }
                v2u w0, w1; w0.x = pk2(y0[0], y0[1]); w0.y = pk2(y0[2], y0[3]); w1.x = pk2(y1[0], y1[1]); w1.y = pk2(y1[2], y1[3]);
                *(v2u*)(YF + (size_t)(pm * 256) * DFF + c) = w0; *(v2u*)(YF + (size_t)(pm * 256 + 1) * DFF + c) = w1;
            }
        }
        PH_END;
        PH_BEGIN(11)
            pg8::Gemm g{YF, W_DOWN + (size_t)li * D * DFF, MP, D, DFF}; pg8::StaticOrder S; S.init(MP, D, G, blk);
            EpiRes E{XB, ss_next};
            pg8::gemm_phase<EpiRes, pg8::StaticOrder, true, true>(lds, g, S, E);
            SEpiRes SE{XB, ss_next}; skinny_sample(lds, YF + (size_t)MP * DFF, W_DOWN + (size_t)li * D * DFF, DFF, SE, blk, tid);
        }
        PH_END;
    }
    PH_BEGIN(12)
#pragma unroll 1
        for (int r = gw; r < MREAL; r += NGW) {
            const v2u* xr = (const v2u*)(XB + (size_t)r * D); f32x4 v[8]; float s = 0.f;
#pragma unroll
            for (int jj = 0; jj < 8; ++jj) { const v2u xw = xr[lane + 64 * jj]; v[jj] = (f32x4){bflo(xw.x), bfhi(xw.x), bflo(xw.y), bfhi(xw.y)}; s += dot4(v[jj]); }
            const float rs = rsqrtf(wave_sum(s) * (1.f / 2048.f) + EPS);
            f32x4* o = (f32x4*)(out + (r < MP ? OFF_YP + (size_t)r * D : OFF_YS + (size_t)(r - MP) * D));
#pragma unroll
            for (int jj = 0; jj < 8; ++jj) o[lane + 64 * jj] = v[jj] * rs * ((const f32x4*)g_final)[lane + 64 * jj];
        }
    }
    PH_END;
#undef PH_BEGIN
#undef PH_END
}
#undef x_prompt
#undef x_sample
#undef mem_prompt
#undef cache_k
#undef cache_v
#undef st_re
#undef st_im
#undef st_conv
#undef g_mix
#undef g_ffn
#undef g_mem
#undef g_final
#undef w_mem_kv
#undef sg_w_in
#undef sg_w_out
#undef sg_g_v
#undef sg_w_s
#undef sg_b_s
#undef ssm_w_in
#undef ssm_w_out
#undef lam_re
#undef lam_im
#undef log_dt
#undef b_re
#undef b_im
#undef c_re
#undef c_im
#undef ssm_d
#undef w_glu
#undef b_glu
#undef w_up
#undef conv_w
#undef conv_b
#undef w_down
#undef ctl
#undef SSX
#undef SSV
#undef SSMEM
#undef W_SGIN
#undef W_SSMIN
#undef W_SGOUT
#undef W_SSMOUT
#undef W_GLU
#undef W_UP
#undef W_DOWN
#undef W_MEM
#undef WSB
#undef TB
#undef BT2
#undef LBT
#undef LB16
#undef BBART
#undef XRES
#undef XB
#undef MEMB
#undef MKV
#undef ZU
#undef ZV
#undef QB
#undef MIX
#undef AG
#undef YF
#undef UH
#undef YB
#undef US
#undef FXA
#undef FXG
#undef ws
#undef out

#ifndef MK_ONE_LAUNCH
#define MK_ONE_LAUNCH 1
#endif
extern "C" void kernel_launch(void* const* d_in, const int* in_sizes, int n_in, void* d_out, int out_size, void* d_ws, size_t ws_size, hipStream_t stream) {
    static int grid = 0;
    if (grid == 0) {
        if (n_in != 34 || (size_t)out_size != OUT_TOTAL || ws_size < WS_END) { fprintf(stderr, "kernel_launch: unexpected shapes (n_in %d, out %d, ws %zu)\n", n_in, out_size, ws_size); grid = -1; return; }
        int dev = 0, cus = 0;
        if (hipGetDevice(&dev) != hipSuccess || hipDeviceGetAttribute(&cus, hipDeviceAttributeMultiprocessorCount, dev) != hipSuccess) { grid = -1; return; }
        if (hipFuncSetAttribute((const void*)trunk_fwd, hipFuncAttributeMaxDynamicSharedMemorySize, LDS_BYTES) != hipSuccess) { fprintf(stderr, "kernel_launch: hipFuncSetAttribute failed\n"); grid = -1; return; }
        int per_cu = 0;
        if (hipOccupancyMaxActiveBlocksPerMultiprocessor(&per_cu, (const void*)trunk_fwd, NTHR, LDS_BYTES) != hipSuccess || per_cu < 1) fprintf(stderr, "kernel_launch: occupancy query says %d\n", per_cu);
        (void)hipGetLastError();
        grid = cus;
    }
    if (grid < 0) return;
    if (hipMemsetAsync((char*)d_ws + WS_CTL, 0, CTL_ZERO_BYTES, stream) != hipSuccess) return;
    Args a{};
    for (int i = 0; i < 34; ++i) a.in[i] = (const float*)d_in[i];
    a.out = (float*)d_out; a.ws = (unsigned char*)d_ws;
#if MK_ONE_LAUNCH
    a.lo = 0; a.hi = NPHASE;
    hipLaunchKernelGGL(trunk_fwd, dim3(grid), dim3(NTHR), LDS_BYTES, stream, a);
#else
    for (int p = 0; p < NPHASE; ++p) { a.lo = p; a.hi = p + 1; hipLaunchKernelGGL(trunk_fwd, dim3(grid), dim3(NTHR), LDS_BYTES, stream, a); }
#endif
#ifdef OUTMASK
    {
        const size_t offs[12] = {OFF_YP, OFF_YS, OFF_MK, OFF_MV, OFF_SRP, OFF_SIP, OFF_CONVP, OFF_SRS, OFF_SIS, OFF_CONVS, OFF_SGV, OUT_TOTAL};
        for (int i = 0; i < 11; ++i) if (!((OUTMASK >> i) & 1)) (void)hipMemsetAsync((float*)d_out + offs[i], 0, (offs[i + 1] - offs[i]) * 4, stream);
    }
#endif
}
```

```cpp
#include <hip/hip_runtime.h>
#include <cstdio>
#include <cstdint>
namespace pg8 {
#define PG8_LAS __attribute__((address_space(3)))
typedef unsigned short bf16_t;
typedef short bf16x8 __attribute__((ext_vector_type(8)));
typedef float f32x4 __attribute__((ext_vector_type(4)));
typedef unsigned u32x4 __attribute__((ext_vector_type(4)));
constexpr int BM = 256, BK = 64, HALF = 128, HTB = HALF * BK * 2  , STAGE_BYTES = 8 * HTB, NXCD = 8, WGM = 8;

__host__ __device__ __forceinline__ int lds_byte(int r, int c) { const int st = (r >> 4) * 2 + (c >> 5), rr = r & 15, cc = c & 31, ob = rr * 64 + cc * 2; return st * 1024 + (ob ^ (((ob >> 9) & 1) << 5)); }
__host__ __device__ __forceinline__ void stage_rc(int b, int& R, int& C) { const int st = b / 1024, sb = b % 1024, swz = sb ^ (((sb >> 9) & 1) << 5); R = (st >> 1) * 16 + swz / 64; C = (st & 1) * 32 + (swz % 64) / 2; }
__host__ __device__ __forceinline__ int perm32(int rho) { const int n = rho >> 4, i = rho & 15; return 8 * (i >> 2) + 4 * n + (i & 3); }

struct Unit { int pm, pn; };
struct Gemm { const bf16_t* A; const bf16_t* Bt; int M, N, K; };

struct StaticOrder {
    int nM, nN, nwg, G, c;
    __host__ __device__ void init(int M, int N, int G_, int c_) { nM = M / BM; nN = N / BM; nwg = nM * nN; G = G_; c = c_; }
    __host__ __device__ __forceinline__ bool next(int i, Unit& u) const { return at((long)i * G + c, u); }
    __host__ __device__ __forceinline__ bool at(long L, Unit& u) const {
        if (L >= nwg) return false;
        int wgid = (int)L; { const int q = nwg / NXCD, r = nwg % NXCD, xcd = wgid % NXCD, off = wgid / NXCD; wgid = (xcd < r ? xcd * (q + 1) : r * (q + 1) + (xcd - r) * q) + off; }
        const int nig = WGM * nN, gid = wgid / nig, fm = gid * WGM, gsz = (nM - fm) < WGM ? (nM - fm) : WGM;
        u.pm = fm + ((wgid % nig) % gsz); u.pn = (wgid % nig) / gsz; return true;
    }
    __device__ __forceinline__ void a_ready(const Unit&) const {}
    __device__ __forceinline__ void done(const Unit&) const {}
};
__device__ __forceinline__ unsigned cvt_pk_bf16(float lo, float hi) { unsigned r; asm volatile("v_cvt_pk_bf16_f32 %0, %1, %2" : "=v"(r) : "v"(lo), "v"(hi)); return r; }
typedef float f32x2 __attribute__((ext_vector_type(2)));
template <class Epi, class Sched, bool ALIGN_EPI = false, bool SP2 = false>
__device__ __forceinline__ void gemm_phase(PG8_LAS unsigned char* lds, const Gemm g, const Sched& S, const Epi& E) {
    int tid = threadIdx.x; asm volatile("" : "+v"(tid)); const int wid = __builtin_amdgcn_readfirstlane(tid >> 6), lane = tid & 63, wr = wid >> 2, wc = wid & 3, fr = lane & 15, fq = lane >> 4;
    const int K = g.K, nt = K / BK;
    unsigned voffA[2], voffB[2];
#pragma unroll
    for (int i = 0; i < 2; ++i) { int R, C; stage_rc(tid * 16 + i * 8192, R, C); const int Rb = Epi::PERM ? ((R & ~31) + perm32(R & 31)) : R;
        voffA[i] = (unsigned)(R * K + C) * 2u; voffB[i] = (unsigned)(Rb * K + C) * 2u; }
    const size_t kstep = (size_t)(BK * 2);
    const size_t hstep = (size_t)HALF * K * 2;
    const size_t tstep = 2 * hstep;
    const unsigned ldsw = (unsigned)wid * 1024u;
    const int aoff = lds_byte(wr * 64 + fr, fq * 8), boff = lds_byte(wc * 32 + fr, fq * 8);
#define PG8_SA(b, h) (((b) * 2 + (h)) * HTB)
#define PG8_SB(b, h) ((4 + (b) * 2 + (h)) * HTB)
#define PG8_STAGE(bufoff, gbase, voff) do { _Pragma("unroll") for (int _i = 0; _i < 2; ++_i) \
        __builtin_amdgcn_global_load_lds((const unsigned*)((const char*)(gbase) + (voff)[_i]), (PG8_LAS unsigned*)(lds + (bufoff) + ldsw + _i * 8192), 16, 0, 0); } while (0)
#define PG8_LDA(dst, b, h) do { _Pragma("unroll") for (int m = 0; m < 4; ++m) _Pragma("unroll") for (int k = 0; k < 2; ++k) dst[m][k] = *(const PG8_LAS bf16x8*)(lds + PG8_SA(b, h) + aoff + m * 2048 + k * 1024); } while (0)
#define PG8_LDB(dst, b, h) do { _Pragma("unroll") for (int n = 0; n < 2; ++n) _Pragma("unroll") for (int k = 0; k < 2; ++k) dst[n][k] = *(const PG8_LAS bf16x8*)(lds + PG8_SB(b, h) + boff + n * 2048 + k * 1024); } while (0)
#define PG8_MMA(ai, bj, At, Bt) do { __builtin_amdgcn_s_setprio(1); _Pragma("unroll") for (int m = 0; m < 4; ++m) _Pragma("unroll") for (int n = 0; n < 2; ++n) _Pragma("unroll") for (int k = 0; k < 2; ++k) \
        acc[ai][bj][m][n] = __builtin_amdgcn_mfma_f32_16x16x32_bf16(Bt[n][k], At[m][k], acc[ai][bj][m][n], 0, 0, 0); __builtin_amdgcn_s_setprio(0); } while (0)
#define PG8_WAIT_V(n) asm volatile("s_waitcnt vmcnt(" #n ")" ::: "memory")
#define PG8_WAIT_L(n) asm volatile("s_waitcnt lgkmcnt(" #n ")" ::: "memory")
#define PG8_BAR __builtin_amdgcn_s_barrier()
#define PG8_SCHED __builtin_amdgcn_sched_barrier(0)
    Unit cur, nxt; int ui = 0;
    if (!S.next(0, cur)) return;
    f32x4 acc[2][2][4][2];
#pragma unroll
    for (int a = 0; a < 2; ++a)
#pragma unroll
        for (int b = 0; b < 2; ++b)
#pragma unroll
            for (int m = 0; m < 4; ++m)
#pragma unroll
                for (int n = 0; n < 2; ++n) acc[a][b][m][n] = (f32x4){0.f, 0.f, 0.f, 0.f};
    if constexpr (Epi::INIT_ACC) E.init_acc(acc, cur, wr, wc, fr, fq);
    bf16x8 At[4][2], B0[2][2], B1[2][2];
    const char* cA = (const char*)g.A + (size_t)cur.pm * tstep; const char* cB = (const char*)g.Bt + (size_t)cur.pn * tstep;
    S.a_ready(cur);
    if constexpr (SP2) {
        PG8_STAGE(PG8_SB(0, 0), cB, voffB); PG8_STAGE(PG8_SB(0, 1), cB + hstep, voffB); PG8_STAGE(PG8_SA(0, 0), cA, voffA); PG8_STAGE(PG8_SA(0, 1), cA + hstep, voffA);
        if (wr == 1) PG8_BAR;
        PG8_WAIT_V(2); PG8_BAR;
        PG8_STAGE(PG8_SB(1, 0), cB + kstep, voffB); PG8_STAGE(PG8_SA(1, 0), cA + kstep, voffA); PG8_STAGE(PG8_SB(1, 1), cB + hstep + kstep, voffB);
        PG8_WAIT_V(6); PG8_BAR;
    } else {
        PG8_STAGE(PG8_SB(0, 0), cB, voffB); PG8_STAGE(PG8_SA(0, 0), cA, voffA); PG8_STAGE(PG8_SB(0, 1), cB + hstep, voffB); PG8_STAGE(PG8_SA(0, 1), cA + hstep, voffA);
        if (wr == 1) PG8_BAR;
        PG8_WAIT_V(4); PG8_BAR;
        PG8_STAGE(PG8_SB(1, 0), cB + kstep, voffB); PG8_STAGE(PG8_SA(1, 0), cA + kstep, voffA); PG8_STAGE(PG8_SB(1, 1), cB + hstep + kstep, voffB);
        PG8_WAIT_V(6); PG8_BAR;
    }
    for (;;) {
        const bool has_next = S.next(ui + 1, nxt);
        const char* nA = has_next ? (const char*)g.A + (size_t)nxt.pm * tstep : cA; const char* nB = has_next ? (const char*)g.Bt + (size_t)nxt.pn * tstep : cB;
        for (int t = 0; t < nt; t += 2) {
            const bool last = (t == nt - 2);
            const char* a1 = cA + (size_t)(t + 1) * kstep;
            const char* a2 = last ? nA : cA + (size_t)(t + 2) * kstep; const char* b2 = last ? nB : cB + (size_t)(t + 2) * kstep;
            const char* a3 = a2 + kstep; const char* b3 = b2 + kstep;
            if (last && has_next) S.a_ready(nxt);
            if constexpr (Epi::PREFETCH) { if (last) E.prefetch(cur, wid, lane); }
            if constexpr (SP2) {
            PG8_LDB(B0, 0, 0); PG8_LDB(B1, 0, 1); PG8_SCHED; PG8_LDA(At, 0, 0); PG8_STAGE(PG8_SA(1, 1), a1 + hstep, voffA);
            PG8_WAIT_V(8); PG8_WAIT_L(0); PG8_BAR; PG8_MMA(0, 0, At, B0); PG8_MMA(0, 1, At, B1); PG8_BAR; PG8_SCHED;
            PG8_LDA(At, 0, 1); PG8_STAGE(PG8_SB(0, 0), b2, voffB); PG8_STAGE(PG8_SB(0, 1), b2 + hstep, voffB); PG8_STAGE(PG8_SA(0, 0), a2, voffA);
            PG8_WAIT_V(8); PG8_WAIT_L(0); PG8_BAR; PG8_MMA(1, 0, At, B0); PG8_MMA(1, 1, At, B1); PG8_BAR; PG8_SCHED;
            PG8_LDB(B0, 1, 0); PG8_LDB(B1, 1, 1); PG8_SCHED; PG8_LDA(At, 1, 0); PG8_STAGE(PG8_SA(0, 1), a2 + hstep, voffA);
            PG8_WAIT_V(8); PG8_WAIT_L(0); PG8_BAR; PG8_MMA(0, 0, At, B0); PG8_MMA(0, 1, At, B1); PG8_BAR; PG8_SCHED;
            PG8_LDA(At, 1, 1); PG8_STAGE(PG8_SB(1, 0), b3, voffB); PG8_STAGE(PG8_SB(1, 1), b3 + hstep, voffB); PG8_STAGE(PG8_SA(1, 0), a3, voffA);
            PG8_WAIT_V(8); PG8_WAIT_L(0); PG8_BAR; PG8_MMA(1, 0, At, B0); PG8_MMA(1, 1, At, B1); PG8_BAR; PG8_SCHED;
            } else {
            PG8_LDB(B0, 0, 0); PG8_SCHED; PG8_LDA(At, 0, 0); PG8_STAGE(PG8_SA(1, 1), a1 + hstep, voffA);
            PG8_WAIT_L(8); PG8_BAR; PG8_WAIT_L(0); PG8_MMA(0, 0, At, B0); PG8_BAR; PG8_SCHED;
            PG8_LDB(B1, 0, 1); PG8_STAGE(PG8_SB(0, 0), b2, voffB);
            PG8_BAR; PG8_WAIT_L(0); PG8_MMA(0, 1, At, B1); PG8_BAR;
            PG8_LDA(At, 0, 1); PG8_STAGE(PG8_SA(0, 0), a2, voffA);
            PG8_BAR; PG8_WAIT_L(0); PG8_MMA(1, 0, At, B0); PG8_BAR; PG8_SCHED;
            PG8_STAGE(PG8_SB(0, 1), b2 + hstep, voffB);
            PG8_WAIT_V(6); PG8_BAR; PG8_MMA(1, 1, At, B1); PG8_BAR;
            PG8_LDB(B0, 1, 0); PG8_SCHED; PG8_LDA(At, 1, 0); PG8_STAGE(PG8_SA(0, 1), a2 + hstep, voffA);
            PG8_WAIT_L(8); PG8_BAR; PG8_WAIT_L(0); PG8_MMA(0, 0, At, B0); PG8_BAR; PG8_SCHED;
            PG8_LDB(B1, 1, 1); PG8_STAGE(PG8_SB(1, 0), b3, voffB);
            PG8_BAR; PG8_WAIT_L(0); PG8_MMA(0, 1, At, B1); PG8_BAR;
            PG8_LDA(At, 1, 1); PG8_STAGE(PG8_SA(1, 0), a3, voffA);
            PG8_BAR; PG8_WAIT_L(0); PG8_MMA(1, 0, At, B0); PG8_BAR; PG8_SCHED;
            PG8_STAGE(PG8_SB(1, 1), b3 + hstep, voffB);
            PG8_WAIT_V(6); PG8_BAR; PG8_MMA(1, 1, At, B1); PG8_BAR;
            }
        }
        if constexpr (ALIGN_EPI) { if (wr == 0) PG8_BAR; }
        if constexpr (!Epi::AFTER_DRAIN) { E(acc, cur, wr, wc, fr, fq); S.done(cur); }
        if (!has_next) break;
#pragma unroll
        for (int a = 0; a < 2; ++a)
#pragma unroll
            for (int b = 0; b < 2; ++b)
#pragma unroll
                for (int m = 0; m < 4; ++m)
#pragma unroll
                    for (int n = 0; n < 2; ++n) acc[a][b][m][n] = (f32x4){0.f, 0.f, 0.f, 0.f};
        cur = nxt; cA = nA; cB = nB; ++ui;
        if constexpr (Epi::INIT_ACC) E.init_acc(acc, cur, wr, wc, fr, fq);
        if constexpr (ALIGN_EPI) { if (wr == 1) PG8_BAR; }
    }
    PG8_WAIT_V(0);
    if constexpr (!ALIGN_EPI) { if (wr == 0) PG8_BAR; }
    PG8_BAR;
    if constexpr (Epi::AFTER_DRAIN) { E.fused(acc, cur, wr, wc, fr, fq, lds, wid, lane); S.done(cur); }
#undef PG8_SA
#undef PG8_SB
#undef PG8_STAGE
#undef PG8_LDA
#undef PG8_LDB
#undef PG8_MMA
#undef PG8_WAIT_V
#undef PG8_WAIT_L
#undef PG8_BAR
#undef PG8_SCHED
}
}
#define LAS_BAR __attribute__((address_space(3)))
#define XB_TMO      128
#define XB_XCNT(j)  (256  + 64 * (j))
#define XB_XSUB(j)  (1280 + 64 * (j))
#define XB_XGEN(j)  (2304 + 64 * (j))
#define XB_TOP      3328
#define XB_TOPGEN   3392
#define XCD_BAR_WORDS 3456
#define XB_SPIN_CAP (1u << 18)

__device__ __forceinline__ unsigned xb_ld(unsigned* p)              { return __hip_atomic_load(p, __ATOMIC_RELAXED, __HIP_MEMORY_SCOPE_AGENT); }
__device__ __forceinline__ unsigned xb_add(unsigned* p, unsigned v) { return __hip_atomic_fetch_add(p, v, __ATOMIC_RELAXED, __HIP_MEMORY_SCOPE_AGENT); }
__device__ __forceinline__ unsigned xb_xcc_id() { return (unsigned)__builtin_amdgcn_s_getreg((3 << 11) | 20) & 0xFu; }
#define XB_SPIN(cond, bar) do { unsigned _sp = 0; while (cond) { __builtin_amdgcn_s_sleep(1); \
    if ((++_sp & 255u) == 0u) { if (xb_ld(&(bar)[XB_TMO])) break; if (_sp > XB_SPIN_CAP) { atomicAdd(&(bar)[XB_TMO], 1u); break; } } } } while (0)

struct XcdBarrier {
    unsigned* bar; unsigned x;
    volatile LAS_BAR unsigned* st;
};

__device__ __forceinline__ XcdBarrier xcd_barrier_post(unsigned* bar, volatile LAS_BAR unsigned* st) {
    XcdBarrier b; b.bar = bar; b.x = xb_xcc_id(); b.st = st;
    if (threadIdx.x == 0) (void)xb_add(&bar[XB_XCNT(b.x)], 1u);
    return b;
}
__device__ __forceinline__ void xcd_barrier_complete(unsigned* bar, unsigned x, unsigned& nloc, unsigned& nx) {
    const unsigned G = gridDim.x * gridDim.y * gridDim.z;
    unsigned sum, cnt, mine, sp = 0u;
    for (;;) {
        sum = 0u; cnt = 0u; mine = 0u;
#pragma unroll
        for (unsigned j = 0; j < 16; ++j) { const unsigned c = xb_ld(&bar[XB_XCNT(j)]); sum += c; cnt += (c > 0u) ? 1u : 0u; mine = (j == x) ? c : mine; }
        if (sum == G) break;
        __builtin_amdgcn_s_sleep(1);
        if ((++sp & 255u) == 0u) { if (xb_ld(&bar[XB_TMO])) break; if (sp > XB_SPIN_CAP) { atomicAdd(&bar[XB_TMO], 1u); break; } }
    }
    nloc = mine > 0u ? mine : 1u; nx = cnt > 0u ? cnt : 1u;
}

__device__ __forceinline__ void xcd_barrier(const XcdBarrier& b) {
    asm volatile("s_waitcnt vmcnt(0)" ::: "memory");
    __syncthreads();
    int t0_ = threadIdx.x; asm volatile("" : "+v"(t0_));
    if (t0_ == 0) {
        unsigned* bar = b.bar;
        __builtin_amdgcn_s_waitcnt(0);
        unsigned nloc = b.st[0], nx = b.st[1];
        if (nloc == 0u) { xcd_barrier_complete(bar, b.x, nloc, nx); b.st[0] = nloc; b.st[1] = nx; }
        const unsigned old = xb_add(&bar[XB_XSUB(b.x)], 1u);
        const unsigned gen = old / nloc;
        if (old + 1u == (gen + 1u) * nloc) {
            __builtin_amdgcn_fence(__ATOMIC_RELEASE, "agent");
            asm volatile("s_waitcnt vmcnt(0)" ::: "memory");
            const unsigned og = xb_add(&bar[XB_TOP], 1u);
            const unsigned tg = og / nx;
            if (og + 1u == (tg + 1u) * nx) xb_add(&bar[XB_TOPGEN], 1u);
            else XB_SPIN(xb_ld(&bar[XB_TOPGEN]) == tg, bar);
            __builtin_amdgcn_fence(__ATOMIC_ACQUIRE, "agent");
            xb_add(&bar[XB_XGEN(b.x)], 1u);
            asm volatile("s_waitcnt vmcnt(0)" ::: "memory");
        } else {
            XB_SPIN(xb_ld(&bar[XB_XGEN(b.x)]) == gen, bar);
            __builtin_amdgcn_fence(__ATOMIC_ACQUIRE, "agent");
            asm volatile("s_waitcnt vmcnt(0)" ::: "memory");
        }
    }
    __syncthreads();
}
#define GAS __attribute__((address_space(1)))
#define LAS __attribute__((address_space(3)))
typedef unsigned short bf16;
typedef unsigned v4u __attribute__((ext_vector_type(4)));
typedef unsigned v2u __attribute__((ext_vector_type(2)));
typedef float f32x4 __attribute__((ext_vector_type(4)));
typedef short bf16x8 __attribute__((ext_vector_type(8)));
typedef short bf16x4 __attribute__((ext_vector_type(4)));

constexpr int NWAVES = 8, NTHR = 512;
constexpr int D = 2048, SEQ = 2048, MP = 8192, MS = 128, MREAL = 8320, MT = 8448;
constexpr int MMEM = 1024, XAW = 512, TOKW = 1536, SGN = 3584, DFF = 5504, NUP = 11008;
constexpr int NGRP = 96, KH = 384;
constexpr float EPS = 1e-6f;
constexpr int NPHASE = 24;

constexpr size_t OFF_YP = 0, OFF_YS = 16777216, OFF_MK = 17039360, OFF_MV = 19136512, OFF_SRP = 21233664, OFF_SIP = 21282816,
                 OFF_CONVP = 21331968, OFF_SRS = 21508096, OFF_SIS = 23080960, OFF_CONVS = 24653824, OFF_SGV = 30289920, OUT_TOTAL = 30683136;

constexpr size_t MiB = 1u << 20;
constexpr size_t WS_CTL = 0, CTL_ZERO_BYTES = 1 * MiB;
constexpr size_t WS_WSGIN = 1 * MiB;
constexpr size_t WS_WSSMIN = WS_WSGIN + 28 * MiB;
constexpr size_t WS_WSGOUT = WS_WSSMIN + 16 * MiB;
constexpr size_t WS_WSSMOUT = WS_WSGOUT + 16 * MiB;
constexpr size_t WS_WGLU = WS_WSSMOUT + 16 * MiB;
constexpr size_t WS_WUP = WS_WGLU + 9 * MiB;
constexpr size_t WS_WDOWN = WS_WUP + 172 * MiB;
constexpr size_t WS_WMEM = WS_WDOWN + 86 * MiB;
constexpr size_t WS_WSB = WS_WMEM + 16 * MiB;
constexpr size_t WS_TB = WS_WSB + 1 * MiB;
constexpr size_t WS_BT2 = WS_TB + 36 * MiB;
constexpr size_t WS_LBT = WS_BT2 + 12 * MiB;
constexpr size_t WS_LB16 = WS_LBT + 128 * 1024;
constexpr size_t WS_BBAR = WS_LBT + 1 * MiB;
constexpr size_t WS_XRES = WS_BBAR + 2 * MiB;
constexpr size_t WS_XB = WS_XRES + 66 * MiB;
constexpr size_t WS_MEMB = WS_XB + 33 * MiB;
constexpr size_t WS_MKV = WS_MEMB + 4 * MiB;
constexpr size_t WS_ZU = WS_MKV + 8 * MiB;
constexpr size_t WS_ZV = WS_ZU + 25 * MiB;
constexpr size_t WS_Q = WS_ZV + 25 * MiB;
constexpr size_t WS_MIX = WS_Q + 9 * MiB;
constexpr size_t WS_AG = WS_MIX + 33 * MiB;
constexpr size_t WS_Y = WS_AG + 178 * MiB;
constexpr size_t WS_UH = WS_Y + 89 * MiB;
constexpr size_t WS_YB = WS_UH + 36 * MiB;
constexpr size_t WS_US = WS_YB + 25 * MiB;
constexpr size_t WS_FXA = WS_US + 1 * MiB;
constexpr size_t WS_FXG = WS_FXA + 3 * MiB;
constexpr size_t WS_END = WS_FXG + 2 * MiB;
constexpr int CW_BAR = 4096;
constexpr int CW_SDONE = 8192, CW_SQUEUE = 8192 + 64 * 4, CW_PCNT = 8192 + 64 * 16, CW_ADONE = CW_PCNT + 64 * 32, CW_AQUEUE = CW_ADONE + 64 * 4, CW_WQUEUE = CW_AQUEUE + 64 * 4;
typedef unsigned long long ssq_t;
constexpr size_t CTL_SSX = 64 * 1024;
constexpr size_t CTL_SSV = 704 * 1024;
constexpr size_t CTL_SSMEM = 896 * 1024;
static_assert(CTL_SSX + 9 * MT * 8 <= CTL_SSV && CTL_SSV + 2 * MT * 8 <= CTL_SSMEM && CTL_SSMEM + 8192 <= CTL_ZERO_BYTES, "ctl map");

constexpr int LDS_BYTES = 147456, MISC_OFF = LDS_BYTES - 512, HALO_OFF = 131072;

__device__ __forceinline__ unsigned pk2(float lo, float hi) { return pg8::cvt_pk_bf16(lo, hi); }
__device__ __forceinline__ float bflo(unsigned w) { return __uint_as_float(w << 16); }
__device__ __forceinline__ float bfhi(unsigned w) { return __uint_as_float(w & 0xffff0000u); }
__device__ __forceinline__ float gelu_t(float x) { const float e = __builtin_amdgcn_exp2f(x * (-2.3022082f - 0.10294324f * x * x)); return x * __builtin_amdgcn_rcpf(1.f + e); }
__device__ __forceinline__ float sigmoid_f(float x) { return __builtin_amdgcn_rcpf(1.f + __builtin_amdgcn_exp2f(-1.4426950409f * x)); }
__device__ __forceinline__ ssq_t ss_fix(float v) { return (ssq_t)(long long)(v * 1073741824.0f); }
__device__ __forceinline__ float rstd_of(ssq_t ss, float inv_n) { return rsqrtf((float)ss * (1.0f / 1073741824.0f) * inv_n + EPS); }
__device__ __forceinline__ float wave_sum(float v) {
#pragma unroll
    for (int o = 1; o < 64; o <<= 1) v += __shfl_xor(v, o);
    return v;
}
__device__ __forceinline__ float wave_max(float v) {
#pragma unroll
    for (int o = 1; o < 64; o <<= 1) v = fmaxf(v, __shfl_xor(v, o));
    return v;
}
__device__ __forceinline__ void fadd_atomic(ssq_t* p, float v) { atomicAdd(p, ss_fix(v)); }
__device__ __forceinline__ int tid_now() { int t = threadIdx.x; asm volatile("" : "+v"(t)); return t; }
__device__ __forceinline__ f32x4 gelu4(f32x4 v) { return (f32x4){gelu_t(v[0]), gelu_t(v[1]), gelu_t(v[2]), gelu_t(v[3])}; }
__device__ __forceinline__ v4u pack8(f32x4 a, f32x4 b) { v4u w; w.x = pk2(a[0], a[1]); w.y = pk2(a[2], a[3]); w.z = pk2(b[0], b[1]); w.w = pk2(b[2], b[3]); return w; }
__device__ __forceinline__ float dot4(f32x4 a) { return (a[0] * a[0] + a[1] * a[1]) + (a[2] * a[2] + a[3] * a[3]); }

typedef const f32x4 (&AccRef)[2][2][4][2];
struct EpiSgIn {
    static constexpr bool PERM = true, AFTER_DRAIN = false, PREFETCH = false, INIT_ACC = false;
    const ssq_t* ss; bf16* zu; bf16* zv; bf16* q; ssq_t* ssv; unsigned* sdone;
    __device__ __forceinline__ void operator()(AccRef acc, const pg8::Unit& u, int wr, int wc, int fr, int fq) const {
        asm volatile("" : "+v"(fr), "+v"(fq));
        const int row0 = u.pm * 256 + wr * 64 + fr, colt = u.pn * 256 + wc * 32 + 8 * fq;
        const int kind = u.pn < 6 ? 0 : (u.pn < 12 ? 1 : 2);
#pragma unroll
        for (int ai = 0; ai < 2; ++ai)
#pragma unroll
            for (int m = 0; m < 4; ++m) {
                const int r = row0 + ai * 128 + m * 16; const float rs = rstd_of(ss[r], 1.f / 2048.f); float sq = 0.f;
#pragma unroll
                for (int bj = 0; bj < 2; ++bj) {
                    f32x4 v0 = acc[ai][bj][m][0] * rs, v1 = acc[ai][bj][m][1] * rs; const int c = colt + bj * 128;
                    if (kind < 2) { v0 = gelu4(v0); v1 = gelu4(v1); }
                    if (kind == 1) sq += dot4(v0) + dot4(v1);
                    bf16* dst = kind == 0 ? zu + (size_t)r * TOKW + c : (kind == 1 ? zv + (size_t)r * TOKW + (c - TOKW) : q + (size_t)r * XAW + (c - 2 * TOKW));
                    *(v4u*)dst = pack8(v0, v1);
                }
                if (kind == 1) { sq += __shfl_xor(sq, 16); sq += __shfl_xor(sq, 32); if (fq == 0) fadd_atomic(ssv + r, sq); }
                asm volatile("" ::: "memory");
            }
        if (u.pm == MP / 256) {
            asm volatile("s_waitcnt vmcnt(0)" ::: "memory"); __builtin_amdgcn_s_barrier(); asm volatile("" ::: "memory");
            if (tid_now() == 0) { __builtin_amdgcn_fence(__ATOMIC_RELEASE, "agent"); asm volatile("s_waitcnt vmcnt(0)" ::: "memory"); __hip_atomic_fetch_add(sdone, 1u, __ATOMIC_RELAXED, __HIP_MEMORY_SCOPE_AGENT); }
        }
    }
};
struct EpiRes {
    static constexpr bool PERM = true, AFTER_DRAIN = false, PREFETCH = false, INIT_ACC = true;
    bf16* xb; ssq_t* ssn;
    __device__ __forceinline__ void init_acc(f32x4 (&acc)[2][2][4][2], const pg8::Unit& u, int wr, int wc, int fr, int fq) const {
        const bf16* bp0 = xb + (size_t)(u.pm * 256 + wr * 64 + fr) * D + u.pn * 256 + wc * 32 + 8 * fq;
#pragma unroll
        for (int ai = 0; ai < 2; ++ai)
#pragma unroll
            for (int m = 0; m < 4; ++m)
#pragma unroll
                for (int bj = 0; bj < 2; ++bj) { const v4u w = *(const v4u*)(bp0 + (size_t)(ai * 128 + m * 16) * D + bj * 128);
                    acc[ai][bj][m][0] = (f32x4){bflo(w.x), bfhi(w.x), bflo(w.y), bfhi(w.y)}; acc[ai][bj][m][1] = (f32x4){bflo(w.z), bfhi(w.z), bflo(w.w), bfhi(w.w)}; }
    }
    __device__ __forceinline__ void operator()(AccRef acc, const pg8::Unit& u, int wr, int wc, int fr, int fq) const {
        asm volatile("" : "+v"(fr), "+v"(fq));
        const int row0 = u.pm * 256 + wr * 64 + fr, col0 = u.pn * 256 + wc * 32 + 8 * fq;
#pragma unroll
        for (int ai = 0; ai < 2; ++ai)
#pragma unroll
            for (int m = 0; m < 4; ++m) {
                const int r = row0 + ai * 128 + m * 16; float sq = 0.f; bf16* bp = xb + (size_t)r * D + col0;
#pragma unroll
                for (int bj = 0; bj < 2; ++bj) { const f32x4 o0 = acc[ai][bj][m][0], o1 = acc[ai][bj][m][1]; sq += dot4(o0) + dot4(o1); *(v4u*)(bp + bj * 128) = pack8(o0, o1); }
                sq += __shfl_xor(sq, 16); sq += __shfl_xor(sq, 32); if (fq == 0) fadd_atomic(ssn + r, sq);
                asm volatile("" ::: "memory");
            }
    }
};
struct EpiResFinal {
    static constexpr bool PERM = true, AFTER_DRAIN = false, PREFETCH = false, INIT_ACC = true;
    const bf16* xb; ssq_t* ssn; float* out; const float* gfin; unsigned* pcnt;
    __device__ __forceinline__ void init_acc(f32x4 (&acc)[2][2][4][2], const pg8::Unit& u, int wr, int wc, int fr, int fq) const {
        const bf16* bp0 = xb + (size_t)(u.pm * 256 + wr * 64 + fr) * D + u.pn * 256 + wc * 32 + 8 * fq;
#pragma unroll
        for (int ai = 0; ai < 2; ++ai)
#pragma unroll
            for (int m = 0; m < 4; ++m)
#pragma unroll
                for (int bj = 0; bj < 2; ++bj) { const v4u w = *(const v4u*)(bp0 + (size_t)(ai * 128 + m * 16) * D + bj * 128);
                    acc[ai][bj][m][0] = (f32x4){bflo(w.x), bfhi(w.x), bflo(w.y), bfhi(w.y)}; acc[ai][bj][m][1] = (f32x4){bflo(w.z), bfhi(w.z), bflo(w.w), bfhi(w.w)}; }
    }
    __device__ __forceinline__ void operator()(f32x4 (&acc)[2][2][4][2], const pg8::Unit& u, int wr, int wc, int fr, int fq) const {
        asm volatile("" : "+v"(fr), "+v"(fq));
        const int row0 = u.pm * 256 + wr * 64 + fr, col0 = u.pn * 256 + wc * 32 + 8 * fq;
#pragma unroll
        for (int ai = 0; ai < 2; ++ai)
#pragma unroll
            for (int m = 0; m < 4; ++m) {
                const int r = row0 + ai * 128 + m * 16; float sq = 0.f;
#pragma unroll
                for (int bj = 0; bj < 2; ++bj) sq += dot4(acc[ai][bj][m][0]) + dot4(acc[ai][bj][m][1]);
                sq += __shfl_xor(sq, 16); sq += __shfl_xor(sq, 32); if (fq == 0) fadd_atomic(ssn + r, sq);
            }
        asm volatile("s_waitcnt vmcnt(0)" ::: "memory"); __builtin_amdgcn_s_barrier(); asm volatile("" ::: "memory");
        if (tid_now() == 0) { unsigned* pc = pcnt + 64 * u.pm; __hip_atomic_fetch_add(pc, 1u, __ATOMIC_RELAXED, __HIP_MEMORY_SCOPE_AGENT);
            unsigned sp = 0; while (__hip_atomic_load(pc, __ATOMIC_RELAXED, __HIP_MEMORY_SCOPE_AGENT) < 8u) { __builtin_amdgcn_s_sleep(1); if (++sp > (1u << 22)) break; } }
        asm volatile("" ::: "memory"); __builtin_amdgcn_s_barrier(); asm volatile("" ::: "memory");
        f32x4 gf[2][2];
#pragma unroll
        for (int bj = 0; bj < 2; ++bj) { gf[bj][0] = *(const f32x4*)(gfin + col0 + bj * 128); gf[bj][1] = *(const f32x4*)(gfin + col0 + bj * 128 + 4); }
#pragma unroll
        for (int ai = 0; ai < 2; ++ai)
#pragma unroll
            for (int m = 0; m < 4; ++m) {
                const int r = row0 + ai * 128 + m * 16; const float rs = rstd_of(__hip_atomic_load(ssn + r, __ATOMIC_RELAXED, __HIP_MEMORY_SCOPE_AGENT), 1.f / 2048.f);
                float* op = out + OFF_YP + (size_t)r * D + col0;
#pragma unroll
                for (int bj = 0; bj < 2; ++bj) { *(f32x4*)(op + bj * 128) = acc[ai][bj][m][0] * rs * gf[bj][0]; *(f32x4*)(op + bj * 128 + 4) = acc[ai][bj][m][1] * rs * gf[bj][1]; }
            }
    }
};
__device__ __forceinline__ float dpp_f(float old, float src, const int ctrl_sel) {
    const int o = __builtin_bit_cast(int, old), v = __builtin_bit_cast(int, src); int r;
    if (ctrl_sel == 0) r = __builtin_amdgcn_update_dpp(o, v, 0x111, 0xf, 0xf, false);
    else if (ctrl_sel == 1) r = __builtin_amdgcn_update_dpp(o, v, 0x112, 0xf, 0xf, false);
    else if (ctrl_sel == 2) r = __builtin_amdgcn_update_dpp(o, v, 0x121, 0xf, 0xf, false);
    else r = __builtin_amdgcn_update_dpp(o, v, 0x122, 0xf, 0xf, false);
    return __builtin_bit_cast(float, r);
}
struct EpiUp {
    static constexpr bool PERM = true, AFTER_DRAIN = false, PREFETCH = true, INIT_ACC = false;
    const ssq_t* ss; bf16* yf; float* out; const float* stc; const float* cw; const float* cb; float* fxa; LAS float* halo; int layer; unsigned* sdone;
    __device__ __forceinline__ void prefetch(const pg8::Unit& u, int wid, int lane) const {
        const int arr = wid >> 1, half = wid & 1; const float* src = (arr < 3 ? cw + (size_t)arr * DFF : cb) + u.pn * 128 + half * 64 + lane;
        __builtin_amdgcn_global_load_lds((const unsigned*)src, (LAS unsigned*)(halo + 1024 + arr * 128 + half * 64), 4, 0, 0);
        const unsigned* s2 = (const unsigned*)(ss + u.pm * 256 + wid * 32) + lane;
        __builtin_amdgcn_global_load_lds(s2, (LAS unsigned*)(halo + 1536 + wid * 64), 4, 0, 0);
    }
    typedef float f32x2 __attribute__((ext_vector_type(2)));
    static __device__ __forceinline__ f32x2 silu_gate2(f32x2 cc, f32x2 g) {
        const f32x2 t = cc * (-1.4426950409f); f32x2 e; e.x = __builtin_amdgcn_exp2f(t.x); e.y = __builtin_amdgcn_exp2f(t.y); e = e + 1.0f;
        f32x2 r; r.x = __builtin_amdgcn_rcpf(e.x); r.y = __builtin_amdgcn_rcpf(e.y); return (cc * r) * g;
    }
    __device__ __forceinline__ void operator()(AccRef acc, const pg8::Unit& u, int wr, int wc, int fr, int fq) const {
        asm volatile("" : "+v"(fr), "+v"(fq));
        const int lrow0 = wr * 64 + fr, row0 = u.pm * 256 + lrow0, cl = wc * 32 + 8 * fq, c0 = u.pn * 128 + cl;
        const LAS ssq_t* ssl = (const LAS ssq_t*)(halo + 1536);
        float rs[2][4];
#pragma unroll
        for (int ai = 0; ai < 2; ++ai)
#pragma unroll
            for (int m = 0; m < 4; ++m) rs[ai][m] = rstd_of(ssl[lrow0 + ai * 128 + m * 16], 1.f / 2048.f);
        if (u.pm == MP / 256) {
#pragma unroll
            for (int n = 0; n < 2; ++n) {
                const int c = c0 + 4 * n;
                const f32x4 k0 = *(const LAS f32x4*)(halo + 1024 + cl + 4 * n), k1 = *(const LAS f32x4*)(halo + 1152 + cl + 4 * n), k2 = *(const LAS f32x4*)(halo + 1280 + cl + 4 * n), kb = *(const LAS f32x4*)(halo + 1408 + cl + 4 * n);
#pragma unroll
                for (int ai = 0; ai < 2; ++ai)
#pragma unroll
                    for (int m = 0; m < 4; ++m) {
                        const int r = row0 + ai * 128 + m * 16; if (r >= MREAL) continue;
                        const f32x4 a = acc[ai][0][m][n] * rs[ai][m], g = acc[ai][1][m][n] * rs[ai][m];
                        const float* sp = stc + ((size_t)(r - MP) * 2) * DFF + c; const f32x4 p2 = *(const f32x4*)sp, p1 = *(const f32x4*)(sp + DFF);
                        float* co = out + OFF_CONVS + ((size_t)(layer * MS + (r - MP)) * 2) * DFF + c; *(f32x4*)co = p1; *(f32x4*)(co + DFF) = a;
                        f32x4 y;
#pragma unroll
                        for (int i = 0; i < 4; ++i) { const float cc = kb[i] + k0[i] * p2[i] + k1[i] * p1[i] + k2[i] * a[i]; y[i] = cc * sigmoid_f(cc) * g[i]; }
                        v2u w; w.x = pk2(y[0], y[1]); w.y = pk2(y[2], y[3]); *(v2u*)(yf + (size_t)r * DFF + c) = w;
                    }
            }
            asm volatile("s_waitcnt vmcnt(0)" ::: "memory"); __builtin_amdgcn_s_barrier(); asm volatile("" ::: "memory");
            if (tid_now() == 0) { __builtin_amdgcn_fence(__ATOMIC_RELEASE, "agent"); asm volatile("s_waitcnt vmcnt(0)" ::: "memory"); __hip_atomic_fetch_add(sdone, 1u, __ATOMIC_RELAXED, __HIP_MEMORY_SCOPE_AGENT); }
            return;
        }
        float* const fxg = fxa + (WS_FXG - WS_FXA) / 4;
        if (fr >= 14) {
#pragma unroll
            for (int ai = 0; ai < 2; ++ai)
#pragma unroll
                for (int n = 0; n < 2; ++n) *(LAS f32x4*)(halo + ((2 * ai + wr) * 2 + (fr - 14)) * 128 + cl + 4 * n) = acc[ai][0][3][n] * rs[ai][3];
        }
        asm volatile("s_waitcnt lgkmcnt(0)" ::: "memory"); __builtin_amdgcn_s_barrier(); asm volatile("" ::: "memory");
        f32x2 kk[2][8];
#pragma unroll
        for (int n = 0; n < 2; ++n) {
            const f32x4 k0 = *(const LAS f32x4*)(halo + 1024 + cl + 4 * n), k1 = *(const LAS f32x4*)(halo + 1152 + cl + 4 * n), k2 = *(const LAS f32x4*)(halo + 1280 + cl + 4 * n), kb = *(const LAS f32x4*)(halo + 1408 + cl + 4 * n);
            kk[n][0] = (f32x2){k0[0], k0[1]}; kk[n][1] = (f32x2){k0[2], k0[3]}; kk[n][2] = (f32x2){k1[0], k1[1]}; kk[n][3] = (f32x2){k1[2], k1[3]};
            kk[n][4] = (f32x2){k2[0], k2[1]}; kk[n][5] = (f32x2){k2[2], k2[3]}; kk[n][6] = (f32x2){kb[0], kb[1]}; kk[n][7] = (f32x2){kb[2], kb[3]};
        }
#pragma unroll
        for (int ai = 0; ai < 2; ++ai) {
            f32x4 prev[2];
#pragma unroll
            for (int n = 0; n < 2; ++n) { prev[n] = (f32x4){0.f, 0.f, 0.f, 0.f};
                if ((ai + wr) > 0 && fr >= 14) prev[n] = *(const LAS f32x4*)(halo + ((2 * ai + wr - 1) * 2 + (fr - 14)) * 128 + cl + 4 * n); }
#pragma unroll
            for (int m = 0; m < 4; ++m) {
                const int r = row0 + ai * 128 + m * 16; v4u w;
#pragma unroll
                for (int n = 0; n < 2; ++n) {
                    const int c = c0 + 4 * n; const f32x4 a = acc[ai][0][m][n] * rs[ai][m], g = acc[ai][1][m][n] * rs[ai][m];
                    f32x4 p1, p2;
#pragma unroll
                    for (int i = 0; i < 4; ++i) { p1[i] = dpp_f(dpp_f(0.f, prev[n][i], 2), a[i], 0); p2[i] = dpp_f(dpp_f(0.f, prev[n][i], 3), a[i], 1); }
                    const f32x2 ccl = kk[n][6] + kk[n][0] * (f32x2){p2[0], p2[1]} + kk[n][2] * (f32x2){p1[0], p1[1]} + kk[n][4] * (f32x2){a[0], a[1]};
                    const f32x2 cch = kk[n][7] + kk[n][1] * (f32x2){p2[2], p2[3]} + kk[n][3] * (f32x2){p1[2], p1[3]} + kk[n][5] * (f32x2){a[2], a[3]};
                    const f32x2 yl = silu_gate2(ccl, (f32x2){g[0], g[1]}), yh = silu_gate2(cch, (f32x2){g[2], g[3]});
                    if (n == 0) { w.x = pk2(yl.x, yl.y); w.y = pk2(yh.x, yh.y); } else { w.z = pk2(yl.x, yl.y); w.w = pk2(yh.x, yh.y); }
                    if (ai == 0 && m == 0) { if (wr == 0 && fr < 2) { *(f32x4*)(fxa + ((size_t)(u.pm * 4 + fr)) * DFF + c) = a; *(f32x4*)(fxg + ((size_t)(u.pm * 2 + fr)) * DFF + c) = g; } }
                    if (ai == 1 && m == 3) { if (wr == 1 && fr >= 14) { *(f32x4*)(fxa + ((size_t)(u.pm * 4 + fr - 12)) * DFF + c) = a;
                        if ((u.pm & 7) == 7) *(f32x4*)(out + OFF_CONVP + ((size_t)((layer * 4 + (u.pm >> 3)) * 2 + (fr - 14))) * DFF + c) = a; } }
                    prev[n] = a;
                }
                *(v4u*)(yf + (size_t)r * DFF + c0) = w;
            }
        }
    }
};
struct EpiSsmIn {
    static constexpr bool PERM = true, AFTER_DRAIN = false, PREFETCH = false, INIT_ACC = false;
    const ssq_t* ss; bf16* uh; float* us; bf16* q;
    __device__ __forceinline__ void operator()(AccRef acc, const pg8::Unit& u, int wr, int wc, int fr, int fq) const {
        asm volatile("" : "+v"(fr), "+v"(fq));
        const int row0 = u.pm * 256 + wr * 64 + fr, colt = u.pn * 256 + wc * 32 + 8 * fq;
#pragma unroll
        for (int ai = 0; ai < 2; ++ai)
#pragma unroll
            for (int m = 0; m < 4; ++m) {
                const int r = row0 + ai * 128 + m * 16; const float rs = rstd_of(ss[r], 1.f / 2048.f);
#pragma unroll
                for (int bj = 0; bj < 2; ++bj) {
                    const f32x4 v0 = acc[ai][bj][m][0] * rs, v1 = acc[ai][bj][m][1] * rs; const int c = colt + bj * 128;
                    if (u.pn < 6) {
                        if (r < MP) { const int h = c >> 4, c0 = c & 15; *(v4u*)(uh + ((size_t)(h * 512 + (r >> 4)) * KH + (r & 15) * 16 + c0)) = pack8(v0, v1); }
                        else if (r < MREAL) { float* o = us + (size_t)(r - MP) * TOKW + c; *(f32x4*)o = v0; *(f32x4*)(o + 4) = v1; }
                    } else *(v4u*)(q + (size_t)r * XAW + (c - TOKW)) = pack8(v0, v1);
                }
                asm volatile("" ::: "memory");
            }
    }
};
struct EpiToep {
    static constexpr bool PERM = true, AFTER_DRAIN = false, PREFETCH = false, INIT_ACC = false;
    bf16* yb;
    __device__ __forceinline__ void operator()(AccRef acc, const pg8::Unit& u, int wr, int wc, int fr, int fq) const {
        asm volatile("" : "+v"(fr), "+v"(fq));
        const int h = u.pn, mh = u.pm - 2 * h;
#pragma unroll
        for (int ai = 0; ai < 2; ++ai)
#pragma unroll
            for (int m = 0; m < 4; ++m) {
                const int ml = mh * 256 + ai * 128 + wr * 64 + m * 16 + fr;
#pragma unroll
                for (int bj = 0; bj < 2; ++bj) {
                    const int cl = bj * 128 + wc * 32 + 8 * fq, tau = cl >> 4, c0 = cl & 15;
                    *(v4u*)(yb + (size_t)(ml * 16 + tau) * TOKW + h * 16 + c0) = pack8(gelu4(acc[ai][bj][m][0]), gelu4(acc[ai][bj][m][1]));
                    __builtin_amdgcn_sched_barrier(0);
                }
            }
    }
};
struct EpiGlu {
    static constexpr bool PERM = true, AFTER_DRAIN = false, PREFETCH = false, INIT_ACC = false;
    const bf16* yb; const float* bias; bf16* mix;
    __device__ __forceinline__ void operator()(AccRef acc, const pg8::Unit& u, int wr, int wc, int fr, int fq) const {
        asm volatile("" : "+v"(fr), "+v"(fq));
        const int row0 = u.pm * 256 + wr * 64 + fr, colt = u.pn * 256 + wc * 32 + 8 * fq;
#pragma unroll
        for (int ai = 0; ai < 2; ++ai)
#pragma unroll
            for (int m = 0; m < 4; ++m) {
                const int r = row0 + ai * 128 + m * 16;
#pragma unroll
                for (int bj = 0; bj < 2; ++bj) {
                    const int c = colt + bj * 128; const f32x4 b0 = *(const f32x4*)(bias + c), b1 = *(const f32x4*)(bias + c + 4);
                    const v4u yw = *(const v4u*)(yb + (size_t)r * TOKW + c);
                    const f32x4 g0 = acc[ai][bj][m][0] + b0, g1 = acc[ai][bj][m][1] + b1;
                    f32x4 o0, o1;
                    o0[0] = bflo(yw.x) * sigmoid_f(g0[0]); o0[1] = bfhi(yw.x) * sigmoid_f(g0[1]); o0[2] = bflo(yw.y) * sigmoid_f(g0[2]); o0[3] = bfhi(yw.y) * sigmoid_f(g0[3]);
                    o1[0] = bflo(yw.z) * sigmoid_f(g1[0]); o1[1] = bfhi(yw.z) * sigmoid_f(g1[1]); o1[2] = bflo(yw.w) * sigmoid_f(g1[2]); o1[3] = bfhi(yw.w) * sigmoid_f(g1[3]);
                    *(v4u*)(mix + (size_t)r * D + c) = pack8(o0, o1);
                    asm volatile("" ::: "memory");
                }
            }
    }
};
struct EpiMem {
    static constexpr bool PERM = false, AFTER_DRAIN = false, PREFETCH = false, INIT_ACC = false;
    const ssq_t* ssm; float* out; bf16* mkv;
    __device__ __forceinline__ void operator()(AccRef acc, const pg8::Unit& u, int wr, int wc, int fr, int fq) const {
        asm volatile("" : "+v"(fr), "+v"(fq));
        const int row0 = u.pm * 256 + wr * 64 + fr, col0 = u.pn * 256 + wc * 32 + 4 * fq;
#pragma unroll
        for (int ai = 0; ai < 2; ++ai)
#pragma unroll
            for (int m = 0; m < 4; ++m) {
                const int r = row0 + ai * 128 + m * 16; const float rs = rstd_of(ssm[r], 1.f / 2048.f);
#pragma unroll
                for (int bj = 0; bj < 2; ++bj)
#pragma unroll
                    for (int n = 0; n < 2; ++n) { const int c = col0 + bj * 128 + n * 16, li = c >> 10, cc = c & 1023; const f32x4 v = acc[ai][bj][m][n] * rs;
                        *(f32x4*)(out + (cc < 512 ? OFF_MK : OFF_MV) + (size_t)(li * 1024 + r) * 512 + (cc & 511)) = v;
                        v2u w; w.x = pk2(v[0], v[1]); w.y = pk2(v[2], v[3]); *(v2u*)(mkv + (size_t)(li * 1024 + r) * 1024 + cc) = w; }
            }
    }
};
struct MemOrder {
    int G, c, first, count, base;
    __device__ __forceinline__ bool next(int i, pg8::Unit& u) const { const int q = (c - first + G) % G + i * G; if (q >= count) return false; const int Q = base + q; u.pm = Q & 3; u.pn = Q >> 2; return true; }
    __device__ __forceinline__ void a_ready(const pg8::Unit&) const {}
    __device__ __forceinline__ void done(const pg8::Unit&) const {}
};
struct UpOrder {
    pg8::StaticOrder base; int G, c;
    __device__ __forceinline__ bool next(int i, pg8::Unit& u) const { const long L = (long)i * G + c; if (L < NUP / 256) { u.pm = MP / 256; u.pn = (int)L; return true; } return base.at(L - NUP / 256, u); }
    __device__ __forceinline__ void a_ready(const pg8::Unit&) const {}
    __device__ __forceinline__ void done(const pg8::Unit&) const {}
};
struct SgOrder {
    pg8::StaticOrder base; int G, c;
    __device__ __forceinline__ bool next(int i, pg8::Unit& u) const { const long L = (long)i * G + c; if (L < SGN / 256) { u.pm = MP / 256; u.pn = (int)L; return true; } return base.at(L - SGN / 256, u); }
    __device__ __forceinline__ void a_ready(const pg8::Unit&) const {}
    __device__ __forceinline__ void done(const pg8::Unit&) const {}
};
struct ToepOrder {
    int G, c;
    __device__ __forceinline__ bool next(int i, pg8::Unit& u) const { const int L = i * G + c; if (L >= 2 * NGRP) return false; const int h = L >> 1; u.pm = 2 * h + (L & 1); u.pn = h; return true; }
    __device__ __forceinline__ void a_ready(const pg8::Unit&) const {}
    __device__ __forceinline__ void done(const pg8::Unit&) const {}
};

constexpr int P0_TLD = 130;
constexpr int P0_T0 = 896, P0_T1 = P0_T0 + 512, P0_T2 = P0_T1 + 512, P0_T3 = P0_T2 + 512, P0_T4 = P0_T3 + 288, P0_T5 = P0_T4 + 5504, P0_T6 = P0_T5 + 2752, P0_NTILES = P0_T6 + 512;
constexpr int P0_NOW = 8752, P0_DEF2 = 1392, P0_DEF3 = 1344;
__device__ __forceinline__ int p0_remap_now(int c) {
    if (c < 448) return c; c -= 448; if (c < 256) return 896 + c; c -= 256; if (c < 256) return 1408 + c; c -= 256; if (c < 256) return 1920 + c; c -= 256;
    if (c < 144) return 2432 + c; c -= 144; if (c < 5504) return 2720 + c; c -= 5504; if (c < 1376) return 8224 + c; c -= 1376; return 10976 + c;
}
__device__ __forceinline__ int p0_remap_def(int layer, int c) {
    if (layer == 2) { if (c < 448) return 448 + c; c -= 448; if (c < 256) return 1664 + c; c -= 256; return 9600 + c; }
    if (c < 256) return 1152 + c; c -= 256; if (c < 256) return 2176 + c; c -= 256; if (c < 144) return 2576 + c; c -= 144; return 10288 + c;
}
static_assert(P0_NOW + P0_DEF2 + P0_DEF3 == P0_NTILES, "tile split");
struct P0Desc { const float* W; const float* gn; bf16* WT; int K, N, roff, tile, perm; };
struct Args;
__device__ __forceinline__ P0Desc p0_decode(int t, const float* const* in, unsigned char* wsb) {
    P0Desc d; d.gn = nullptr; d.roff = 0; d.perm = 0;
    if (t < P0_T0) { const int mi = t / 448; d.tile = t - mi * 448; d.W = in[13] + (size_t)mi * D * SGN; d.gn = in[8] + (2 * mi) * D; d.K = D; d.N = SGN; d.WT = (bf16*)(wsb + WS_WSGIN) + (size_t)mi * SGN * D; }
    else if (t < P0_T1) { t -= P0_T0; const int mi = t >> 8; d.tile = t & 255; d.W = in[18] + (size_t)mi * D * D; d.gn = in[8] + (2 * mi + 1) * D; d.K = D; d.N = D; d.WT = (bf16*)(wsb + WS_WSSMIN) + (size_t)mi * D * D; }
    else if (t < P0_T2) { t -= P0_T1; const int mi = t >> 8; d.tile = t & 255; d.W = in[14] + (size_t)mi * D * D; d.K = D; d.N = D; d.WT = (bf16*)(wsb + WS_WSGOUT) + (size_t)mi * D * D; }
    else if (t < P0_T3) { t -= P0_T2; const int mi = t >> 8; d.tile = t & 255; d.W = in[19] + (size_t)mi * D * D; d.K = D; d.N = D; d.WT = (bf16*)(wsb + WS_WSSMOUT) + (size_t)mi * D * D; }
    else if (t < P0_T4) { t -= P0_T3; const int mi = t / 144; d.tile = t - mi * 144; d.W = in[28] + (size_t)mi * TOKW * TOKW; d.K = TOKW; d.N = TOKW; d.WT = (bf16*)(wsb + WS_WGLU) + (size_t)mi * TOKW * TOKW; }
    else if (t < P0_T5) { t -= P0_T4; const int mi = t / 1376; d.tile = t - mi * 1376; d.W = in[30] + (size_t)mi * D * NUP; d.gn = in[9] + mi * D; d.K = D; d.N = NUP; d.WT = (bf16*)(wsb + WS_WUP) + (size_t)mi * NUP * D; d.perm = 1; }
    else if (t < P0_T6) { t -= P0_T5; const int mi = t / 688; d.tile = t - mi * 688; d.W = in[33] + (size_t)mi * DFF * D; d.K = DFF; d.N = D; d.WT = (bf16*)(wsb + WS_WDOWN) + (size_t)mi * D * DFF; }
    else { t -= P0_T6; const int mi = t >> 7; d.tile = t & 127; d.W = in[12] + (size_t)mi * D * 1024; d.gn = in[10] + mi * D; d.K = D; d.N = 1024; d.WT = (bf16*)(wsb + WS_WMEM); d.roff = mi * 1024; }
    return d;
}
__device__ __forceinline__ void p0_load(const P0Desc& d, f32x4 (&v)[8], float (&gv)[8], int tid) {
    const int nbn = d.N >> 7, kb = d.tile / nbn, nb = d.tile - kb * nbn; const float* p = d.W + (size_t)((kb << 7) + (tid >> 5)) * d.N + (nb << 7) + (tid & 31) * 4;
#pragma unroll
    for (int it = 0; it < 8; ++it) v[it] = __builtin_nontemporal_load((const f32x4*)(p + (size_t)(16 * it) * d.N));
    const float* gp = d.gn ? d.gn + (kb << 7) + (tid >> 5) : nullptr;
#pragma unroll
    for (int it = 0; it < 8; ++it) gv[it] = gp ? gp[16 * it] : 1.f;
}
__device__ __forceinline__ void p0_to_lds(const P0Desc& d, const f32x4 (&v)[8], const float (&gv)[8], LAS bf16* T, int tid) {
    const int kq = tid >> 5, n4 = (tid & 31) * 4;
#pragma unroll
    for (int it = 0; it < 8; ++it) { const int kk = kq + 16 * it; const float g = gv[it];
        LAS unsigned* p = (LAS unsigned*)(T + kk * P0_TLD + n4); p[0] = pk2(v[it][0] * g, v[it][1] * g); p[1] = pk2(v[it][2] * g, v[it][3] * g); }
}
__device__ __forceinline__ void p0_store(const P0Desc& d, const LAS bf16* T, int tid) {
    const int nbn = d.N >> 7, kb = d.tile / nbn, nb = d.tile - kb * nbn, k0 = kb << 7, n0 = (d.perm ? (nb < 43 ? 2 * nb : 2 * (nb - 43) + 1) : nb) << 7;
#pragma unroll
    for (int j = 0; j < 4; ++j) { const int p = tid + 512 * j, n = p >> 4, kg = p & 15; const LAS bf16* s_ = T + (kg * 8) * P0_TLD + n;
        v4u o; o.x = (unsigned)s_[0] | ((unsigned)s_[P0_TLD] << 16); o.y = (unsigned)s_[2 * P0_TLD] | ((unsigned)s_[3 * P0_TLD] << 16);
        o.z = (unsigned)s_[4 * P0_TLD] | ((unsigned)s_[5 * P0_TLD] << 16); o.w = (unsigned)s_[6 * P0_TLD] | ((unsigned)s_[7 * P0_TLD] << 16);
        __builtin_nontemporal_store(o, (v4u*)(d.WT + (size_t)(d.roff + n0 + n) * d.K + k0 + kg * 8)); }
}
__device__ __forceinline__ void p0_queue(LAS unsigned char* lds, volatile LAS unsigned* qw, unsigned* q, int layer, int ntiles, const float* const* in, unsigned char* ws, int tid) {
    LAS bf16* T0 = (LAS bf16*)lds; LAS bf16* T1 = (LAS bf16*)(lds + 128 * P0_TLD * 2); LAS bf16* T2 = (LAS bf16*)(lds + 2 * 128 * P0_TLD * 2);
    f32x4 v0[8], v1[8], v2[8]; float g0_[8], g1_[8], g2_[8]; P0Desc d0, d1, d2, e0, e1, e2;
    if (tid == 0) qw[0] = __hip_atomic_fetch_add(q, 3u, __ATOMIC_RELAXED, __HIP_MEMORY_SCOPE_AGENT);
    __syncthreads();
    int t = (int)qw[0];
    __syncthreads();
    d0 = p0_decode(p0_remap_def(layer, t < ntiles ? t : 0), in, ws); d1 = p0_decode(p0_remap_def(layer, t + 1 < ntiles ? t + 1 : 0), in, ws); d2 = p0_decode(p0_remap_def(layer, t + 2 < ntiles ? t + 2 : 0), in, ws);
    if (t < ntiles) p0_load(d0, v0, g0_, tid);
    if (t + 1 < ntiles) p0_load(d1, v1, g1_, tid);
    if (t + 2 < ntiles) p0_load(d2, v2, g2_, tid);
#pragma unroll 1
    while (t < ntiles) {
        const bool has1 = t + 1 < ntiles, has2 = t + 2 < ntiles; e0 = d0; e1 = d1; e2 = d2;
        p0_to_lds(d0, v0, g0_, T0, tid);
        if (tid == 0) qw[0] = __hip_atomic_fetch_add(q, 3u, __ATOMIC_RELAXED, __HIP_MEMORY_SCOPE_AGENT);
        __syncthreads();
        const int tn = (int)qw[0];
        if (tn < ntiles) { e0 = p0_decode(p0_remap_def(layer, tn), in, ws); p0_load(e0, v0, g0_, tid); }
        p0_store(d0, T0, tid);
        if (has1) p0_to_lds(d1, v1, g1_, T1, tid);
        __syncthreads();
        if (tn + 1 < ntiles) { e1 = p0_decode(p0_remap_def(layer, tn + 1), in, ws); p0_load(e1, v1, g1_, tid); }
        if (has1) p0_store(d1, T1, tid);
        if (has2) p0_to_lds(d2, v2, g2_, T2, tid);
        __syncthreads();
        if (tn + 2 < ntiles) { e2 = p0_decode(p0_remap_def(layer, tn + 2), in, ws); p0_load(e2, v2, g2_, tid); }
        if (has2) p0_store(d2, T2, tid);
        t = tn; d0 = e0; d1 = e1; d2 = e2;
    }
    __syncthreads();
}
__device__ __forceinline__ void p0_row(const float* src, float* dstf, bf16* dstb, ssq_t* ssp, int lane) {
    f32x4 v[8]; float s = 0.f;
#pragma unroll
    for (int j = 0; j < 8; ++j) { v[j] = src ? ((const f32x4*)src)[lane + 64 * j] : (f32x4){0.f, 0.f, 0.f, 0.f}; s += dot4(v[j]); }
    s = wave_sum(s);
#pragma unroll
    for (int j = 0; j < 8; ++j) { if (dstf) ((f32x4*)dstf)[lane + 64 * j] = v[j]; v2u w; w.x = pk2(v[j][0], v[j][1]); w.y = pk2(v[j][2], v[j][3]); ((v2u*)dstb)[lane + 64 * j] = w; }
    if (lane == 0) *ssp = ss_fix(s);
}
__device__ __forceinline__ void p0_row_load(const float* src, f32x4 (&v)[8], int lane) {
#pragma unroll
    for (int j = 0; j < 8; ++j) v[j] = ((const f32x4*)src)[lane + 64 * j];
}
__device__ __forceinline__ void p0_row_finish(const f32x4 (&vin)[8], bool zero, bf16* dstb, ssq_t* ssp, int lane) {
    float s = 0.f; f32x4 v[8];
#pragma unroll
    for (int j = 0; j < 8; ++j) { v[j] = zero ? (f32x4){0.f, 0.f, 0.f, 0.f} : vin[j]; s += dot4(v[j]); }
    s = wave_sum(s);
#pragma unroll
    for (int j = 0; j < 8; ++j) { v2u w; w.x = pk2(v[j][0], v[j][1]); w.y = pk2(v[j][2], v[j][3]); ((v2u*)dstb)[lane + 64 * j] = w; }
    if (lane == 0) *ssp = ss_fix(s);
}
__device__ __forceinline__ void s5_tables(LAS float* L, int j, int h, const float* lam_re, const float* lam_im, const float* log_dt, const float* b_re, const float* b_im,
                                          const float* c_re, const float* c_im, const float* dvec, bf16* TB, bf16* BT2, float* LBT, float* LB16, float* BBART, int tid) {
    LAS float* PWr = L; LAS float* PWi = L + 1088; LAS float* BBr = L + 2176; LAS float* BBi = L + 3200; LAS float* Cr = L + 4224; LAS float* Ci = L + 5312; LAS float* KM = L + 6400;
    const int gh = j * NGRP + h;
    if (tid < 64) {
        const int p = tid, idx = gh * 64 + p; const float lr = lam_re[idx], li = lam_im[idx], dt = expf(log_dt[gh]);
        const float ar = lr * dt, ai = li * dt, mag = expf(ar); float sn, cs; sincosf(ai, &sn, &cs);
        const float lbr = mag * cs, lbi = mag * sn; const float sh = sinf(0.5f * ai);
        const float nr = expm1f(ar) * cs - 2.f * sh * sh, ni = lbi, den = lr * lr + li * li;
        const float kr = (nr * lr + ni * li) / den, ki = (ni * lr - nr * li) / den;
        float pr = 1.f, pi = 0.f;
#pragma unroll
        for (int n = 0; n < 17; ++n) { PWr[p * 17 + n] = pr; PWi[p * 17 + n] = pi; if (n == 16) { LB16[idx * 2] = pr; LB16[idx * 2 + 1] = pi; } const float t = pr * lbr - pi * lbi; pi = pr * lbi + pi * lbr; pr = t; }
        LBT[idx * 2] = lbr; LBT[idx * 2 + 1] = lbi;
#pragma unroll
        for (int c = 0; c < 16; ++c) { const float br = b_re[(size_t)idx * 16 + c], bi = b_im[(size_t)idx * 16 + c]; const float xr = kr * br - ki * bi, xi = kr * bi + ki * br;
            BBr[p * 16 + c] = xr; BBi[p * 16 + c] = xi; BBART[((size_t)idx * 16 + c) * 2] = xr; BBART[((size_t)idx * 16 + c) * 2 + 1] = xi; }
    }
#pragma unroll
    for (int i = 0; i < 2; ++i) { const int e = tid + 512 * i, ci_ = (e & 63) * 17 + (e >> 6); Cr[ci_] = c_re[(size_t)gh * 1024 + e]; Ci[ci_] = c_im[(size_t)gh * 1024 + e]; }
    __syncthreads();
    {
        const int lane = tid & 63, w = tid >> 6, ci16 = lane & 15, kq = lane >> 4;
#pragma unroll 1
        for (int dd = 0; dd < 2; ++dd) {
            const int dl = 2 * w + dd; f32x4 acc = (f32x4){0.f, 0.f, 0.f, 0.f};
#pragma unroll 8
            for (int sblk = 0; sblk < 32; ++sblk) {
                const int k = 4 * sblk + kq, p = k & 63; const bool im = k >= 64;
                const float a = im ? -Ci[p * 17 + ci16] : Cr[p * 17 + ci16];
                const float wr_ = PWr[p * 17 + dl], wi_ = PWi[p * 17 + dl], xr = BBr[p * 16 + ci16], xi = BBi[p * 16 + ci16];
                const float b = im ? (wr_ * xi + wi_ * xr) : (wr_ * xr - wi_ * xi);
                acc = __builtin_amdgcn_mfma_f32_16x16x4f32(a, b, acc, 0, 0, 0);
            }
#pragma unroll
            for (int jj = 0; jj < 4; ++jj) { const int c = 4 * kq + jj; float v = acc[jj]; if (dl == 0 && c == ci16) v += dvec[j * TOKW + h * 16 + c]; KM[dl * 256 + c * 16 + ci16] = v; }
        }
    }
    __syncthreads();
#pragma unroll 1
    for (int it = 0; it < 24; ++it) {
        const int grp = tid + 512 * it, row = grp / 48, cg = grp % 48, tau = row >> 4, c = row & 15; float v[8];
        if (cg < 32) { const int sg = cg >> 1, c0 = (cg & 1) * 8;
#pragma unroll
            for (int i = 0; i < 8; ++i) v[i] = sg <= tau ? KM[(tau - sg) * 256 + c * 16 + c0 + i] : 0.f; }
        else if (cg < 40) {
#pragma unroll
            for (int i = 0; i < 8; ++i) { const int p = (cg - 32) * 8 + i; v[i] = Cr[p * 17 + c] * PWr[p * 17 + tau + 1] - Ci[p * 17 + c] * PWi[p * 17 + tau + 1]; } }
        else {
#pragma unroll
            for (int i = 0; i < 8; ++i) { const int p = (cg - 40) * 8 + i; v[i] = -(Cr[p * 17 + c] * PWi[p * 17 + tau + 1] + Ci[p * 17 + c] * PWr[p * 17 + tau + 1]); } }
        v4u w; w.x = pk2(v[0], v[1]); w.y = pk2(v[2], v[3]); w.z = pk2(v[4], v[5]); w.w = pk2(v[6], v[7]);
        *(v4u*)(TB + ((size_t)gh * 256 + row) * KH + cg * 8) = w;
    }
#pragma unroll 1
    for (int it = 0; it < 8; ++it) {
        const int grp = tid + 512 * it, row = grp >> 5, cg = grp & 31, ri = row >> 6, p = row & 63, n = 15 - (cg >> 1), c0 = (cg & 1) * 8; float v[8];
        const float wr_ = PWr[p * 17 + n], wi_ = PWi[p * 17 + n];
#pragma unroll
        for (int i = 0; i < 8; ++i) { const float xr = BBr[p * 16 + c0 + i], xi = BBi[p * 16 + c0 + i]; v[i] = ri == 0 ? (wr_ * xr - wi_ * xi) : (wr_ * xi + wi_ * xr); }
        v4u w; w.x = pk2(v[0], v[1]); w.y = pk2(v[2], v[3]); w.z = pk2(v[4], v[5]); w.w = pk2(v[6], v[7]);
        *(v4u*)(BT2 + ((size_t)gh * 128 + row) * 256 + cg * 8) = w;
    }
    __syncthreads();
}

typedef short s4v __attribute__((ext_vector_type(4)));
constexpr int KS_LD = 136, VT_LD = 144, VT_OFF = 256 * KS_LD * 2;
__device__ __forceinline__ void attn_prompt_unit(LAS unsigned char* lds, const bf16* q, const bf16* mkv_l, bf16* mix, int unit, int tid) {
    const int b = unit >> 6, hd = (unit >> 4) & 3, qb = unit & 15, lane = tid & 63, w = tid >> 6, fr = lane & 15, fq = lane >> 4;
    LAS bf16* Ks = (LAS bf16*)lds; LAS bf16* Vt = (LAS bf16*)(lds + VT_OFF);
    const bf16* kvb = mkv_l + (size_t)(b * 256) * 1024 + hd * 128;
#pragma unroll
    for (int it = 0; it < 8; ++it) { const int id = tid + 512 * it, key = id >> 4, part = id & 15;
        const v4u kw = *(const v4u*)(kvb + (size_t)key * 1024 + part * 8); *(LAS v4u*)(Ks + key * KS_LD + part * 8) = kw;
        const v4u vw = *(const v4u*)(kvb + (size_t)key * 1024 + 512 + part * 8); *(LAS v4u*)(Vt + key * VT_LD + part * 8) = vw; }
    const int r = b * SEQ + qb * 128 + w * 16 + fr;
    bf16x8 qf[4];
#pragma unroll
    for (int ks = 0; ks < 4; ++ks) qf[ks] = *(const bf16x8*)(q + (size_t)r * XAW + hd * 128 + ks * 32 + fq * 8);
    __syncthreads();
    f32x4 s[16];
#pragma unroll
    for (int t = 0; t < 16; ++t) { s[t] = (f32x4){0.f, 0.f, 0.f, 0.f};
#pragma unroll
        for (int ks = 0; ks < 4; ++ks) { const bf16x8 kf = *(const LAS bf16x8*)(Ks + (t * 16 + fr) * KS_LD + ks * 32 + fq * 8); s[t] = __builtin_amdgcn_mfma_f32_16x16x32_bf16(kf, qf[ks], s[t], 0, 0, 0); } }
    float mx = -3.0e38f;
#pragma unroll
    for (int t = 0; t < 16; ++t) mx = fmaxf(fmaxf(fmaxf(s[t][0], s[t][1]), fmaxf(s[t][2], s[t][3])), mx);
    mx = fmaxf(mx, __shfl_xor(mx, 16)); mx = fmaxf(mx, __shfl_xor(mx, 32));
    const float sc = 0.08838834764831845f * 1.4426950408889634f; float sum = 0.f;
#pragma unroll
    for (int t = 0; t < 16; ++t) {
#pragma unroll
        for (int jj = 0; jj < 4; ++jj) { const float p = __builtin_amdgcn_exp2f((s[t][jj] - mx) * sc); s[t][jj] = p; sum += p; } }
    sum += __shfl_xor(sum, 16); sum += __shfl_xor(sum, 32);
    f32x4 o[8];
#pragma unroll
    for (int dt = 0; dt < 8; ++dt) o[dt] = (f32x4){0.f, 0.f, 0.f, 0.f};
#pragma unroll
    for (int kk = 0; kk < 8; ++kk) {
        v4u pw; pw.x = pk2(s[2 * kk][0], s[2 * kk][1]); pw.y = pk2(s[2 * kk][2], s[2 * kk][3]); pw.z = pk2(s[2 * kk + 1][0], s[2 * kk + 1][1]); pw.w = pk2(s[2 * kk + 1][2], s[2 * kk + 1][3]);
        const bf16x8 pf = __builtin_bit_cast(bf16x8, pw);
#pragma unroll
        for (int dt = 0; dt < 8; ++dt) { const LAS bf16* vp = Vt + (kk * 32 + fq * 4 + (fr >> 2)) * VT_LD + dt * 16 + (fr & 3) * 4;
            const v2u lo2 = __builtin_bit_cast(v2u, __builtin_amdgcn_ds_read_tr16_b64_v4i16((LAS s4v*)vp));
            const v2u hi2 = __builtin_bit_cast(v2u, __builtin_amdgcn_ds_read_tr16_b64_v4i16((LAS s4v*)(vp + 16 * VT_LD)));
            v4u vw; vw.x = lo2.x; vw.y = lo2.y; vw.z = hi2.x; vw.w = hi2.y;
            o[dt] = __builtin_amdgcn_mfma_f32_16x16x32_bf16(__builtin_bit_cast(bf16x8, vw), pf, o[dt], 0, 0, 0); } }
    const float inv = 1.f / sum;
#pragma unroll
    for (int dt = 0; dt < 8; ++dt) { v2u w2; w2.x = pk2(o[dt][0] * inv, o[dt][1] * inv); w2.y = pk2(o[dt][2] * inv, o[dt][3] * inv);
        *(v2u*)(mix + (size_t)r * D + TOKW + hd * 128 + dt * 16 + fq * 4) = w2; }
    __syncthreads();
}
template <int N> __device__ __forceinline__ float dpp_ror(float v) { return __builtin_bit_cast(float, __builtin_amdgcn_update_dpp(0, __builtin_bit_cast(int, v), 0x120 + N, 0xf, 0xf, false)); }
__device__ __forceinline__ float row16_sum(float d) { d += dpp_ror<8>(d); d += dpp_ror<4>(d); d += dpp_ror<2>(d); d += dpp_ror<1>(d); return d; }
__device__ __forceinline__ void attn_sample_unit(LAS unsigned char* lds, const bf16* q, const float* ck, const float* cv, bf16* mix, int li, int unit, int tid) {
    const int b = unit >> 1, hp = unit & 1, lane = tid & 63, w = tid >> 6, hd = 2 * hp + (w >> 2), kq = (w & 3) * 64, dd = lane & 15, kg = lane >> 4;
    LAS float* red = (LAS float*)lds;
    const v4u qw = *(const v4u*)(q + (size_t)(MP + b) * XAW + hd * 128 + dd * 8);
    const float qv[8] = {bflo(qw.x), bfhi(qw.x), bflo(qw.y), bfhi(qw.y), bflo(qw.z), bfhi(qw.z), bflo(qw.w), bfhi(qw.w)};
    const size_t base = ((size_t)(li * MS + b) * 256) * 512 + hd * 128 + dd * 8 + (size_t)(kq + kg) * 512;
    const float* kp = ck + base; const float* vp = cv + base;
    f32x4 kr[16][2];
#pragma unroll
    for (int it = 0; it < 16; ++it) { kr[it][0] = *(const f32x4*)(kp + (size_t)it * 2048); kr[it][1] = *(const f32x4*)(kp + (size_t)it * 2048 + 4); }
    __builtin_amdgcn_sched_barrier(0);
    float sc[16];
#pragma unroll
    for (int it = 0; it < 16; ++it) { const f32x4 k0 = kr[it][0], k1 = kr[it][1];
        sc[it] = row16_sum(qv[0] * k0[0] + qv[1] * k0[1] + qv[2] * k0[2] + qv[3] * k0[3] + qv[4] * k1[0] + qv[5] * k1[1] + qv[6] * k1[2] + qv[7] * k1[3]); }
    __builtin_amdgcn_sched_barrier(0);
    f32x4 vr[16][2];
#pragma unroll
    for (int it = 0; it < 16; ++it) { vr[it][0] = *(const f32x4*)(vp + (size_t)it * 2048); vr[it][1] = *(const f32x4*)(vp + (size_t)it * 2048 + 4); }
    __builtin_amdgcn_sched_barrier(0);
    float mx = sc[0];
#pragma unroll
    for (int it = 1; it < 16; ++it) mx = fmaxf(mx, sc[it]);
    mx = fmaxf(mx, __shfl_xor(mx, 16)); mx = fmaxf(mx, __shfl_xor(mx, 32));
    if (lane == 0) red[w] = mx;
    __syncthreads();
    const int w0 = w & 4; mx = fmaxf(fmaxf(red[w0], red[w0 + 1]), fmaxf(red[w0 + 2], red[w0 + 3]));
    const float scl = 0.08838834764831845f * 1.4426950408889634f; float sum = 0.f;
    float oacc[8] = {0.f, 0.f, 0.f, 0.f, 0.f, 0.f, 0.f, 0.f};
#pragma unroll
    for (int it = 0; it < 16; ++it) { const float p = __builtin_amdgcn_exp2f((sc[it] - mx) * scl); sum += p; const f32x4 v0 = vr[it][0], v1 = vr[it][1];
        oacc[0] += p * v0[0]; oacc[1] += p * v0[1]; oacc[2] += p * v0[2]; oacc[3] += p * v0[3]; oacc[4] += p * v1[0]; oacc[5] += p * v1[1]; oacc[6] += p * v1[2]; oacc[7] += p * v1[3]; }
    sum += __shfl_xor(sum, 16); sum += __shfl_xor(sum, 32);
#pragma unroll
    for (int i = 0; i < 8; ++i) { oacc[i] += __shfl_xor(oacc[i], 16); oacc[i] += __shfl_xor(oacc[i], 32); }
    if (lane == 0) red[8 + w] = sum;
    if (lane < 16) {
#pragma unroll
        for (int i = 0; i < 8; ++i) red[16 + w * 128 + dd * 8 + i] = oacc[i]; }
    __syncthreads();
    if ((w & 3) == 0 && lane < 16) {
        const float tot = (red[8 + w] + red[9 + w]) + (red[10 + w] + red[11 + w]), inv = 1.f / tot; float o[8];
#pragma unroll
        for (int i = 0; i < 8; ++i) o[i] = ((red[16 + w * 128 + dd * 8 + i] + red[16 + (w + 1) * 128 + dd * 8 + i]) + (red[16 + (w + 2) * 128 + dd * 8 + i] + red[16 + (w + 3) * 128 + dd * 8 + i])) * inv;
        v4u ow; ow.x = pk2(o[0], o[1]); ow.y = pk2(o[2], o[3]); ow.z = pk2(o[4], o[5]); ow.w = pk2(o[6], o[7]);
        *(v4u*)(mix + (size_t)(MP + b) * D + TOKW + hd * 128 + dd * 8) = ow;
    }
    __syncthreads();
}

constexpr int SG_LD = 136;
__device__ __forceinline__ void sg_unit(LAS unsigned char* lds, const bf16* zu, const bf16* zv, const ssq_t* ssv, const float* g_v, const bf16* wsb, const float* b_s, bf16* mix, int unit, int tid) {
    const int ch = unit / 12, g = unit % 12, row0 = ch * 128, lane = tid & 63, w = tid >> 6, fr = lane & 15, fq = lane >> 4;
    LAS bf16* Vt = (LAS bf16*)lds;
    { const int s = tid & 127, dq = tid >> 7; const float rsv = rstd_of(ssv[row0 + s], 1.f / 1536.f);
#pragma unroll
      for (int it = 0; it < 4; ++it) { const int d0 = (dq + 4 * it) * 8; const v4u vw = *(const v4u*)(zv + (size_t)(row0 + s) * TOKW + g * 128 + d0);
          const f32x4 g0 = *(const f32x4*)(g_v + g * 128 + d0), g1 = *(const f32x4*)(g_v + g * 128 + d0 + 4);
          const unsigned a = pk2(bflo(vw.x) * rsv * g0[0], bfhi(vw.x) * rsv * g0[1]), b2 = pk2(bflo(vw.y) * rsv * g0[2], bfhi(vw.y) * rsv * g0[3]),
                         c2 = pk2(bflo(vw.z) * rsv * g1[0], bfhi(vw.z) * rsv * g1[1]), e2 = pk2(bflo(vw.w) * rsv * g1[2], bfhi(vw.w) * rsv * g1[3]);
          LAS bf16* vp = Vt + d0 * SG_LD + s;
          vp[0] = (bf16)(a & 0xffff); vp[SG_LD] = (bf16)(a >> 16); vp[2 * SG_LD] = (bf16)(b2 & 0xffff); vp[3 * SG_LD] = (bf16)(b2 >> 16);
          vp[4 * SG_LD] = (bf16)(c2 & 0xffff); vp[5 * SG_LD] = (bf16)(c2 >> 16); vp[6 * SG_LD] = (bf16)(e2 & 0xffff); vp[7 * SG_LD] = (bf16)(e2 >> 16); } }
    const int nks = (w >> 1) + 1;
    bf16x8 wf[4];
#pragma unroll
    for (int ks = 0; ks < 4; ++ks) wf[ks] = *(const bf16x8*)(wsb + ((size_t)g * 128 + w * 16 + fr) * 128 + ks * 32 + fq * 8);
    __syncthreads();
    f32x4 acc[8];
#pragma unroll
    for (int dt = 0; dt < 8; ++dt) { acc[dt] = (f32x4){0.f, 0.f, 0.f, 0.f};
#pragma unroll
        for (int ks = 0; ks < 4; ++ks) if (ks < nks) { const bf16x8 vf = *(const LAS bf16x8*)(Vt + (dt * 16 + fr) * SG_LD + ks * 32 + fq * 8); acc[dt] = __builtin_amdgcn_mfma_f32_16x16x32_bf16(vf, wf[ks], acc[dt], 0, 0, 0); } }
    const int t = w * 16 + fr, r = row0 + t; const float bias = b_s[g * 128 + t];
#pragma unroll
    for (int dt = 0; dt < 8; ++dt) { const int c = g * 128 + dt * 16 + fq * 4; const v2u uw = *(const v2u*)(zu + (size_t)r * TOKW + c);
        v2u ow; ow.x = pk2(bflo(uw.x) * (acc[dt][0] + bias), bfhi(uw.x) * (acc[dt][1] + bias)); ow.y = pk2(bflo(uw.y) * (acc[dt][2] + bias), bfhi(uw.y) * (acc[dt][3] + bias));
        *(v2u*)(mix + (size_t)r * D + c) = ow; }
    __syncthreads();
}

__device__ __forceinline__ void s5_state_task(LAS unsigned char* lds, bf16* uh, const bf16* bt2_l, const float* lb16_l, float* out, int j, int task, int tid) {
    const int b = task / NGRP, h = task % NGRP, lane = tid & 63, w = tid >> 6, fr = lane & 15, fq = lane >> 4;
    LAS float* S = (LAS float*)lds;
    bf16x8 af[8];
    const bf16* ap = uh + ((size_t)(h * 512 + b * 128 + w * 16 + fr)) * KH + fq * 8;
#pragma unroll
    for (int ks = 0; ks < 8; ++ks) af[ks] = *(const bf16x8*)(ap + ks * 32);
#pragma unroll
    for (int nt = 0; nt < 8; ++nt) { f32x4 acc = (f32x4){0.f, 0.f, 0.f, 0.f}; const bf16* bp = bt2_l + ((size_t)(h * 128 + nt * 16 + fr)) * 256 + fq * 8;
#pragma unroll
        for (int ks = 0; ks < 8; ++ks) { const bf16x8 bf = *(const bf16x8*)(bp + ks * 32); acc = __builtin_amdgcn_mfma_f32_16x16x32_bf16(af[ks], bf, acc, 0, 0, 0); }
#pragma unroll
        for (int jj = 0; jj < 4; ++jj) S[(w * 16 + fq * 4 + jj) * 129 + nt * 16 + fr] = acc[jj]; }
    __syncthreads();
    {
        const int p = lane; const float lr = lb16_l[(h * 64 + p) * 2], li = lb16_l[(h * 64 + p) * 2 + 1];
        LAS float* Tb = S + 128 * 129;
        float tr = 0.f, ti = 0.f;
#pragma unroll
        for (int k = 0; k < 16; ++k) { const int m = w * 16 + k; const float sr = S[m * 129 + p], si = S[m * 129 + 64 + p]; const float t = lr * tr - li * ti + sr; ti = lr * ti + li * tr + si; tr = t; }
        Tb[w * 128 + p] = tr; Tb[w * 128 + 64 + p] = ti;
        float Lr = lr, Li = li;
#pragma unroll
        for (int q = 0; q < 4; ++q) { const float t = Lr * Lr - Li * Li; Li = 2.f * Lr * Li; Lr = t; }
        __syncthreads();
        float hr = 0.f, hi = 0.f;
        for (int w2 = 0; w2 < w; ++w2) { const float t = Lr * hr - Li * hi + Tb[w2 * 128 + p]; hi = Lr * hi + Li * hr + Tb[w2 * 128 + 64 + p]; hr = t; }
        bf16* up = uh + ((size_t)(h * 512 + b * 128 + w * 16)) * KH + 256 + p;
#pragma unroll
        for (int k = 0; k < 16; ++k) { const int m = w * 16 + k; up[(size_t)k * KH] = (bf16)(pk2(hr, 0.f) & 0xffff); up[(size_t)k * KH + 64] = (bf16)(pk2(hi, 0.f) & 0xffff);
            const float sr = S[m * 129 + p], si = S[m * 129 + 64 + p]; const float t = lr * hr - li * hi + sr; hi = lr * hi + li * hr + si; hr = t; }
        if (w == 7) { out[OFF_SRP + ((size_t)(j * 4 + b) * NGRP + h) * 64 + p] = hr; out[OFF_SIP + ((size_t)(j * 4 + b) * NGRP + h) * 64 + p] = hi; }
    }
    __syncthreads();
}
__device__ __forceinline__ void s5_sample_task(const float* us, const float* st_re, const float* st_im, const float* lbt_l, const float* bbar_l, const float* c_re_l, const float* c_im_l, const float* d_l,
                                               float* out, bf16* yb, int j, int task, int lane) {
    const int h = task >> 4, b0 = (task & 15) * 8, p = lane, co = lane >> 2;
    float bbr[16], bbi[16], cr[16], ci[16];
    const float* bb = bbar_l + ((size_t)(h * 64 + p)) * 32;
#pragma unroll
    for (int c2 = 0; c2 < 8; ++c2) { const f32x4 t = *(const f32x4*)(bb + c2 * 4); bbr[2 * c2] = t[0]; bbi[2 * c2] = t[1]; bbr[2 * c2 + 1] = t[2]; bbi[2 * c2 + 1] = t[3]; }
#pragma unroll
    for (int c = 0; c < 16; ++c) { cr[c] = c_re_l[((size_t)(h * 16 + c)) * 64 + p]; ci[c] = c_im_l[((size_t)(h * 16 + c)) * 64 + p]; }
    const float lr = lbt_l[(h * 64 + p) * 2], li = lbt_l[(h * 64 + p) * 2 + 1], dd = d_l[h * 16 + co];
    const bool b5 = (lane & 32) != 0, b4 = (lane & 16) != 0, b3 = (lane & 8) != 0, b2 = (lane & 4) != 0;
#pragma unroll 1
    for (int bi_ = 0; bi_ < 8; ++bi_) {
        const int b = b0 + bi_; float u[16];
#pragma unroll
        for (int c4 = 0; c4 < 4; ++c4) { const f32x4 t = *(const f32x4*)(us + (size_t)b * TOKW + h * 16 + c4 * 4); u[c4 * 4] = t[0]; u[c4 * 4 + 1] = t[1]; u[c4 * 4 + 2] = t[2]; u[c4 * 4 + 3] = t[3]; }
        const float uco = us[(size_t)b * TOKW + h * 16 + co];
        float xr = 0.f, xi = 0.f;
#pragma unroll
        for (int c = 0; c < 16; ++c) { xr += bbr[c] * u[c]; xi += bbi[c] * u[c]; }
        const size_t si_ = ((size_t)(j * MS + b) * NGRP + h) * 64 + p; const float s0r = st_re[si_], s0i = st_im[si_];
        const float hr = lr * s0r - li * s0i + xr, hi = lr * s0i + li * s0r + xi;
        out[OFF_SRS + si_] = hr; out[OFF_SIS + si_] = hi;
        float w8[8], w4[4], w2[2], w1;
#pragma unroll
        for (int i = 0; i < 8; ++i) { const float va = cr[i] * hr - ci[i] * hi, vb = cr[i + 8] * hr - ci[i + 8] * hi; w8[i] = (b5 ? vb : va) + __shfl_xor(b5 ? va : vb, 32); }
#pragma unroll
        for (int i = 0; i < 4; ++i) w4[i] = (b4 ? w8[i + 4] : w8[i]) + __shfl_xor(b4 ? w8[i] : w8[i + 4], 16);
#pragma unroll
        for (int i = 0; i < 2; ++i) w2[i] = (b3 ? w4[i + 2] : w4[i]) + __shfl_xor(b3 ? w4[i] : w4[i + 2], 8);
        w1 = (b2 ? w2[1] : w2[0]) + __shfl_xor(b2 ? w2[0] : w2[1], 4);
        w1 += __shfl_xor(w1, 2); w1 += __shfl_xor(w1, 1);
        const float yv = w1 + dd * uco;
        if ((lane & 3) == 0) yb[(size_t)(MP + b) * TOKW + h * 16 + co] = (bf16)(pk2(gelu_t(yv), 0.f) & 0xffff);
    }
}

struct SEpiRes {
    bf16* xb; ssq_t* ssn;
    __device__ __forceinline__ void operator()(f32x4 v, int m, int c) const {
        const int r = MP + m; bf16* bp = xb + (size_t)r * D + c; const v2u xw = *(const v2u*)bp; const f32x4 o = (f32x4){bflo(xw.x), bfhi(xw.x), bflo(xw.y), bfhi(xw.y)} + v;
        v2u w; w.x = pk2(o[0], o[1]); w.y = pk2(o[2], o[3]); *(v2u*)bp = w;
        float sq = dot4(o); sq += __shfl_xor(sq, 1); sq += __shfl_xor(sq, 2); sq += __shfl_xor(sq, 4); if ((tid_now() & 7) == 0) fadd_atomic(ssn + r, sq);
    }
};
struct SEpiSsmIn {
    const ssq_t* ss; float* us; bf16* q;
    __device__ __forceinline__ void operator()(f32x4 v, int m, int c) const {
        const int r = MP + m; v = v * rstd_of(ss[r], 1.f / 2048.f);
        if (c < TOKW) *(f32x4*)(us + (size_t)m * TOKW + c) = v;
        else { v2u w; w.x = pk2(v[0], v[1]); w.y = pk2(v[2], v[3]); *(v2u*)(q + (size_t)r * XAW + (c - TOKW)) = w; }
    }
};
template <class SEpi>
__device__ __forceinline__ void skinny_sample(LAS unsigned char* lds, const bf16* As, const bf16* Bt, int K, const SEpi& E, int blk, int tid) {
    if (blk >= 256) return;
    const int lane = tid & 63, w = __builtin_amdgcn_readfirstlane(tid >> 6), fr = lane & 15, fq = lane >> 4, m0 = (blk & 3) * 32, n0 = (blk >> 2) * 32;
    f32x4 acc[2][2];
#pragma unroll
    for (int a = 0; a < 2; ++a)
#pragma unroll
        for (int b = 0; b < 2; ++b) acc[a][b] = (f32x4){0.f, 0.f, 0.f, 0.f};
    const int nks = K >> 5; const bf16* bp = Bt + (size_t)(n0 + fr) * K + fq * 8; const bf16* ap = As + (size_t)(m0 + fr) * K + fq * 8; const size_t r16 = (size_t)16 * K;
#pragma unroll 8
    for (int ks = w; ks < nks; ks += 8) {
        const bf16x8 b0 = *(const bf16x8*)(bp + ks * 32), b1 = *(const bf16x8*)(bp + r16 + ks * 32), a0 = *(const bf16x8*)(ap + ks * 32), a1 = *(const bf16x8*)(ap + r16 + ks * 32);
        acc[0][0] = __builtin_amdgcn_mfma_f32_16x16x32_bf16(b0, a0, acc[0][0], 0, 0, 0); acc[0][1] = __builtin_amdgcn_mfma_f32_16x16x32_bf16(b1, a0, acc[0][1], 0, 0, 0);
        acc[1][0] = __builtin_amdgcn_mfma_f32_16x16x32_bf16(b0, a1, acc[1][0], 0, 0, 0); acc[1][1] = __builtin_amdgcn_mfma_f32_16x16x32_bf16(b1, a1, acc[1][1], 0, 0, 0);
    }
    LAS float* red = (LAS float*)lds;
#pragma unroll
    for (int a = 0; a < 2; ++a)
#pragma unroll
        for (int b = 0; b < 2; ++b) *(LAS f32x4*)(red + ((w * 32 + a * 16 + fr) * 32 + b * 16 + fq * 4)) = acc[a][b];
    __syncthreads();
    if (tid < 256) {
        const int m = tid >> 3, nq = (tid & 7) * 4; f32x4 sum = *(const LAS f32x4*)(red + (m * 32 + nq));
#pragma unroll
        for (int w2 = 1; w2 < 8; ++w2) sum += *(const LAS f32x4*)(red + ((w2 * 32 + m) * 32 + nq));
        E(sum, m0 + m, n0 + nq);
    }
    __syncthreads();
}

#define RLX_AGENT __ATOMIC_RELAXED, __HIP_MEMORY_SCOPE_AGENT
struct Args { const float* in[34]; float* out; unsigned char* ws; int lo, hi; };
__global__ void __launch_bounds__(NTHR, 2) trunk_fwd(Args args) {
    extern __shared__ __attribute__((aligned(16))) unsigned char lds_raw[];
    LAS unsigned char* lds = (LAS unsigned char*)lds_raw;
    volatile LAS unsigned* MISC = (volatile LAS unsigned*)(lds + MISC_OFF);
    const int G = gridDim.x, blk = blockIdx.x;
    const Args* ap = &args;
#define ws (ap->ws)
#define out (ap->out)
#define x_prompt (ap->in[0])
#define x_sample (ap->in[1])
#define mem_prompt (ap->in[2])
#define cache_k (ap->in[3])
#define cache_v (ap->in[4])
#define st_re (ap->in[5])
#define st_im (ap->in[6])
#define st_conv (ap->in[7])
#define g_mix (ap->in[8])
#define g_ffn (ap->in[9])
#define g_mem (ap->in[10])
#define g_final (ap->in[11])
#define w_mem_kv (ap->in[12])
#define sg_w_in (ap->in[13])
#define sg_w_out (ap->in[14])
#define sg_g_v (ap->in[15])
#define sg_w_s (ap->in[16])
#define sg_b_s (ap->in[17])
#define ssm_w_in (ap->in[18])
#define ssm_w_out (ap->in[19])
#define lam_re (ap->in[20])
#define lam_im (ap->in[21])
#define log_dt (ap->in[22])
#define b_re (ap->in[23])
#define b_im (ap->in[24])
#define c_re (ap->in[25])
#define c_im (ap->in[26])
#define ssm_d (ap->in[27])
#define w_glu (ap->in[28])
#define b_glu (ap->in[29])
#define w_up (ap->in[30])
#define conv_w (ap->in[31])
#define conv_b (ap->in[32])
#define w_down (ap->in[33])
#define ctl ((unsigned*)(ws + WS_CTL))
#define SSX ((ssq_t*)(ws + CTL_SSX))
#define ss_mix (SSX + (size_t)(2 * li) * MT)
#define ss_ffn (SSX + (size_t)(2 * li + 1) * MT)
#define ss_next (SSX + (size_t)(2 * li + 2) * MT)
#define mkv_l (MKV + (size_t)li * 1024 * 1024)
#define SSV ((ssq_t*)(ws + CTL_SSV))
#define SSMEM ((ssq_t*)(ws + CTL_SSMEM))
#define W_SGIN ((bf16*)(ws + WS_WSGIN))
#define W_SSMIN ((bf16*)(ws + WS_WSSMIN))
#define W_SGOUT ((bf16*)(ws + WS_WSGOUT))
#define W_SSMOUT ((bf16*)(ws + WS_WSSMOUT))
#define W_GLU ((bf16*)(ws + WS_WGLU))
#define W_UP ((bf16*)(ws + WS_WUP))
#define W_DOWN ((bf16*)(ws + WS_WDOWN))
#define W_MEM ((bf16*)(ws + WS_WMEM))
#define WSB ((bf16*)(ws + WS_WSB))
#define TB ((bf16*)(ws + WS_TB))
#define BT2 ((bf16*)(ws + WS_BT2))
#define LBT ((float*)(ws + WS_LBT))
#define LB16 ((float*)(ws + WS_LB16))
#define BBART ((float*)(ws + WS_BBAR))
#define XRES ((float*)(ws + WS_XRES))
#define XB ((bf16*)(ws + WS_XB))
#define MEMB ((bf16*)(ws + WS_MEMB))
#define MKV ((bf16*)(ws + WS_MKV))
#define ZU ((bf16*)(ws + WS_ZU))
#define ZV ((bf16*)(ws + WS_ZV))
#define QB ((bf16*)(ws + WS_Q))
#define MIX ((bf16*)(ws + WS_MIX))
#define AG ((bf16*)(ws + WS_AG))
#define YF ((bf16*)(ws + WS_Y))
#define UH ((bf16*)(ws + WS_UH))
#define YB ((bf16*)(ws + WS_YB))
#define US ((float*)(ws + WS_US))
#define FXA ((float*)(ws + WS_FXA))
#define FXG ((float*)(ws + WS_FXG))
    for (int u = threadIdx.x; u < 128; u += NTHR) MISC[u] = 0u;
    __syncthreads();
    XcdBarrier bar = xcd_barrier_post(ctl + CW_BAR, MISC + 8);
    const int lo = args.lo, hi = args.hi; int ph = 0;
#ifndef PHM
#define PHM 0xFFFFFFFFu
#endif
#ifndef DUPM
#define DUPM 0u
#endif
#ifndef DUPX
#define DUPX 0u
#endif
#ifndef DUPSUB
#define DUPSUB 0u
#endif
#define SUBREP(k) for (int srep_ = 0; srep_ < (((DUPSUB >> (k)) & 1u) ? 2 : 1); ++srep_)
#define PH_BEGIN(k) if (((PHM >> (k)) & 1u) && ph >= lo && ph < hi) for (int rep_ = 0; rep_ < (((DUPM >> (k)) & 1u) ? 2 : 1); ++rep_) { unsigned z_; asm volatile("s_mov_b32 %0, 0" : "=s"(z_)); const Args* ap = (const Args*)((const char*)&args + z_); int blk_l_ = blockIdx.x; asm volatile("" : "+s"(blk_l_)); const int blk = blk_l_; int tid = threadIdx.x; asm volatile("" : "+v"(tid)); const int lane = tid & 63, wave = __builtin_amdgcn_readfirstlane(tid >> 6); const int gw = blk * NWAVES + wave, NGW = G * NWAVES, gtid = blk * NTHR + tid, NT = G * NTHR; (void)lane; (void)gw; (void)NGW; (void)gtid; (void)NT;
#ifdef PROBE_K1
    unsigned long long tprev_ = __builtin_amdgcn_s_memrealtime(), d1_ = 0ull, d2_ = 0ull;
#define PH_END do { if (ph >= lo && ph + 1 < hi) xcd_barrier(bar); { const unsigned long long tn_ = __builtin_amdgcn_s_memrealtime(); if (ph == PROBE_K1) d1_ = tn_ - tprev_; if (ph == PROBE_K2) d2_ = tn_ - tprev_; tprev_ = tn_; } ++ph; } while (0)
#else
#define PH_END do { if (ph >= lo && ph + 1 < hi) xcd_barrier(bar); ++ph; } while (0)
#endif

    PH_BEGIN(0)
        {
            LAS bf16* T0 = (LAS bf16*)lds; LAS bf16* T1 = (LAS bf16*)(lds + 128 * P0_TLD * 2); LAS bf16* T2 = (LAS bf16*)(lds + 2 * 128 * P0_TLD * 2);
            f32x4 v0[8], v1[8], v2[8]; float g0_[8], g1_[8], g2_[8]; int t = blk; P0Desc d0, d1, d2, e0, e1, e2;
            d0 = p0_decode(p0_remap_now(t < P0_NOW ? t : 0), ap->in, ws); d1 = p0_decode(p0_remap_now(t + G < P0_NOW ? t + G : 0), ap->in, ws); d2 = p0_decode(p0_remap_now(t + 2 * G < P0_NOW ? t + 2 * G : 0), ap->in, ws);
            if (t < P0_NOW) p0_load(d0, v0, g0_, tid);
            if (t + G < P0_NOW) p0_load(d1, v1, g1_, tid);
            if (t + 2 * G < P0_NOW) p0_load(d2, v2, g2_, tid);
#pragma unroll 1
            while (t < P0_NOW) {
                const bool has1 = t + G < P0_NOW, has2 = t + 2 * G < P0_NOW; const int tn = t + 3 * G; e0 = d0; e1 = d1; e2 = d2;
                p0_to_lds(d0, v0, g0_, T0, tid);
                __syncthreads();
                if (tn < P0_NOW) { e0 = p0_decode(p0_remap_now(tn), ap->in, ws); p0_load(e0, v0, g0_, tid); }
                p0_store(d0, T0, tid);
                if (has1) p0_to_lds(d1, v1, g1_, T1, tid);
                __syncthreads();
                if (tn + G < P0_NOW) { e1 = p0_decode(p0_remap_now(tn + G), ap->in, ws); p0_load(e1, v1, g1_, tid); }
                if (has1) p0_store(d1, T1, tid);
                if (has2) p0_to_lds(d2, v2, g2_, T2, tid);
                __syncthreads();
                if (tn + 2 * G < P0_NOW) { e2 = p0_decode(p0_remap_now(tn + 2 * G), ap->in, ws); p0_load(e2, v2, g2_, tid); }
                if (has2) p0_store(d2, T2, tid);
                t = tn; d0 = e0; d1 = e1; d2 = e2;
            }
            __syncthreads();
        }
        {
            auto rsrc = [&](int r) -> const float* { return r < MP ? x_prompt + (size_t)r * D : (r < MREAL ? x_sample + (size_t)(r - MP) * D : (r < MT ? x_prompt : mem_prompt + (size_t)(r - MT) * D)); };
            int r = gw; f32x4 rv[8];
            p0_row_load(rsrc(r < MT + MMEM ? r : 0), rv, lane);
#pragma unroll 1
            while (r < MT + MMEM) {
                const int rn = r + NGW; f32x4 rvn[8];
                p0_row_load(rsrc(rn < MT + MMEM ? rn : 0), rvn, lane);
                if (r < MT) p0_row_finish(rv, r >= MREAL, XB + (size_t)r * D, SSX + r, lane);
                else p0_row_finish(rv, false, MEMB + (size_t)(r - MT) * D, SSMEM + (r - MT), lane);
#pragma unroll
                for (int j = 0; j < 8; ++j) rv[j] = rvn[j];
                r = rn;
            }
        }
        for (int e = gtid; e < 2 * 12 * 128 * 128 / 4; e += NT) { const int e4 = e * 4, s = e4 & 127, t = (e4 >> 7) & 127; const f32x4 wv = *(const f32x4*)(sg_w_s + e4);
            v2u o; o.x = pk2(s <= t ? wv[0] : 0.f, s + 1 <= t ? wv[1] : 0.f); o.y = pk2(s + 2 <= t ? wv[2] : 0.f, s + 3 <= t ? wv[3] : 0.f); *(v2u*)(WSB + e4) = o; }
    }
    PH_END;
#pragma unroll 1
    for (int li = 0; li < 4; ++li) {
        const int j = li >> 1;
        if ((li & 1) == 0) {
            PH_BEGIN(2)
                pg8::Gemm g{XB, W_SGIN + (size_t)j * SGN * D, MT, SGN, D}; SgOrder S; S.base.init(MP, SGN, G, blk); S.G = G; S.c = blk;
                EpiSgIn E{ss_mix, ZU, ZV, QB, SSV + (size_t)j * MT, ctl + CW_ADONE + 64 * j};
                pg8::gemm_phase<EpiSgIn, SgOrder, true, true>(lds, g, S, E);
                if (li == 0) {
                    const int first = (MT / 256) * (SGN / 256) % G;
                    pg8::Gemm gm{MEMB, W_MEM, MMEM, 4096, D}; MemOrder MO{G, blk, first, 16, 0}; EpiMem EM{SSMEM, out, MKV};
                    pg8::gemm_phase<EpiMem, MemOrder, true, true>(lds, gm, MO, EM);
                    const int r_ = (blk - (first + 16) % G + G) % G;
                    for (int un = 2 * r_; un < 68; un += 2 * G) for (int k2 = 0; k2 < 2 && un + k2 < 68; ++k2) { const int t_ = un + k2;
                        s5_tables((LAS float*)lds, t_ / NGRP, t_ % NGRP, lam_re, lam_im, log_dt, b_re, b_im, c_re, c_im, ssm_d, TB, BT2, LBT, LB16, BBART, tid); }
                }
                {
                    unsigned* sd = ctl + CW_ADONE + 64 * j; unsigned* aq = ctl + CW_AQUEUE + 64 * j; volatile LAS unsigned* qw = MISC + 20;
                    if (tid == 0) { unsigned sp = 0;
                        while (__hip_atomic_load(sd, __ATOMIC_RELAXED, __HIP_MEMORY_SCOPE_AGENT) < (unsigned)(SGN / 256)) { __builtin_amdgcn_s_sleep(2); if (++sp > (1u << 22)) break; }
                        __builtin_amdgcn_fence(__ATOMIC_ACQUIRE, "agent"); asm volatile("s_waitcnt vmcnt(0)" ::: "memory"); }
                    __syncthreads();
#pragma unroll 1
                    for (;;) {
                        if (tid == 0) qw[0] = __hip_atomic_fetch_add(aq, 1u, __ATOMIC_RELAXED, __HIP_MEMORY_SCOPE_AGENT);
                        __syncthreads();
                        const unsigned un = qw[0];
                        __syncthreads();
                        if (un >= 256u) break;
                        attn_sample_unit(lds, QB, cache_k, cache_v, MIX, li, (int)un, tid);
                    }
                }
            }
            PH_END;
            PH_BEGIN(3)
                const ssq_t* ssv = SSV + (size_t)j * MT; const float* gv = sg_g_v + j * TOKW;
                SUBREP(0)
#pragma unroll 1
                for (int un = blk; un < 768; un += G) sg_unit(lds, ZU, ZV, ssv, gv, WSB + (size_t)j * 12 * 128 * 128, sg_b_s + j * 12 * 128, MIX, un, tid);
                SUBREP(1)
#pragma unroll 1
                for (int un = blk; un < 256; un += G) attn_prompt_unit(lds, QB, mkv_l, MIX, un, tid);
                {
                    unsigned* aq = ctl + CW_AQUEUE + 64 * j; volatile LAS unsigned* qw = MISC + 20;
#pragma unroll 1
                    for (;;) {
                        if (tid == 0) qw[0] = __hip_atomic_fetch_add(aq, 1u, __ATOMIC_RELAXED, __HIP_MEMORY_SCOPE_AGENT);
                        __syncthreads();
                        const unsigned un = qw[0];
                        __syncthreads();
                        if (un >= 256u) break;
                        attn_sample_unit(lds, QB, cache_k, cache_v, MIX, li, (int)un, tid);
                    }
                }
                for (int e = gtid; e < MS * TOKW / 8; e += NT) { const int b = e / 192, c = (e % 192) * 8, g = c >> 7, r = MP + b;
                    const float rsv = rstd_of(ssv[r], 1.f / 1536.f); const v4u vw = *(const v4u*)(ZV + (size_t)r * TOKW + c), uw = *(const v4u*)(ZU + (size_t)r * TOKW + c);
                    const f32x4 g0 = *(const f32x4*)(gv + c), g1 = *(const f32x4*)(gv + c + 4);
                    const f32x4 n0 = (f32x4){bflo(vw.x) * rsv * g0[0], bfhi(vw.x) * rsv * g0[1], bflo(vw.y) * rsv * g0[2], bfhi(vw.y) * rsv * g0[3]};
                    const f32x4 n1 = (f32x4){bflo(vw.z) * rsv * g1[0], bfhi(vw.z) * rsv * g1[1], bflo(vw.w) * rsv * g1[2], bfhi(vw.w) * rsv * g1[3]};
                    float* so = out + OFF_SGV + (size_t)(j * MS + b) * TOKW + c; *(f32x4*)so = n0; *(f32x4*)(so + 4) = n1;
                    const float w00 = sg_w_s[((size_t)(j * 12 + g) * 128) * 128], bs = sg_b_s[(j * 12 + g) * 128];
                    const f32x4 t0 = (f32x4){bflo(uw.x), bfhi(uw.x), bflo(uw.y), bfhi(uw.y)} * (n0 * w00 + bs), t1 = (f32x4){bflo(uw.z), bfhi(uw.z), bflo(uw.w), bfhi(uw.w)} * (n1 * w00 + bs);
                    *(v4u*)(MIX + (size_t)r * D + c) = pack8(t0, t1); }
            }
            PH_END;
        } else {
            PH_BEGIN(4)
                pg8::Gemm g{XB, W_SSMIN + (size_t)j * D * D, MP, D, D}; pg8::StaticOrder S; S.init(MP, D, G, blk);
                EpiSsmIn E{ss_mix, UH, US, QB};
                const bool sk_first = ((blk >> 3) & 1) != 0; SEpiSsmIn SE{ss_mix, US, QB};
                if (sk_first) skinny_sample(lds, XB + (size_t)MP * D, W_SSMIN + (size_t)j * D * D, D, SE, blk, tid);
                pg8::gemm_phase<EpiSsmIn, pg8::StaticOrder, true, true>(lds, g, S, E);
                if (!sk_first) skinny_sample(lds, XB + (size_t)MP * D, W_SSMIN + (size_t)j * D * D, D, SE, blk, tid);
            }
            PH_END;
            PH_BEGIN(5)
                if (blk < 2 * NGRP) {
                    const int h = blk >> 1, mh = blk & 1;
                    s5_state_task(lds, UH, BT2 + (size_t)j * NGRP * 128 * 256, LB16 + (size_t)j * NGRP * 64 * 2, out, j, (2 * mh) * NGRP + h, tid);
                    s5_state_task(lds, UH, BT2 + (size_t)j * NGRP * 128 * 256, LB16 + (size_t)j * NGRP * 64 * 2, out, j, (2 * mh + 1) * NGRP + h, tid);
                    asm volatile("s_waitcnt vmcnt(0)" ::: "memory"); __syncthreads();
                }
                {
                    int kh = KH; asm volatile("" : "+s"(kh)); pg8::Gemm g{UH, TB + (size_t)j * NGRP * 256 * KH, NGRP * 512, NGRP * 256, kh}; ToepOrder S{G, blk};
                    EpiToep E{YB};
                    pg8::gemm_phase<EpiToep, ToepOrder, true, true>(lds, g, S, E);
                }
#pragma unroll 1
                for (int tk = gw; tk < NGRP * 16; tk += NGW)
                    s5_sample_task(US, st_re, st_im, LBT + (size_t)j * NGRP * 64 * 2, BBART + (size_t)j * NGRP * 64 * 32, c_re + (size_t)j * NGRP * 1024, c_im + (size_t)j * NGRP * 1024, ssm_d + j * TOKW, out, YB, j, tk, lane);
                {
                    unsigned* aq = ctl + CW_SQUEUE + 64 * (4 + j); volatile LAS unsigned* qw = MISC + 17;
#pragma unroll 1
                    for (;;) {
                        if (tid == 0) qw[0] = __hip_atomic_fetch_add(aq, 1u, __ATOMIC_RELAXED, __HIP_MEMORY_SCOPE_AGENT);
                        __syncthreads();
                        const unsigned un = qw[0];
                        __syncthreads();
                        if (un >= 512u) break;
                        if (un < 256u) attn_sample_unit(lds, QB, cache_k, cache_v, MIX, li, (int)un, tid); else attn_prompt_unit(lds, QB, mkv_l, MIX, (int)un - 256, tid);
                    }
                }
            }
            PH_END;
            PH_BEGIN(7)
                pg8::Gemm g{YB, W_GLU + (size_t)j * TOKW * TOKW, MT, TOKW, TOKW}; pg8::StaticOrder S; S.init(MT, TOKW, G, blk);
                EpiGlu E{YB, b_glu + j * TOKW, MIX};
                pg8::gemm_phase<EpiGlu, pg8::StaticOrder, true, true>(lds, g, S, E);
            }
            PH_END;
        }
        PH_BEGIN(8)
            const bf16* wo = (li & 1) ? W_SSMOUT + (size_t)j * D * D : W_SGOUT + (size_t)j * D * D;
            pg8::Gemm g{MIX, wo, MP, D, D}; pg8::StaticOrder S; S.init(MP, D, G, blk);
            if (DUPX & 2u) { EpiRes E0{AG, SSX + (size_t)8 * MT}; pg8::gemm_phase<EpiRes, pg8::StaticOrder, true, true>(lds, g, S, E0); }
            EpiRes E{XB, ss_ffn};
            const bool sk_first = ((blk >> 3) & 1) != 0; SEpiRes SE{XB, ss_ffn};
            if (sk_first) skinny_sample(lds, MIX + (size_t)MP * D, wo, D, SE, blk, tid);
            pg8::gemm_phase<EpiRes, pg8::StaticOrder, true, true>(lds, g, S, E);
            if (!sk_first) skinny_sample(lds, MIX + (size_t)MP * D, wo, D, SE, blk, tid);
        }
        PH_END;
        PH_BEGIN(9)
            pg8::Gemm g{XB, W_UP + (size_t)li * NUP * D, MT, NUP, D}; UpOrder S; S.base.init(MP, NUP, G, blk); S.G = G; S.c = blk;
            EpiUp E{ss_ffn, YF, out, st_conv + (size_t)li * MS * 2 * DFF, conv_w + (size_t)li * 3 * DFF, conv_b + (size_t)li * DFF, FXA, (LAS float*)(lds + HALO_OFF), li, ctl + CW_SDONE + 64 * li};
            pg8::gemm_phase<EpiUp, UpOrder, true, true>(lds, g, S, E);
            if (li == 0) {
                const int first = (MT / 256) * (NUP / 256) % G;
                pg8::Gemm gm{MEMB, W_MEM, MMEM, 4096, D}; MemOrder MO{G, blk, first, 48, 16}; EpiMem EM{SSMEM, out, MKV};
                pg8::gemm_phase<EpiMem, MemOrder, true, true>(lds, gm, MO, EM);
                const int r_ = (blk - (first + 48) % G + G) % G;
                for (int un = 68 + 2 * r_; un < 2 * NGRP; un += 2 * G) for (int k2 = 0; k2 < 2 && un + k2 < 2 * NGRP; ++k2) { const int t_ = un + k2;
                    s5_tables((LAS float*)lds, t_ / NGRP, t_ % NGRP, lam_re, lam_im, log_dt, b_re, b_im, c_re, c_im, ssm_d, TB, BT2, LBT, LB16, BBART, tid); }
            }
            {
                unsigned* sd = ctl + CW_SDONE + 64 * li; unsigned* sq = ctl + CW_SQUEUE + 64 * li; volatile LAS unsigned* qw = MISC + 16;
                if (tid == 0) { unsigned sp = 0;
                    while (__hip_atomic_load(sd, __ATOMIC_RELAXED, __HIP_MEMORY_SCOPE_AGENT) < (unsigned)(NUP / 256)) { __builtin_amdgcn_s_sleep(2); if (++sp > (1u << 22)) break; }
                    __builtin_amdgcn_fence(__ATOMIC_ACQUIRE, "agent"); asm volatile("s_waitcnt vmcnt(0)" ::: "memory"); }
                __syncthreads();
                SEpiRes SE{XB, ss_next};
#pragma unroll 1
                for (;;) {
                    if (tid == 0) qw[0] = __hip_atomic_fetch_add(sq, 1u, __ATOMIC_RELAXED, __HIP_MEMORY_SCOPE_AGENT);
                    __syncthreads();
                    const unsigned tile = qw[0];
                    __syncthreads();
                    if (tile >= 256u) break;
                    skinny_sample(lds, YF + (size_t)MP * DFF, W_DOWN + (size_t)li * D * DFF, DFF, SE, (int)tile, tid);
                }
            }
            if (li == 1 || li == 2)
                p0_queue(lds, MISC + 22, ctl + CW_WQUEUE + 64 * li, li + 1, li == 1 ? P0_DEF2 : P0_DEF3, ap->in, ws, tid);
        }
        PH_END;
        PH_BEGIN(11)
            pg8::Gemm g{YF, W_DOWN + (size_t)li * D * DFF, MP, D, DFF}; pg8::StaticOrder S; S.init(MP, D, G, blk);
            {
                pg8::Unit u0;
                if (S.next(0, u0) && (u0.pm & 7) != 0) {
                    const int pm = u0.pm; const float* cw = conv_w + (size_t)li * 3 * DFF; const float* cb = conv_b + (size_t)li * DFF;
                    for (int e = tid; e < DFF / 4; e += NTHR) { const int c = e * 4;
                        const f32x4 am2 = *(const f32x4*)(FXA + ((size_t)((pm - 1) * 4 + 2)) * DFF + c), am1 = *(const f32x4*)(FXA + ((size_t)((pm - 1) * 4 + 3)) * DFF + c);
                        const f32x4 a0 = *(const f32x4*)(FXA + ((size_t)(pm * 4)) * DFF + c), a1 = *(const f32x4*)(FXA + ((size_t)(pm * 4 + 1)) * DFF + c);
                        const f32x4 g0 = *(const f32x4*)(FXG + ((size_t)(pm * 2)) * DFF + c), g1 = *(const f32x4*)(FXG + ((size_t)(pm * 2 + 1)) * DFF + c);
                        const f32x4 k0 = *(const f32x4*)(cw + c), k1 = *(const f32x4*)(cw + DFF + c), k2 = *(const f32x4*)(cw + 2 * DFF + c), kb = *(const f32x4*)(cb + c);
                        f32x4 y0, y1;
#pragma unroll
                        for (int i = 0; i < 4; ++i) { const float c0_ = kb[i] + k0[i] * am2[i] + k1[i] * am1[i] + k2[i] * a0[i], c1_ = kb[i] + k0[i] * am1[i] + k1[i] * a0[i] + k2[i] * a1[i];
                            y0[i] = c0_ * sigmoid_f(c0_) * g0[i]; y1[i] = c1_ * sigmoid_f(c1_) * g1[i]; }
                        v2u w0, w1; w0.x = pk2(y0[0], y0[1]); w0.y = pk2(y0[2], y0[3]); w1.x = pk2(y1[0], y1[1]); w1.y = pk2(y1[2], y1[3]);
                        *(v2u*)(YF + (size_t)(pm * 256) * DFF + c) = w0; *(v2u*)(YF + (size_t)(pm * 256 + 1) * DFF + c) = w1; }
                }
                asm volatile("s_waitcnt vmcnt(0)" ::: "memory"); __syncthreads();
            }
            if (DUPX & 4u) { EpiRes E0{AG, SSX + (size_t)8 * MT}; pg8::gemm_phase<EpiRes, pg8::StaticOrder, true, true>(lds, g, S, E0); }
            if (li == 3 && G == 256) {
                if (wave == 0 && blk < MS) {
                    const int r = MP + blk; const v2u* xr = (const v2u*)(XB + (size_t)r * D); f32x4 v[8]; float s_ = 0.f;
#pragma unroll
                    for (int jj = 0; jj < 8; ++jj) { const v2u xw = xr[lane + 64 * jj]; v[jj] = (f32x4){bflo(xw.x), bfhi(xw.x), bflo(xw.y), bfhi(xw.y)}; s_ += dot4(v[jj]); }
                    const float rs = rsqrtf(wave_sum(s_) * (1.f / 2048.f) + EPS); f32x4* o = (f32x4*)(out + OFF_YS + (size_t)blk * D);
#pragma unroll
                    for (int jj = 0; jj < 8; ++jj) o[lane + 64 * jj] = v[jj] * rs * ((const f32x4*)g_final)[lane + 64 * jj];
                }
                EpiResFinal EF{XB, ss_next, out, g_final, ctl + CW_PCNT};
                pg8::gemm_phase<EpiResFinal, pg8::StaticOrder, true, true>(lds, g, S, EF);
            } else {
            EpiRes E{XB, ss_next};
            pg8::gemm_phase<EpiRes, pg8::StaticOrder, true, true>(lds, g, S, E);
            }

        }
        PH_END;
    }
    PH_BEGIN(12)
#pragma unroll 1
        for (int r = gw; r < MREAL; r += NGW) {
            const v2u* xr = (const v2u*)(XB + (size_t)r * D); f32x4 v[8]; float s = 0.f;
#pragma unroll
            for (int jj = 0; jj < 8; ++jj) { const v2u xw = xr[lane + 64 * jj]; v[jj] = (f32x4){bflo(xw.x), bfhi(xw.x), bflo(xw.y), bfhi(xw.y)}; s += dot4(v[jj]); }
            const float rs = rsqrtf(wave_sum(s) * (1.f / 2048.f) + EPS);
            f32x4* o = (f32x4*)(out + (r < MP ? OFF_YP + (size_t)r * D : OFF_YS + (size_t)(r - MP) * D));
#pragma unroll
            for (int jj = 0; jj < 8; ++jj) o[lane + 64 * jj] = v[jj] * rs * ((const f32x4*)g_final)[lane + 64 * jj];
        }
    }
    PH_END;
#ifdef PROBE_K1
    xcd_barrier(bar);
    if (blockIdx.x == 0) { const unsigned n = (unsigned)((d1_ * 262144ull) / 100000ull); for (unsigned e = threadIdx.x; e < n && e < 262144u; e += NTHR) (out + OFF_YS)[e] = 0.f;
        if (threadIdx.x == 0) (out + OFF_YP)[0] += (float)d2_ * 0.01f; }
#endif
#undef PH_BEGIN
#undef PH_END
}
#undef x_prompt
#undef x_sample
#undef mem_prompt
#undef cache_k
#undef cache_v
#undef st_re
#undef st_im
#undef st_conv
#undef g_mix
#undef g_ffn
#undef g_mem
#undef g_final
#undef w_mem_kv
#undef sg_w_in
#undef sg_w_out
#undef sg_g_v
#undef sg_w_s
#undef sg_b_s
#undef ssm_w_in
#undef ssm_w_out
#undef lam_re
#undef lam_im
#undef log_dt
#undef b_re
#undef b_im
#undef c_re
#undef c_im
#undef ssm_d
#undef w_glu
#undef b_glu
#undef w_up
#undef conv_w
#undef conv_b
#undef w_down
#undef ctl
#undef SSX
#undef ss_mix
#undef ss_ffn
#undef ss_next
#undef mkv_l
#undef SSV
#undef SSMEM
#undef W_SGIN
#undef W_SSMIN
#undef W_SGOUT
#undef W_SSMOUT
#undef W_GLU
#undef W_UP
#undef W_DOWN
#undef W_MEM
#undef WSB
#undef TB
#undef BT2
#undef LBT
#undef LB16
#undef BBART
#undef XRES
#undef XB
#undef MEMB
#undef MKV
#undef ZU
#undef ZV
#undef QB
#undef MIX
#undef AG
#undef YF
#undef UH
#undef YB
#undef US
#undef FXA
#undef FXG
#undef ws
#undef out

#ifndef MK_ONE_LAUNCH
#define MK_ONE_LAUNCH 1
#endif
extern "C" void kernel_launch(void* const* d_in, const int* in_sizes, int n_in, void* d_out, int out_size, void* d_ws, size_t ws_size, hipStream_t stream) {
    static int grid = 0;
    if (grid == 0) {
        if (n_in != 34 || (size_t)out_size != OUT_TOTAL || ws_size < WS_END) { fprintf(stderr, "kernel_launch: unexpected shapes (n_in %d, out %d, ws %zu)\n", n_in, out_size, ws_size); grid = -1; return; }
        int dev = 0, cus = 0;
        if (hipGetDevice(&dev) != hipSuccess || hipDeviceGetAttribute(&cus, hipDeviceAttributeMultiprocessorCount, dev) != hipSuccess) { grid = -1; return; }
        if (hipFuncSetAttribute((const void*)trunk_fwd, hipFuncAttributeMaxDynamicSharedMemorySize, LDS_BYTES) != hipSuccess) { fprintf(stderr, "kernel_launch: hipFuncSetAttribute failed\n"); grid = -1; return; }
        int per_cu = 0;
        if (hipOccupancyMaxActiveBlocksPerMultiprocessor(&per_cu, (const void*)trunk_fwd, NTHR, LDS_BYTES) != hipSuccess || per_cu < 1) fprintf(stderr, "kernel_launch: occupancy query says %d\n", per_cu);
        (void)hipGetLastError();
        grid = cus;
    }
    if (grid < 0) return;
    if (hipMemsetAsync((char*)d_ws + WS_CTL, 0, CTL_ZERO_BYTES, stream) != hipSuccess) return;
    Args a{};
    for (int i = 0; i < 34; ++i) a.in[i] = (const float*)d_in[i];
    a.out = (float*)d_out; a.ws = (unsigned char*)d_ws;
#if MK_ONE_LAUNCH
    a.lo = 0; a.hi = (grid == 256) ? NPHASE - 1 : NPHASE;
    hipLaunchKernelGGL(trunk_fwd, dim3(grid), dim3(NTHR), LDS_BYTES, stream, a);
#else
    for (int p = 0; p < NPHASE; ++p) { a.lo = p; a.hi = p + 1; hipLaunchKernelGGL(trunk_fwd, dim3(grid), dim3(NTHR), LDS_BYTES, stream, a); }
#endif
#ifdef OUTMASK
    {
        const size_t offs[12] = {OFF_YP, OFF_YS, OFF_MK, OFF_MV, OFF_SRP, OFF_SIP, OFF_CONVP, OFF_SRS, OFF_SIS, OFF_CONVS, OFF_SGV, OUT_TOTAL};
        for (int i = 0; i < 11; ++i) if (!((OUTMASK >> i) & 1)) (void)hipMemsetAsync((float*)d_out + offs[i], 0, (offs[i + 1] - offs[i]) * 4, stream);
    }
#endif
}
```

```cpp
#include <hip/hip_runtime.h>
#include <cstdio>
#include <cstdint>
namespace pg8 {
#define PG8_LAS __attribute__((address_space(3)))
typedef unsigned short bf16_t;
typedef short bf16x8 __attribute__((ext_vector_type(8)));
typedef float f32x4 __attribute__((ext_vector_type(4)));
typedef unsigned u32x4 __attribute__((ext_vector_type(4)));
constexpr int BM = 256, BK = 64, HALF = 128, HTB = HALF * BK * 2  , STAGE_BYTES = 8 * HTB, NXCD = 8, WGM = 8;

__host__ __device__ __forceinline__ int lds_byte(int r, int c) { const int st = (r >> 4) * 2 + (c >> 5), rr = r & 15, cc = c & 31, ob = rr * 64 + cc * 2; return st * 1024 + (ob ^ (((ob >> 9) & 1) << 5)); }
__host__ __device__ __forceinline__ void stage_rc(int b, int& R, int& C) { const int st = b / 1024, sb = b % 1024, swz = sb ^ (((sb >> 9) & 1) << 5); R = (st >> 1) * 16 + swz / 64; C = (st & 1) * 32 + (swz % 64) / 2; }
__host__ __device__ __forceinline__ int perm32(int rho) { const int n = rho >> 4, i = rho & 15; return 8 * (i >> 2) + 4 * n + (i & 3); }

struct Unit { int pm, pn; };
struct Gemm { const bf16_t* A; const bf16_t* Bt; int M, N, K; };

struct StaticOrder {
    int nM, nN, nwg, G, c;
    __host__ __device__ void init(int M, int N, int G_, int c_) { nM = M / BM; nN = N / BM; nwg = nM * nN; G = G_; c = c_; }
    __host__ __device__ __forceinline__ bool next(int i, Unit& u) const { return at((long)i * G + c, u); }
    __host__ __device__ __forceinline__ bool at(long L, Unit& u) const {
        if (L >= nwg) return false;
        int wgid = (int)L; { const int q = nwg / NXCD, r = nwg % NXCD, xcd = wgid % NXCD, off = wgid / NXCD; wgid = (xcd < r ? xcd * (q + 1) : r * (q + 1) + (xcd - r) * q) + off; }
        const int nig = WGM * nN, gid = wgid / nig, fm = gid * WGM, gsz = (nM - fm) < WGM ? (nM - fm) : WGM;
        u.pm = fm + ((wgid % nig) % gsz); u.pn = (wgid % nig) / gsz; return true;
    }
    __device__ __forceinline__ void a_ready(const Unit&) const {}
    __device__ __forceinline__ void done(const Unit&) const {}
};
__device__ __forceinline__ unsigned cvt_pk_bf16(float lo, float hi) { unsigned r; asm volatile("v_cvt_pk_bf16_f32 %0, %1, %2" : "=v"(r) : "v"(lo), "v"(hi)); return r; }
typedef float f32x2 __attribute__((ext_vector_type(2)));
template <class Epi, class Sched, bool ALIGN_EPI = false, bool SP2 = false>
__device__ __forceinline__ void gemm_phase(PG8_LAS unsigned char* lds, const Gemm g, const Sched& S, const Epi& E) {
    int tid = threadIdx.x; asm volatile("" : "+v"(tid)); const int wid = __builtin_amdgcn_readfirstlane(tid >> 6), lane = tid & 63, wr = wid >> 2, wc = wid & 3, fr = lane & 15, fq = lane >> 4;
    const int K = g.K, nt = K / BK;
    unsigned voffA[2], voffB[2];
#pragma unroll
    for (int i = 0; i < 2; ++i) { int R, C; stage_rc(tid * 16 + i * 8192, R, C); const int Rb = Epi::PERM ? ((R & ~31) + perm32(R & 31)) : R;
        voffA[i] = (unsigned)(R * K + C) * 2u; voffB[i] = (unsigned)(Rb * K + C) * 2u; }
    const size_t kstep = (size_t)(BK * 2);
    const size_t hstep = (size_t)HALF * K * 2;
    const size_t tstep = 2 * hstep;
    const unsigned ldsw = (unsigned)wid * 1024u;
    const int aoff = lds_byte(wr * 64 + fr, fq * 8), boff = lds_byte(wc * 32 + fr, fq * 8);
#define PG8_SA(b, h) (((b) * 2 + (h)) * HTB)
#define PG8_SB(b, h) ((4 + (b) * 2 + (h)) * HTB)
#define PG8_STAGE(bufoff, gbase, voff) do { _Pragma("unroll") for (int _i = 0; _i < 2; ++_i) \
        __builtin_amdgcn_global_load_lds((const unsigned*)((const char*)(gbase) + (voff)[_i]), (PG8_LAS unsigned*)(lds + (bufoff) + ldsw + _i * 8192), 16, 0, 0); } while (0)
#define PG8_LDA(dst, b, h) do { _Pragma("unroll") for (int m = 0; m < 4; ++m) _Pragma("unroll") for (int k = 0; k < 2; ++k) dst[m][k] = *(const PG8_LAS bf16x8*)(lds + PG8_SA(b, h) + aoff + m * 2048 + k * 1024); } while (0)
#define PG8_LDB(dst, b, h) do { _Pragma("unroll") for (int n = 0; n < 2; ++n) _Pragma("unroll") for (int k = 0; k < 2; ++k) dst[n][k] = *(const PG8_LAS bf16x8*)(lds + PG8_SB(b, h) + boff + n * 2048 + k * 1024); } while (0)
#define PG8_MMA(ai, bj, At, Bt) do { __builtin_amdgcn_s_setprio(1); _Pragma("unroll") for (int m = 0; m < 4; ++m) _Pragma("unroll") for (int n = 0; n < 2; ++n) _Pragma("unroll") for (int k = 0; k < 2; ++k) \
        acc[ai][bj][m][n] = __builtin_amdgcn_mfma_f32_16x16x32_bf16(Bt[n][k], At[m][k], acc[ai][bj][m][n], 0, 0, 0); __builtin_amdgcn_s_setprio(0); } while (0)
#define PG8_WAIT_V(n) asm volatile("s_waitcnt vmcnt(" #n ")" ::: "memory")
#define PG8_WAIT_L(n) asm volatile("s_waitcnt lgkmcnt(" #n ")" ::: "memory")
#define PG8_BAR __builtin_amdgcn_s_barrier()
#define PG8_SCHED __builtin_amdgcn_sched_barrier(0)
    Unit cur, nxt; int ui = 0;
    if (!S.next(0, cur)) return;
    f32x4 acc[2][2][4][2];
#pragma unroll
    for (int a = 0; a < 2; ++a)
#pragma unroll
        for (int b = 0; b < 2; ++b)
#pragma unroll
            for (int m = 0; m < 4; ++m)
#pragma unroll
                for (int n = 0; n < 2; ++n) acc[a][b][m][n] = (f32x4){0.f, 0.f, 0.f, 0.f};
    if constexpr (Epi::INIT_ACC) E.init_acc(acc, cur, wr, wc, fr, fq);
    bf16x8 At[4][2], B0[2][2], B1[2][2];
    const char* cA = (const char*)g.A + (size_t)cur.pm * tstep; const char* cB = (const char*)g.Bt + (size_t)cur.pn * tstep;
    S.a_ready(cur);
    if constexpr (SP2) {
        PG8_STAGE(PG8_SB(0, 0), cB, voffB); PG8_STAGE(PG8_SB(0, 1), cB + hstep, voffB); PG8_STAGE(PG8_SA(0, 0), cA, voffA); PG8_STAGE(PG8_SA(0, 1), cA + hstep, voffA);
        if (wr == 1) PG8_BAR;
        PG8_WAIT_V(2); PG8_BAR;
        PG8_STAGE(PG8_SB(1, 0), cB + kstep, voffB); PG8_STAGE(PG8_SA(1, 0), cA + kstep, voffA); PG8_STAGE(PG8_SB(1, 1), cB + hstep + kstep, voffB);
        PG8_WAIT_V(6); PG8_BAR;
    } else {
        PG8_STAGE(PG8_SB(0, 0), cB, voffB); PG8_STAGE(PG8_SA(0, 0), cA, voffA); PG8_STAGE(PG8_SB(0, 1), cB + hstep, voffB); PG8_STAGE(PG8_SA(0, 1), cA + hstep, voffA);
        if (wr == 1) PG8_BAR;
        PG8_WAIT_V(4); PG8_BAR;
        PG8_STAGE(PG8_SB(1, 0), cB + kstep, voffB); PG8_STAGE(PG8_SA(1, 0), cA + kstep, voffA); PG8_STAGE(PG8_SB(1, 1), cB + hstep + kstep, voffB);
        PG8_WAIT_V(6); PG8_BAR;
    }
    for (;;) {
        const bool has_next = S.next(ui + 1, nxt);
        const char* nA = has_next ? (const char*)g.A + (size_t)nxt.pm * tstep : cA; const char* nB = has_next ? (const char*)g.Bt + (size_t)nxt.pn * tstep : cB;
        for (int t = 0; t < nt; t += 2) {
            const bool last = (t == nt - 2);
            const char* a1 = cA + (size_t)(t + 1) * kstep;
            const char* a2 = last ? nA : cA + (size_t)(t + 2) * kstep; const char* b2 = last ? nB : cB + (size_t)(t + 2) * kstep;
            const char* a3 = a2 + kstep; const char* b3 = b2 + kstep;
            if (last && has_next) S.a_ready(nxt);
            if constexpr (Epi::PREFETCH) { if (last) E.prefetch(cur, wid, lane); }
            if constexpr (SP2) {
            PG8_LDB(B0, 0, 0); PG8_LDB(B1, 0, 1); PG8_SCHED; PG8_LDA(At, 0, 0); PG8_STAGE(PG8_SA(1, 1), a1 + hstep, voffA);
            PG8_WAIT_V(8); PG8_WAIT_L(0); PG8_BAR; PG8_MMA(0, 0, At, B0); PG8_MMA(0, 1, At, B1); PG8_BAR; PG8_SCHED;
            PG8_LDA(At, 0, 1); PG8_STAGE(PG8_SB(0, 0), b2, voffB); PG8_STAGE(PG8_SB(0, 1), b2 + hstep, voffB); PG8_STAGE(PG8_SA(0, 0), a2, voffA);
            PG8_WAIT_V(8); PG8_WAIT_L(0); PG8_BAR; PG8_MMA(1, 0, At, B0); PG8_MMA(1, 1, At, B1); PG8_BAR; PG8_SCHED;
            PG8_LDB(B0, 1, 0); PG8_LDB(B1, 1, 1); PG8_SCHED; PG8_LDA(At, 1, 0); PG8_STAGE(PG8_SA(0, 1), a2 + hstep, voffA);
            PG8_WAIT_V(8); PG8_WAIT_L(0); PG8_BAR; PG8_MMA(0, 0, At, B0); PG8_MMA(0, 1, At, B1); PG8_BAR; PG8_SCHED;
            PG8_LDA(At, 1, 1); PG8_STAGE(PG8_SB(1, 0), b3, voffB); PG8_STAGE(PG8_SB(1, 1), b3 + hstep, voffB); PG8_STAGE(PG8_SA(1, 0), a3, voffA);
            PG8_WAIT_V(8); PG8_WAIT_L(0); PG8_BAR; PG8_MMA(1, 0, At, B0); PG8_MMA(1, 1, At, B1); PG8_BAR; PG8_SCHED;
            } else {
            PG8_LDB(B0, 0, 0); PG8_SCHED; PG8_LDA(At, 0, 0); PG8_STAGE(PG8_SA(1, 1), a1 + hstep, voffA);
            PG8_WAIT_L(8); PG8_BAR; PG8_WAIT_L(0); PG8_MMA(0, 0, At, B0); PG8_BAR; PG8_SCHED;
            PG8_LDB(B1, 0, 1); PG8_STAGE(PG8_SB(0, 0), b2, voffB);
            PG8_BAR; PG8_WAIT_L(0); PG8_MMA(0, 1, At, B1); PG8_BAR;
            PG8_LDA(At, 0, 1); PG8_STAGE(PG8_SA(0, 0), a2, voffA);
            PG8_BAR; PG8_WAIT_L(0); PG8_MMA(1, 0, At, B0); PG8_BAR; PG8_SCHED;
            PG8_STAGE(PG8_SB(0, 1), b2 + hstep, voffB);
            PG8_WAIT_V(6); PG8_BAR; PG8_MMA(1, 1, At, B1); PG8_BAR;
            PG8_LDB(B0, 1, 0); PG8_SCHED; PG8_LDA(At, 1, 0); PG8_STAGE(PG8_SA(0, 1), a2 + hstep, voffA);
            PG8_WAIT_L(8); PG8_BAR; PG8_WAIT_L(0); PG8_MMA(0, 0, At, B0); PG8_BAR; PG8_SCHED;
            PG8_LDB(B1, 1, 1); PG8_STAGE(PG8_SB(1, 0), b3, voffB);
            PG8_BAR; PG8_WAIT_L(0); PG8_MMA(0, 1, At, B1); PG8_BAR;
            PG8_LDA(At, 1, 1); PG8_STAGE(PG8_SA(1, 0), a3, voffA);
            PG8_BAR; PG8_WAIT_L(0); PG8_MMA(1, 0, At, B0); PG8_BAR; PG8_SCHED;
            PG8_STAGE(PG8_SB(1, 1), b3 + hstep, voffB);
            PG8_WAIT_V(6); PG8_BAR; PG8_MMA(1, 1, At, B1); PG8_BAR;
            }
        }
        if constexpr (ALIGN_EPI) { if (wr == 0) PG8_BAR; }
        if constexpr (!Epi::AFTER_DRAIN) { E(acc, cur, wr, wc, fr, fq); S.done(cur); }
        if (!has_next) break;
#pragma unroll
        for (int a = 0; a < 2; ++a)
#pragma unroll
            for (int b = 0; b < 2; ++b)
#pragma unroll
                for (int m = 0; m < 4; ++m)
#pragma unroll
                    for (int n = 0; n < 2; ++n) acc[a][b][m][n] = (f32x4){0.f, 0.f, 0.f, 0.f};
        cur = nxt; cA = nA; cB = nB; ++ui;
        if constexpr (Epi::INIT_ACC) E.init_acc(acc, cur, wr, wc, fr, fq);
        if constexpr (ALIGN_EPI) { if (wr == 1) PG8_BAR; }
    }
    PG8_WAIT_V(0);
    if constexpr (!ALIGN_EPI) { if (wr == 0) PG8_BAR; }
    PG8_BAR;
    if constexpr (Epi::AFTER_DRAIN) { E.fused(acc, cur, wr, wc, fr, fq, lds, wid, lane); S.done(cur); }
#undef PG8_SA
#undef PG8_SB
#undef PG8_STAGE
#undef PG8_LDA
#undef PG8_LDB
#undef PG8_MMA
#undef PG8_WAIT_V
#undef PG8_WAIT_L
#undef PG8_BAR
#undef PG8_SCHED
}
}
#define LAS_BAR __attribute__((address_space(3)))
#define XB_TMO      128
#define XB_XCNT(j)  (256  + 64 * (j))
#define XB_XSUB(j)  (1280 + 64 * (j))
#define XB_XGEN(j)  (2304 + 64 * (j))
#define XB_TOP      3328
#define XB_TOPGEN   3392
#define XCD_BAR_WORDS 3456
#define XB_SPIN_CAP (1u << 18)

__device__ __forceinline__ unsigned xb_ld(unsigned* p)              { return __hip_atomic_load(p, __ATOMIC_RELAXED, __HIP_MEMORY_SCOPE_AGENT); }
__device__ __forceinline__ unsigned xb_add(unsigned* p, unsigned v) { return __hip_atomic_fetch_add(p, v, __ATOMIC_RELAXED, __HIP_MEMORY_SCOPE_AGENT); }
__device__ __forceinline__ unsigned xb_xcc_id() { return (unsigned)__builtin_amdgcn_s_getreg((3 << 11) | 20) & 0xFu; }
#define XB_SPIN(cond, bar) do { unsigned _sp = 0; while (cond) { __builtin_amdgcn_s_sleep(1); \
    if ((++_sp & 255u) == 0u) { if (xb_ld(&(bar)[XB_TMO])) break; if (_sp > XB_SPIN_CAP) { atomicAdd(&(bar)[XB_TMO], 1u); break; } } } } while (0)

struct XcdBarrier {
    unsigned* bar; unsigned x;
    volatile LAS_BAR unsigned* st;
};

__device__ __forceinline__ XcdBarrier xcd_barrier_post(unsigned* bar, volatile LAS_BAR unsigned* st) {
    XcdBarrier b; b.bar = bar; b.x = xb_xcc_id(); b.st = st;
    if (threadIdx.x == 0) (void)xb_add(&bar[XB_XCNT(b.x)], 1u);
    return b;
}
__device__ __forceinline__ void xcd_barrier_complete(unsigned* bar, unsigned x, unsigned& nloc, unsigned& nx) {
    const unsigned G = gridDim.x * gridDim.y * gridDim.z;
    unsigned sum, cnt, mine, sp = 0u;
    for (;;) {
        sum = 0u; cnt = 0u; mine = 0u;
#pragma unroll
        for (unsigned j = 0; j < 16; ++j) { const unsigned c = xb_ld(&bar[XB_XCNT(j)]); sum += c; cnt += (c > 0u) ? 1u : 0u; mine = (j == x) ? c : mine; }
        if (sum == G) break;
        __builtin_amdgcn_s_sleep(1);
        if ((++sp & 255u) == 0u) { if (xb_ld(&bar[XB_TMO])) break; if (sp > XB_SPIN_CAP) { atomicAdd(&bar[XB_TMO], 1u); break; } }
    }
    nloc = mine > 0u ? mine : 1u; nx = cnt > 0u ? cnt : 1u;
}

__device__ __forceinline__ void xcd_barrier(const XcdBarrier& b) {
    asm volatile("s_waitcnt vmcnt(0)" ::: "memory");
    __syncthreads();
    int t0_ = threadIdx.x; asm volatile("" : "+v"(t0_));
    if (t0_ == 0) {
        unsigned* bar = b.bar;
        __builtin_amdgcn_s_waitcnt(0);
        unsigned nloc = b.st[0], nx = b.st[1];
        if (nloc == 0u) { xcd_barrier_complete(bar, b.x, nloc, nx); b.st[0] = nloc; b.st[1] = nx; }
        const unsigned old = xb_add(&bar[XB_XSUB(b.x)], 1u);
        const unsigned gen = old / nloc;
        if (old + 1u == (gen + 1u) * nloc) {
            __builtin_amdgcn_fence(__ATOMIC_RELEASE, "agent");
            asm volatile("s_waitcnt vmcnt(0)" ::: "memory");
            const unsigned og = xb_add(&bar[XB_TOP], 1u);
            const unsigned tg = og / nx;
            if (og + 1u == (tg + 1u) * nx) xb_add(&bar[XB_TOPGEN], 1u);
            else XB_SPIN(xb_ld(&bar[XB_TOPGEN]) == tg, bar);
            __builtin_amdgcn_fence(__ATOMIC_ACQUIRE, "agent");
            xb_add(&bar[XB_XGEN(b.x)], 1u);
            asm volatile("s_waitcnt vmcnt(0)" ::: "memory");
        } else {
            XB_SPIN(xb_ld(&bar[XB_XGEN(b.x)]) == gen, bar);
            __builtin_amdgcn_fence(__ATOMIC_ACQUIRE, "agent");
            asm volatile("s_waitcnt vmcnt(0)" ::: "memory");
        }
    }
    __syncthreads();
}
#define GAS __attribute__((address_space(1)))
#define LAS __attribute__((address_space(3)))
typedef unsigned short bf16;
typedef unsigned v4u __attribute__((ext_vector_type(4)));
typedef unsigned v2u __attribute__((ext_vector_type(2)));
typedef float f32x4 __attribute__((ext_vector_type(4)));
typedef short bf16x8 __attribute__((ext_vector_type(8)));
typedef short bf16x4 __attribute__((ext_vector_type(4)));

constexpr int NWAVES = 8, NTHR = 512;
constexpr int D = 2048, SEQ = 2048, MP = 8192, MS = 128, MREAL = 8320, MT = 8448;
constexpr int MMEM = 1024, XAW = 512, TOKW = 1536, SGN = 3584, DFF = 5504, NUP = 11008;
constexpr int NGRP = 96, KH = 384;
constexpr float EPS = 1e-6f;
constexpr int NPHASE = 24;

constexpr size_t OFF_YP = 0, OFF_YS = 16777216, OFF_MK = 17039360, OFF_MV = 19136512, OFF_SRP = 21233664, OFF_SIP = 21282816,
                 OFF_CONVP = 21331968, OFF_SRS = 21508096, OFF_SIS = 23080960, OFF_CONVS = 24653824, OFF_SGV = 30289920, OUT_TOTAL = 30683136;

constexpr size_t MiB = 1u << 20;
constexpr size_t WS_CTL = 0, CTL_ZERO_BYTES = 1 * MiB;
constexpr size_t WS_WSGIN = 1 * MiB;
constexpr size_t WS_WSSMIN = WS_WSGIN + 28 * MiB;
constexpr size_t WS_WSGOUT = WS_WSSMIN + 16 * MiB;
constexpr size_t WS_WSSMOUT = WS_WSGOUT + 16 * MiB;
constexpr size_t WS_WGLU = WS_WSSMOUT + 16 * MiB;
constexpr size_t WS_WUP = WS_WGLU + 9 * MiB;
constexpr size_t WS_WDOWN = WS_WUP + 172 * MiB;
constexpr size_t WS_WMEM = WS_WDOWN + 86 * MiB;
constexpr size_t WS_WSB = WS_WMEM + 16 * MiB;
constexpr size_t WS_TB = WS_WSB + 1 * MiB;
constexpr size_t WS_BT2 = WS_TB + 36 * MiB;
constexpr size_t WS_LBT = WS_BT2 + 12 * MiB;
constexpr size_t WS_LB16 = WS_LBT + 128 * 1024;
constexpr size_t WS_BBAR = WS_LBT + 1 * MiB;
constexpr size_t WS_XRES = WS_BBAR + 2 * MiB;
constexpr size_t WS_XB = WS_XRES + 66 * MiB;
constexpr size_t WS_MEMB = WS_XB + 33 * MiB;
constexpr size_t WS_MKV = WS_MEMB + 4 * MiB;
constexpr size_t WS_ZU = WS_MKV + 8 * MiB;
constexpr size_t WS_ZV = WS_ZU + 25 * MiB;
constexpr size_t WS_Q = WS_ZV + 25 * MiB;
constexpr size_t WS_MIX = WS_Q + 9 * MiB;
constexpr size_t WS_AG = WS_MIX + 33 * MiB;
constexpr size_t WS_Y = WS_AG + 178 * MiB;
constexpr size_t WS_UH = WS_Y + 89 * MiB;
constexpr size_t WS_YB = WS_UH + 36 * MiB;
constexpr size_t WS_US = WS_YB + 25 * MiB;
constexpr size_t WS_FXA = WS_US + 1 * MiB;
constexpr size_t WS_FXG = WS_FXA + 3 * MiB;
constexpr size_t WS_END = WS_FXG + 2 * MiB;
constexpr int CW_BAR = 4096;
constexpr int CW_SDONE = 8192, CW_SQUEUE = 8192 + 64 * 4, CW_PCNT = 8192 + 64 * 16, CW_ADONE = CW_PCNT + 64 * 32, CW_AQUEUE = CW_ADONE + 64 * 4, CW_WQUEUE = CW_AQUEUE + 64 * 4;
typedef unsigned long long ssq_t;
constexpr size_t CTL_SSX = 64 * 1024;
constexpr size_t CTL_SSV = 704 * 1024;
constexpr size_t CTL_SSMEM = 896 * 1024;
static_assert(CTL_SSX + 9 * MT * 8 <= CTL_SSV && CTL_SSV + 2 * MT * 8 <= CTL_SSMEM && CTL_SSMEM + 8192 <= CTL_ZERO_BYTES, "ctl map");

constexpr int LDS_BYTES = 147456, MISC_OFF = LDS_BYTES - 512, HALO_OFF = 131072;

__device__ __forceinline__ unsigned pk2(float lo, float hi) { return pg8::cvt_pk_bf16(lo, hi); }
__device__ __forceinline__ float bflo(unsigned w) { return __uint_as_float(w << 16); }
__device__ __forceinline__ float bfhi(unsigned w) { return __uint_as_float(w & 0xffff0000u); }
__device__ __forceinline__ float gelu_t(float x) { const float e = __builtin_amdgcn_exp2f(x * (-2.3022082f - 0.10294324f * x * x)); return x * __builtin_amdgcn_rcpf(1.f + e); }
__device__ __forceinline__ float sigmoid_f(float x) { return __builtin_amdgcn_rcpf(1.f + __builtin_amdgcn_exp2f(-1.4426950409f * x)); }
__device__ __forceinline__ ssq_t ss_fix(float v) { return (ssq_t)(long long)(v * 1073741824.0f); }
__device__ __forceinline__ float rstd_of(ssq_t ss, float inv_n) { return rsqrtf((float)ss * (1.0f / 1073741824.0f) * inv_n + EPS); }
__device__ __forceinline__ float wave_sum(float v) {
#pragma unroll
    for (int o = 1; o < 64; o <<= 1) v += __shfl_xor(v, o);
    return v;
}
__device__ __forceinline__ float wave_max(float v) {
#pragma unroll
    for (int o = 1; o < 64; o <<= 1) v = fmaxf(v, __shfl_xor(v, o));
    return v;
}
__device__ __forceinline__ void fadd_atomic(ssq_t* p, float v) { atomicAdd(p, ss_fix(v)); }
__device__ __forceinline__ int tid_now() { int t = threadIdx.x; asm volatile("" : "+v"(t)); return t; }
__device__ __forceinline__ f32x4 gelu4(f32x4 v) { return (f32x4){gelu_t(v[0]), gelu_t(v[1]), gelu_t(v[2]), gelu_t(v[3])}; }
__device__ __forceinline__ v4u pack8(f32x4 a, f32x4 b) { v4u w; w.x = pk2(a[0], a[1]); w.y = pk2(a[2], a[3]); w.z = pk2(b[0], b[1]); w.w = pk2(b[2], b[3]); return w; }
__device__ __forceinline__ float dot4(f32x4 a) { return (a[0] * a[0] + a[1] * a[1]) + (a[2] * a[2] + a[3] * a[3]); }

typedef const f32x4 (&AccRef)[2][2][4][2];
struct EpiSgIn {
    static constexpr bool PERM = true, AFTER_DRAIN = false, PREFETCH = false, INIT_ACC = false;
    const ssq_t* ss; bf16* zu; bf16* zv; bf16* q; ssq_t* ssv; unsigned* sdone;
    __device__ __forceinline__ void operator()(AccRef acc, const pg8::Unit& u, int wr, int wc, int fr, int fq) const {
        asm volatile("" : "+v"(fr), "+v"(fq));
        const int row0 = u.pm * 256 + wr * 64 + fr, colt = u.pn * 256 + wc * 32 + 8 * fq;
        const int kind = u.pn < 6 ? 0 : (u.pn < 12 ? 1 : 2);
#pragma unroll
        for (int ai = 0; ai < 2; ++ai)
#pragma unroll
            for (int m = 0; m < 4; ++m) {
                const int r = row0 + ai * 128 + m * 16; const float rs = rstd_of(ss[r], 1.f / 2048.f); float sq = 0.f;
#pragma unroll
                for (int bj = 0; bj < 2; ++bj) {
                    f32x4 v0 = acc[ai][bj][m][0] * rs, v1 = acc[ai][bj][m][1] * rs; const int c = colt + bj * 128;
                    if (kind < 2) { v0 = gelu4(v0); v1 = gelu4(v1); }
                    if (kind == 1) sq += dot4(v0) + dot4(v1);
                    bf16* dst = kind == 0 ? zu + (size_t)r * TOKW + c : (kind == 1 ? zv + (size_t)r * TOKW + (c - TOKW) : q + (size_t)r * XAW + (c - 2 * TOKW));
                    *(v4u*)dst = pack8(v0, v1);
                }
                if (kind == 1) { sq += __shfl_xor(sq, 16); sq += __shfl_xor(sq, 32); if (fq == 0) fadd_atomic(ssv + r, sq); }
                asm volatile("" ::: "memory");
            }
        if (u.pm == MP / 256) {
            asm volatile("s_waitcnt vmcnt(0)" ::: "memory"); __builtin_amdgcn_s_barrier(); asm volatile("" ::: "memory");
            if (tid_now() == 0) { __builtin_amdgcn_fence(__ATOMIC_RELEASE, "agent"); asm volatile("s_waitcnt vmcnt(0)" ::: "memory"); __hip_atomic_fetch_add(sdone, 1u, __ATOMIC_RELAXED, __HIP_MEMORY_SCOPE_AGENT); }
        }
    }
};
struct EpiRes {
    static constexpr bool PERM = true, AFTER_DRAIN = false, PREFETCH = false, INIT_ACC = true;
    bf16* xb; ssq_t* ssn;
    __device__ __forceinline__ void init_acc(f32x4 (&acc)[2][2][4][2], const pg8::Unit& u, int wr, int wc, int fr, int fq) const {
        const bf16* bp0 = xb + (size_t)(u.pm * 256 + wr * 64 + fr) * D + u.pn * 256 + wc * 32 + 8 * fq;
#pragma unroll
        for (int ai = 0; ai < 2; ++ai)
#pragma unroll
            for (int m = 0; m < 4; ++m)
#pragma unroll
                for (int bj = 0; bj < 2; ++bj) { const v4u w = *(const v4u*)(bp0 + (size_t)(ai * 128 + m * 16) * D + bj * 128);
                    acc[ai][bj][m][0] = (f32x4){bflo(w.x), bfhi(w.x), bflo(w.y), bfhi(w.y)}; acc[ai][bj][m][1] = (f32x4){bflo(w.z), bfhi(w.z), bflo(w.w), bfhi(w.w)}; }
    }
    __device__ __forceinline__ void operator()(AccRef acc, const pg8::Unit& u, int wr, int wc, int fr, int fq) const {
        asm volatile("" : "+v"(fr), "+v"(fq));
        const int row0 = u.pm * 256 + wr * 64 + fr, col0 = u.pn * 256 + wc * 32 + 8 * fq;
#pragma unroll
        for (int ai = 0; ai < 2; ++ai)
#pragma unroll
            for (int m = 0; m < 4; ++m) {
                const int r = row0 + ai * 128 + m * 16; float sq = 0.f; bf16* bp = xb + (size_t)r * D + col0;
#pragma unroll
                for (int bj = 0; bj < 2; ++bj) { const f32x4 o0 = acc[ai][bj][m][0], o1 = acc[ai][bj][m][1]; sq += dot4(o0) + dot4(o1); *(v4u*)(bp + bj * 128) = pack8(o0, o1); }
                sq += __shfl_xor(sq, 16); sq += __shfl_xor(sq, 32); if (fq == 0) fadd_atomic(ssn + r, sq);
                asm volatile("" ::: "memory");
            }
    }
};
struct EpiResFinal {
    static constexpr bool PERM = true, AFTER_DRAIN = false, PREFETCH = false, INIT_ACC = true;
    const bf16* xb; ssq_t* ssn; float* out; const float* gfin; unsigned* pcnt;
    __device__ __forceinline__ void init_acc(f32x4 (&acc)[2][2][4][2], const pg8::Unit& u, int wr, int wc, int fr, int fq) const {
        const bf16* bp0 = xb + (size_t)(u.pm * 256 + wr * 64 + fr) * D + u.pn * 256 + wc * 32 + 8 * fq;
#pragma unroll
        for (int ai = 0; ai < 2; ++ai)
#pragma unroll
            for (int m = 0; m < 4; ++m)
#pragma unroll
                for (int bj = 0; bj < 2; ++bj) { const v4u w = *(const v4u*)(bp0 + (size_t)(ai * 128 + m * 16) * D + bj * 128);
                    acc[ai][bj][m][0] = (f32x4){bflo(w.x), bfhi(w.x), bflo(w.y), bfhi(w.y)}; acc[ai][bj][m][1] = (f32x4){bflo(w.z), bfhi(w.z), bflo(w.w), bfhi(w.w)}; }
    }
    __device__ __forceinline__ void operator()(f32x4 (&acc)[2][2][4][2], const pg8::Unit& u, int wr, int wc, int fr, int fq) const {
        asm volatile("" : "+v"(fr), "+v"(fq));
        const int row0 = u.pm * 256 + wr * 64 + fr, col0 = u.pn * 256 + wc * 32 + 8 * fq;
#pragma unroll
        for (int ai = 0; ai < 2; ++ai)
#pragma unroll
            for (int m = 0; m < 4; ++m) {
                const int r = row0 + ai * 128 + m * 16; float sq = 0.f;
#pragma unroll
                for (int bj = 0; bj < 2; ++bj) sq += dot4(acc[ai][bj][m][0]) + dot4(acc[ai][bj][m][1]);
                sq += __shfl_xor(sq, 16); sq += __shfl_xor(sq, 32); if (fq == 0) fadd_atomic(ssn + r, sq);
            }
        asm volatile("s_waitcnt vmcnt(0)" ::: "memory"); __builtin_amdgcn_s_barrier(); asm volatile("" ::: "memory");
        if (tid_now() == 0) { unsigned* pc = pcnt + 64 * u.pm; __hip_atomic_fetch_add(pc, 1u, __ATOMIC_RELAXED, __HIP_MEMORY_SCOPE_AGENT);
            unsigned sp = 0; while (__hip_atomic_load(pc, __ATOMIC_RELAXED, __HIP_MEMORY_SCOPE_AGENT) < 8u) { __builtin_amdgcn_s_sleep(1); if (++sp > (1u << 22)) break; } }
        asm volatile("" ::: "memory"); __builtin_amdgcn_s_barrier(); asm volatile("" ::: "memory");
        f32x4 gf[2][2];
#pragma unroll
        for (int bj = 0; bj < 2; ++bj) { gf[bj][0] = *(const f32x4*)(gfin + col0 + bj * 128); gf[bj][1] = *(const f32x4*)(gfin + col0 + bj * 128 + 4); }
#pragma unroll
        for (int ai = 0; ai < 2; ++ai)
#pragma unroll
            for (int m = 0; m < 4; ++m) {
                const int r = row0 + ai * 128 + m * 16; const float rs = rstd_of(__hip_atomic_load(ssn + r, __ATOMIC_RELAXED, __HIP_MEMORY_SCOPE_AGENT), 1.f / 2048.f);
                float* op = out + OFF_YP + (size_t)r * D + col0;
#pragma unroll
                for (int bj = 0; bj < 2; ++bj) { *(f32x4*)(op + bj * 128) = acc[ai][bj][m][0] * rs * gf[bj][0]; *(f32x4*)(op + bj * 128 + 4) = acc[ai][bj][m][1] * rs * gf[bj][1]; }
            }
    }
};
__device__ __forceinline__ float dpp_f(float old, float src, const int ctrl_sel) {
    const int o = __builtin_bit_cast(int, old), v = __builtin_bit_cast(int, src); int r;
    if (ctrl_sel == 0) r = __builtin_amdgcn_update_dpp(o, v, 0x111, 0xf, 0xf, false);
    else if (ctrl_sel == 1) r = __builtin_amdgcn_update_dpp(o, v, 0x112, 0xf, 0xf, false);
    else if (ctrl_sel == 2) r = __builtin_amdgcn_update_dpp(o, v, 0x121, 0xf, 0xf, false);
    else r = __builtin_amdgcn_update_dpp(o, v, 0x122, 0xf, 0xf, false);
    return __builtin_bit_cast(float, r);
}
struct EpiUp {
    static constexpr bool PERM = true, AFTER_DRAIN = false, PREFETCH = true, INIT_ACC = false;
    const ssq_t* ss; bf16* yf; float* out; const float* stc; const float* cw; const float* cb; float* fxa; LAS float* halo; int layer; unsigned* sdone;
    __device__ __forceinline__ void prefetch(const pg8::Unit& u, int wid, int lane) const {
        const int arr = wid >> 1, half = wid & 1; const float* src = (arr < 3 ? cw + (size_t)arr * DFF : cb) + u.pn * 128 + half * 64 + lane;
        __builtin_amdgcn_global_load_lds((const unsigned*)src, (LAS unsigned*)(halo + 1024 + arr * 128 + half * 64), 4, 0, 0);
        const unsigned* s2 = (const unsigned*)(ss + u.pm * 256 + wid * 32) + lane;
        __builtin_amdgcn_global_load_lds(s2, (LAS unsigned*)(halo + 1536 + wid * 64), 4, 0, 0);
    }
    typedef float f32x2 __attribute__((ext_vector_type(2)));
    static __device__ __forceinline__ f32x2 silu_gate2(f32x2 cc, f32x2 g) {
        const f32x2 t = cc * (-1.4426950409f); f32x2 e; e.x = __builtin_amdgcn_exp2f(t.x); e.y = __builtin_amdgcn_exp2f(t.y); e = e + 1.0f;
        f32x2 r; r.x = __builtin_amdgcn_rcpf(e.x); r.y = __builtin_amdgcn_rcpf(e.y); return (cc * r) * g;
    }
    __device__ __forceinline__ void operator()(AccRef acc, const pg8::Unit& u, int wr, int wc, int fr, int fq) const {
        asm volatile("" : "+v"(fr), "+v"(fq));
        const int lrow0 = wr * 64 + fr, row0 = u.pm * 256 + lrow0, cl = wc * 32 + 8 * fq, c0 = u.pn * 128 + cl;
        const LAS ssq_t* ssl = (const LAS ssq_t*)(halo + 1536);
        float rs[2][4];
#pragma unroll
        for (int ai = 0; ai < 2; ++ai)
#pragma unroll
            for (int m = 0; m < 4; ++m) rs[ai][m] = rstd_of(ssl[lrow0 + ai * 128 + m * 16], 1.f / 2048.f);
        if (u.pm == MP / 256) {
#pragma unroll
            for (int n = 0; n < 2; ++n) {
                const int c = c0 + 4 * n;
                const f32x4 k0 = *(const LAS f32x4*)(halo + 1024 + cl + 4 * n), k1 = *(const LAS f32x4*)(halo + 1152 + cl + 4 * n), k2 = *(const LAS f32x4*)(halo + 1280 + cl + 4 * n), kb = *(const LAS f32x4*)(halo + 1408 + cl + 4 * n);
#pragma unroll
                for (int ai = 0; ai < 2; ++ai)
#pragma unroll
                    for (int m = 0; m < 4; ++m) {
                        const int r = row0 + ai * 128 + m * 16; if (r >= MREAL) continue;
                        const f32x4 a = acc[ai][0][m][n] * rs[ai][m], g = acc[ai][1][m][n] * rs[ai][m];
                        const float* sp = stc + ((size_t)(r - MP) * 2) * DFF + c; const f32x4 p2 = *(const f32x4*)sp, p1 = *(const f32x4*)(sp + DFF);
                        float* co = out + OFF_CONVS + ((size_t)(layer * MS + (r - MP)) * 2) * DFF + c; *(f32x4*)co = p1; *(f32x4*)(co + DFF) = a;
                        f32x4 y;
#pragma unroll
                        for (int i = 0; i < 4; ++i) { const float cc = kb[i] + k0[i] * p2[i] + k1[i] * p1[i] + k2[i] * a[i]; y[i] = cc * sigmoid_f(cc) * g[i]; }
                        v2u w; w.x = pk2(y[0], y[1]); w.y = pk2(y[2], y[3]); *(v2u*)(yf + (size_t)r * DFF + c) = w;
                    }
            }
            asm volatile("s_waitcnt vmcnt(0)" ::: "memory"); __builtin_amdgcn_s_barrier(); asm volatile("" ::: "memory");
            if (tid_now() == 0) { __builtin_amdgcn_fence(__ATOMIC_RELEASE, "agent"); asm volatile("s_waitcnt vmcnt(0)" ::: "memory"); __hip_atomic_fetch_add(sdone, 1u, __ATOMIC_RELAXED, __HIP_MEMORY_SCOPE_AGENT); }
            return;
        }
        float* const fxg = fxa + (WS_FXG - WS_FXA) / 4;
        if (fr >= 14) {
#pragma unroll
            for (int ai = 0; ai < 2; ++ai)
#pragma unroll
                for (int n = 0; n < 2; ++n) *(LAS f32x4*)(halo + ((2 * ai + wr) * 2 + (fr - 14)) * 128 + cl + 4 * n) = acc[ai][0][3][n] * rs[ai][3];
        }
        asm volatile("s_waitcnt lgkmcnt(0)" ::: "memory"); __builtin_amdgcn_s_barrier(); asm volatile("" ::: "memory");
        f32x2 kk[2][8];
#pragma unroll
        for (int n = 0; n < 2; ++n) {
            const f32x4 k0 = *(const LAS f32x4*)(halo + 1024 + cl + 4 * n), k1 = *(const LAS f32x4*)(halo + 1152 + cl + 4 * n), k2 = *(const LAS f32x4*)(halo + 1280 + cl + 4 * n), kb = *(const LAS f32x4*)(halo + 1408 + cl + 4 * n);
            kk[n][0] = (f32x2){k0[0], k0[1]}; kk[n][1] = (f32x2){k0[2], k0[3]}; kk[n][2] = (f32x2){k1[0], k1[1]}; kk[n][3] = (f32x2){k1[2], k1[3]};
            kk[n][4] = (f32x2){k2[0], k2[1]}; kk[n][5] = (f32x2){k2[2], k2[3]}; kk[n][6] = (f32x2){kb[0], kb[1]}; kk[n][7] = (f32x2){kb[2], kb[3]};
        }
#pragma unroll
        for (int ai = 0; ai < 2; ++ai) {
            f32x4 prev[2];
#pragma unroll
            for (int n = 0; n < 2; ++n) { prev[n] = (f32x4){0.f, 0.f, 0.f, 0.f};
                if ((ai + wr) > 0 && fr >= 14) prev[n] = *(const LAS f32x4*)(halo + ((2 * ai + wr - 1) * 2 + (fr - 14)) * 128 + cl + 4 * n); }
#pragma unroll
            for (int m = 0; m < 4; ++m) {
                const int r = row0 + ai * 128 + m * 16; v4u w;
#pragma unroll
                for (int n = 0; n < 2; ++n) {
                    const int c = c0 + 4 * n; const f32x4 a = acc[ai][0][m][n] * rs[ai][m], g = acc[ai][1][m][n] * rs[ai][m];
                    f32x4 p1, p2;
#pragma unroll
                    for (int i = 0; i < 4; ++i) { p1[i] = dpp_f(dpp_f(0.f, prev[n][i], 2), a[i], 0); p2[i] = dpp_f(dpp_f(0.f, prev[n][i], 3), a[i], 1); }
                    const f32x2 ccl = kk[n][6] + kk[n][0] * (f32x2){p2[0], p2[1]} + kk[n][2] * (f32x2){p1[0], p1[1]} + kk[n][4] * (f32x2){a[0], a[1]};
                    const f32x2 cch = kk[n][7] + kk[n][1] * (f32x2){p2[2], p2[3]} + kk[n][3] * (f32x2){p1[2], p1[3]} + kk[n][5] * (f32x2){a[2], a[3]};
                    const f32x2 yl = silu_gate2(ccl, (f32x2){g[0], g[1]}), yh = silu_gate2(cch, (f32x2){g[2], g[3]});
                    if (n == 0) { w.x = pk2(yl.x, yl.y); w.y = pk2(yh.x, yh.y); } else { w.z = pk2(yl.x, yl.y); w.w = pk2(yh.x, yh.y); }
                    if (ai == 0 && m == 0) { if (wr == 0 && fr < 2) { *(f32x4*)(fxa + ((size_t)(u.pm * 4 + fr)) * DFF + c) = a; *(f32x4*)(fxg + ((size_t)(u.pm * 2 + fr)) * DFF + c) = g; } }
                    if (ai == 1 && m == 3) { if (wr == 1 && fr >= 14) { *(f32x4*)(fxa + ((size_t)(u.pm * 4 + fr - 12)) * DFF + c) = a;
                        if ((u.pm & 7) == 7) *(f32x4*)(out + OFF_CONVP + ((size_t)((layer * 4 + (u.pm >> 3)) * 2 + (fr - 14))) * DFF + c) = a; } }
                    prev[n] = a;
                }
                *(v4u*)(yf + (size_t)r * DFF + c0) = w;
            }
        }
    }
};
struct EpiSsmIn {
    static constexpr bool PERM = true, AFTER_DRAIN = false, PREFETCH = false, INIT_ACC = false;
    const ssq_t* ss; bf16* uh; float* us; bf16* q;
    __device__ __forceinline__ void operator()(AccRef acc, const pg8::Unit& u, int wr, int wc, int fr, int fq) const {
        asm volatile("" : "+v"(fr), "+v"(fq));
        const int row0 = u.pm * 256 + wr * 64 + fr, colt = u.pn * 256 + wc * 32 + 8 * fq;
#pragma unroll
        for (int ai = 0; ai < 2; ++ai)
#pragma unroll
            for (int m = 0; m < 4; ++m) {
                const int r = row0 + ai * 128 + m * 16; const float rs = rstd_of(ss[r], 1.f / 2048.f);
#pragma unroll
                for (int bj = 0; bj < 2; ++bj) {
                    const f32x4 v0 = acc[ai][bj][m][0] * rs, v1 = acc[ai][bj][m][1] * rs; const int c = colt + bj * 128;
                    if (u.pn < 6) {
                        if (r < MP) { const int h = c >> 4, c0 = c & 15; *(v4u*)(uh + ((size_t)(h * 512 + (r >> 4)) * KH + (r & 15) * 16 + c0)) = pack8(v0, v1); }
                        else if (r < MREAL) { float* o = us + (size_t)(r - MP) * TOKW + c; *(f32x4*)o = v0; *(f32x4*)(o + 4) = v1; }
                    } else *(v4u*)(q + (size_t)r * XAW + (c - TOKW)) = pack8(v0, v1);
                }
                asm volatile("" ::: "memory");
            }
    }
};
struct EpiToep {
    static constexpr bool PERM = true, AFTER_DRAIN = false, PREFETCH = false, INIT_ACC = false;
    bf16* yb;
    __device__ __forceinline__ void operator()(AccRef acc, const pg8::Unit& u, int wr, int wc, int fr, int fq) const {
        asm volatile("" : "+v"(fr), "+v"(fq));
        const int h = u.pn, mh = u.pm - 2 * h;
#pragma unroll
        for (int ai = 0; ai < 2; ++ai)
#pragma unroll
            for (int m = 0; m < 4; ++m) {
                const int ml = mh * 256 + ai * 128 + wr * 64 + m * 16 + fr;
#pragma unroll
                for (int bj = 0; bj < 2; ++bj) {
                    const int cl = bj * 128 + wc * 32 + 8 * fq, tau = cl >> 4, c0 = cl & 15;
                    *(v4u*)(yb + (size_t)(ml * 16 + tau) * TOKW + h * 16 + c0) = pack8(gelu4(acc[ai][bj][m][0]), gelu4(acc[ai][bj][m][1]));
                    __builtin_amdgcn_sched_barrier(0);
                }
            }
    }
};
struct EpiGlu {
    static constexpr bool PERM = true, AFTER_DRAIN = false, PREFETCH = false, INIT_ACC = false;
    const bf16* yb; const float* bias; bf16* mix;
    __device__ __forceinline__ void operator()(AccRef acc, const pg8::Unit& u, int wr, int wc, int fr, int fq) const {
        asm volatile("" : "+v"(fr), "+v"(fq));
        const int row0 = u.pm * 256 + wr * 64 + fr, colt = u.pn * 256 + wc * 32 + 8 * fq;
#pragma unroll
        for (int ai = 0; ai < 2; ++ai)
#pragma unroll
            for (int m = 0; m < 4; ++m) {
                const int r = row0 + ai * 128 + m * 16;
#pragma unroll
                for (int bj = 0; bj < 2; ++bj) {
                    const int c = colt + bj * 128; const f32x4 b0 = *(const f32x4*)(bias + c), b1 = *(const f32x4*)(bias + c + 4);
                    const v4u yw = *(const v4u*)(yb + (size_t)r * TOKW + c);
                    const f32x4 g0 = acc[ai][bj][m][0] + b0, g1 = acc[ai][bj][m][1] + b1;
                    f32x4 o0, o1;
                    o0[0] = bflo(yw.x) * sigmoid_f(g0[0]); o0[1] = bfhi(yw.x) * sigmoid_f(g0[1]); o0[2] = bflo(yw.y) * sigmoid_f(g0[2]); o0[3] = bfhi(yw.y) * sigmoid_f(g0[3]);
                    o1[0] = bflo(yw.z) * sigmoid_f(g1[0]); o1[1] = bfhi(yw.z) * sigmoid_f(g1[1]); o1[2] = bflo(yw.w) * sigmoid_f(g1[2]); o1[3] = bfhi(yw.w) * sigmoid_f(g1[3]);
                    *(v4u*)(mix + (size_t)r * D + c) = pack8(o0, o1);
                    asm volatile("" ::: "memory");
                }
            }
    }
};
struct EpiMem {
    static constexpr bool PERM = false, AFTER_DRAIN = false, PREFETCH = false, INIT_ACC = false;
    const ssq_t* ssm; float* out; bf16* mkv;
    __device__ __forceinline__ void operator()(AccRef acc, const pg8::Unit& u, int wr, int wc, int fr, int fq) const {
        asm volatile("" : "+v"(fr), "+v"(fq));
        const int row0 = u.pm * 256 + wr * 64 + fr, col0 = u.pn * 256 + wc * 32 + 4 * fq;
#pragma unroll
        for (int ai = 0; ai < 2; ++ai)
#pragma unroll
            for (int m = 0; m < 4; ++m) {
                const int r = row0 + ai * 128 + m * 16; const float rs = rstd_of(ssm[r], 1.f / 2048.f);
#pragma unroll
                for (int bj = 0; bj < 2; ++bj)
#pragma unroll
                    for (int n = 0; n < 2; ++n) { const int c = col0 + bj * 128 + n * 16, li = c >> 10, cc = c & 1023; const f32x4 v = acc[ai][bj][m][n] * rs;
                        *(f32x4*)(out + (cc < 512 ? OFF_MK : OFF_MV) + (size_t)(li * 1024 + r) * 512 + (cc & 511)) = v;
                        v2u w; w.x = pk2(v[0], v[1]); w.y = pk2(v[2], v[3]); *(v2u*)(mkv + (size_t)(li * 1024 + r) * 1024 + cc) = w; }
            }
    }
};
struct MemOrder {
    int G, c, first, count, base;
    __device__ __forceinline__ bool next(int i, pg8::Unit& u) const { const int q = (c - first + G) % G + i * G; if (q >= count) return false; const int Q = base + q; u.pm = Q & 3; u.pn = Q >> 2; return true; }
    __device__ __forceinline__ void a_ready(const pg8::Unit&) const {}
    __device__ __forceinline__ void done(const pg8::Unit&) const {}
};
struct UpOrder {
    pg8::StaticOrder base; int G, c;
    __device__ __forceinline__ bool next(int i, pg8::Unit& u) const { const long L = (long)i * G + c; if (L < NUP / 256) { u.pm = MP / 256; u.pn = (int)L; return true; } return base.at(L - NUP / 256, u); }
    __device__ __forceinline__ void a_ready(const pg8::Unit&) const {}
    __device__ __forceinline__ void done(const pg8::Unit&) const {}
};
struct SgOrder {
    pg8::StaticOrder base; int G, c;
    __device__ __forceinline__ bool next(int i, pg8::Unit& u) const { const long L = (long)i * G + c; if (L < SGN / 256) { u.pm = MP / 256; u.pn = (int)L; return true; } return base.at(L - SGN / 256, u); }
    __device__ __forceinline__ void a_ready(const pg8::Unit&) const {}
    __device__ __forceinline__ void done(const pg8::Unit&) const {}
};
struct ToepOrder {
    int G, c;
    __device__ __forceinline__ bool next(int i, pg8::Unit& u) const { const int L = i * G + c; if (L >= 2 * NGRP) return false; const int h = L >> 1; u.pm = 2 * h + (L & 1); u.pn = h; return true; }
    __device__ __forceinline__ void a_ready(const pg8::Unit&) const {}
    __device__ __forceinline__ void done(const pg8::Unit&) const {}
};

constexpr int P0_TLD = 130;
constexpr int P0_T0 = 896, P0_T1 = P0_T0 + 512, P0_T2 = P0_T1 + 512, P0_T3 = P0_T2 + 512, P0_T4 = P0_T3 + 288, P0_T5 = P0_T4 + 5504, P0_T6 = P0_T5 + 2752, P0_NTILES = P0_T6 + 512;
constexpr int P0_NOW = 8752, P0_DEF2 = 1392, P0_DEF3 = 1344;
__device__ __forceinline__ int p0_remap_now(int c) {
    if (c < 448) return c; c -= 448; if (c < 256) return 896 + c; c -= 256; if (c < 256) return 1408 + c; c -= 256; if (c < 256) return 1920 + c; c -= 256;
    if (c < 144) return 2432 + c; c -= 144; if (c < 5504) return 2720 + c; c -= 5504; if (c < 1376) return 8224 + c; c -= 1376; return 10976 + c;
}
__device__ __forceinline__ int p0_remap_def(int layer, int c) {
    if (layer == 2) { if (c < 448) return 448 + c; c -= 448; if (c < 256) return 1664 + c; c -= 256; return 9600 + c; }
    if (c < 256) return 1152 + c; c -= 256; if (c < 256) return 2176 + c; c -= 256; if (c < 144) return 2576 + c; c -= 144; return 10288 + c;
}
static_assert(P0_NOW + P0_DEF2 + P0_DEF3 == P0_NTILES, "tile split");
struct P0Desc { const float* W; const float* gn; bf16* WT; int K, N, roff, tile, perm; };
struct Args;
__device__ __forceinline__ P0Desc p0_decode(int t, const float* const* in, unsigned char* wsb) {
    P0Desc d; d.gn = nullptr; d.roff = 0; d.perm = 0;
    if (t < P0_T0) { const int mi = t / 448; d.tile = t - mi * 448; d.W = in[13] + (size_t)mi * D * SGN; d.gn = in[8] + (2 * mi) * D; d.K = D; d.N = SGN; d.WT = (bf16*)(wsb + WS_WSGIN) + (size_t)mi * SGN * D; }
    else if (t < P0_T1) { t -= P0_T0; const int mi = t >> 8; d.tile = t & 255; d.W = in[18] + (size_t)mi * D * D; d.gn = in[8] + (2 * mi + 1) * D; d.K = D; d.N = D; d.WT = (bf16*)(wsb + WS_WSSMIN) + (size_t)mi * D * D; }
    else if (t < P0_T2) { t -= P0_T1; const int mi = t >> 8; d.tile = t & 255; d.W = in[14] + (size_t)mi * D * D; d.K = D; d.N = D; d.WT = (bf16*)(wsb + WS_WSGOUT) + (size_t)mi * D * D; }
    else if (t < P0_T3) { t -= P0_T2; const int mi = t >> 8; d.tile = t & 255; d.W = in[19] + (size_t)mi * D * D; d.K = D; d.N = D; d.WT = (bf16*)(wsb + WS_WSSMOUT) + (size_t)mi * D * D; }
    else if (t < P0_T4) { t -= P0_T3; const int mi = t / 144; d.tile = t - mi * 144; d.W = in[28] + (size_t)mi * TOKW * TOKW; d.K = TOKW; d.N = TOKW; d.WT = (bf16*)(wsb + WS_WGLU) + (size_t)mi * TOKW * TOKW; }
    else if (t < P0_T5) { t -= P0_T4; const int mi = t / 1376; d.tile = t - mi * 1376; d.W = in[30] + (size_t)mi * D * NUP; d.gn = in[9] + mi * D; d.K = D; d.N = NUP; d.WT = (bf16*)(wsb + WS_WUP) + (size_t)mi * NUP * D; d.perm = 1; }
    else if (t < P0_T6) { t -= P0_T5; const int mi = t / 688; d.tile = t - mi * 688; d.W = in[33] + (size_t)mi * DFF * D; d.K = DFF; d.N = D; d.WT = (bf16*)(wsb + WS_WDOWN) + (size_t)mi * D * DFF; }
    else { t -= P0_T6; const int mi = t >> 7; d.tile = t & 127; d.W = in[12] + (size_t)mi * D * 1024; d.gn = in[10] + mi * D; d.K = D; d.N = 1024; d.WT = (bf16*)(wsb + WS_WMEM); d.roff = mi * 1024; }
    return d;
}
__device__ __forceinline__ void p0_load(const P0Desc& d, f32x4 (&v)[8], float (&gv)[8], int tid) {
    const int nbn = d.N >> 7, kb = d.tile / nbn, nb = d.tile - kb * nbn; const float* p = d.W + (size_t)((kb << 7) + (tid >> 5)) * d.N + (nb << 7) + (tid & 31) * 4;
#pragma unroll
    for (int it = 0; it < 8; ++it) v[it] = __builtin_nontemporal_load((const f32x4*)(p + (size_t)(16 * it) * d.N));
    const float* gp = d.gn ? d.gn + (kb << 7) + (tid >> 5) : nullptr;
#pragma unroll
    for (int it = 0; it < 8; ++it) gv[it] = gp ? gp[16 * it] : 1.f;
}
__device__ __forceinline__ void p0_to_lds(const P0Desc& d, const f32x4 (&v)[8], const float (&gv)[8], LAS bf16* T, int tid) {
    const int kq = tid >> 5, n4 = (tid & 31) * 4;
#pragma unroll
    for (int it = 0; it < 8; ++it) { const int kk = kq + 16 * it; const float g = gv[it];
        LAS unsigned* p = (LAS unsigned*)(T + kk * P0_TLD + n4); p[0] = pk2(v[it][0] * g, v[it][1] * g); p[1] = pk2(v[it][2] * g, v[it][3] * g); }
}
__device__ __forceinline__ void p0_store(const P0Desc& d, const LAS bf16* T, int tid) {
    const int nbn = d.N >> 7, kb = d.tile / nbn, nb = d.tile - kb * nbn, k0 = kb << 7, n0 = (d.perm ? (nb < 43 ? 2 * nb : 2 * (nb - 43) + 1) : nb) << 7;
#pragma unroll
    for (int j = 0; j < 4; ++j) { const int p = tid + 512 * j, n = p >> 4, kg = p & 15; const LAS bf16* s_ = T + (kg * 8) * P0_TLD + n;
        v4u o; o.x = (unsigned)s_[0] | ((unsigned)s_[P0_TLD] << 16); o.y = (unsigned)s_[2 * P0_TLD] | ((unsigned)s_[3 * P0_TLD] << 16);
        o.z = (unsigned)s_[4 * P0_TLD] | ((unsigned)s_[5 * P0_TLD] << 16); o.w = (unsigned)s_[6 * P0_TLD] | ((unsigned)s_[7 * P0_TLD] << 16);
        __builtin_nontemporal_store(o, (v4u*)(d.WT + (size_t)(d.roff + n0 + n) * d.K + k0 + kg * 8)); }
}
__device__ __forceinline__ void p0_queue(LAS unsigned char* lds, volatile LAS unsigned* qw, unsigned* q, int layer, int ntiles, const float* const* in, unsigned char* ws, int tid) {
    LAS bf16* T0 = (LAS bf16*)lds; LAS bf16* T1 = (LAS bf16*)(lds + 128 * P0_TLD * 2); LAS bf16* T2 = (LAS bf16*)(lds + 2 * 128 * P0_TLD * 2);
    f32x4 v0[8], v1[8], v2[8]; float g0_[8], g1_[8], g2_[8]; P0Desc d0, d1, d2, e0, e1, e2;
    if (tid == 0) qw[0] = __hip_atomic_fetch_add(q, 3u, __ATOMIC_RELAXED, __HIP_MEMORY_SCOPE_AGENT);
    __syncthreads();
    int t = (int)qw[0];
    __syncthreads();
    d0 = p0_decode(p0_remap_def(layer, t < ntiles ? t : 0), in, ws); d1 = p0_decode(p0_remap_def(layer, t + 1 < ntiles ? t + 1 : 0), in, ws); d2 = p0_decode(p0_remap_def(layer, t + 2 < ntiles ? t + 2 : 0), in, ws);
    if (t < ntiles) p0_load(d0, v0, g0_, tid);
    if (t + 1 < ntiles) p0_load(d1, v1, g1_, tid);
    if (t + 2 < ntiles) p0_load(d2, v2, g2_, tid);
#pragma unroll 1
    while (t < ntiles) {
        const bool has1 = t + 1 < ntiles, has2 = t + 2 < ntiles; e0 = d0; e1 = d1; e2 = d2;
        p0_to_lds(d0, v0, g0_, T0, tid);
        if (tid == 0) qw[0] = __hip_atomic_fetch_add(q, 3u, __ATOMIC_RELAXED, __HIP_MEMORY_SCOPE_AGENT);
        __syncthreads();
        const int tn = (int)qw[0];
        if (tn < ntiles) { e0 = p0_decode(p0_remap_def(layer, tn), in, ws); p0_load(e0, v0, g0_, tid); }
        p0_store(d0, T0, tid);
        if (has1) p0_to_lds(d1, v1, g1_, T1, tid);
        __syncthreads();
        if (tn + 1 < ntiles) { e1 = p0_decode(p0_remap_def(layer, tn + 1), in, ws); p0_load(e1, v1, g1_, tid); }
        if (has1) p0_store(d1, T1, tid);
        if (has2) p0_to_lds(d2, v2, g2_, T2, tid);
        __syncthreads();
        if (tn + 2 < ntiles) { e2 = p0_decode(p0_remap_def(layer, tn + 2), in, ws); p0_load(e2, v2, g2_, tid); }
        if (has2) p0_store(d2, T2, tid);
        t = tn; d0 = e0; d1 = e1; d2 = e2;
    }
    __syncthreads();
}
__device__ __forceinline__ void p0_row(const float* src, float* dstf, bf16* dstb, ssq_t* ssp, int lane) {
    f32x4 v[8]; float s = 0.f;
#pragma unroll
    for (int j = 0; j < 8; ++j) { v[j] = src ? ((const f32x4*)src)[lane + 64 * j] : (f32x4){0.f, 0.f, 0.f, 0.f}; s += dot4(v[j]); }
    s = wave_sum(s);
#pragma unroll
    for (int j = 0; j < 8; ++j) { if (dstf) ((f32x4*)dstf)[lane + 64 * j] = v[j]; v2u w; w.x = pk2(v[j][0], v[j][1]); w.y = pk2(v[j][2], v[j][3]); ((v2u*)dstb)[lane + 64 * j] = w; }
    if (lane == 0) *ssp = ss_fix(s);
}
__device__ __forceinline__ void p0_row_load(const float* src, f32x4 (&v)[8], int lane) {
#pragma unroll
    for (int j = 0; j < 8; ++j) v[j] = __builtin_nontemporal_load((const f32x4*)src + lane + 64 * j);
}
__device__ __forceinline__ void p0_row_finish(const f32x4 (&vin)[8], bool zero, bf16* dstb, ssq_t* ssp, int lane) {
    float s = 0.f; f32x4 v[8];
#pragma unroll
    for (int j = 0; j < 8; ++j) { v[j] = zero ? (f32x4){0.f, 0.f, 0.f, 0.f} : vin[j]; s += dot4(v[j]); }
    s = wave_sum(s);
#pragma unroll
    for (int j = 0; j < 8; ++j) { v2u w; w.x = pk2(v[j][0], v[j][1]); w.y = pk2(v[j][2], v[j][3]); ((v2u*)dstb)[lane + 64 * j] = w; }
    if (lane == 0) *ssp = ss_fix(s);
}
__device__ __forceinline__ void s5_tables(LAS float* L, int j, int h, const float* lam_re, const float* lam_im, const float* log_dt, const float* b_re, const float* b_im,
                                          const float* c_re, const float* c_im, const float* dvec, bf16* TB, bf16* BT2, float* LBT, float* LB16, float* BBART, int tid) {
    LAS float* PWr = L; LAS float* PWi = L + 1088; LAS float* BBr = L + 2176; LAS float* BBi = L + 3200; LAS float* Cr = L + 4224; LAS float* Ci = L + 5312; LAS float* KM = L + 6400;
    const int gh = j * NGRP + h;
    if (tid < 64) {
        const int p = tid, idx = gh * 64 + p; const float lr = lam_re[idx], li = lam_im[idx], dt = expf(log_dt[gh]);
        const float ar = lr * dt, ai = li * dt, mag = expf(ar); float sn, cs; sincosf(ai, &sn, &cs);
        const float lbr = mag * cs, lbi = mag * sn; const float sh = sinf(0.5f * ai);
        const float nr = expm1f(ar) * cs - 2.f * sh * sh, ni = lbi, den = lr * lr + li * li;
        const float kr = (nr * lr + ni * li) / den, ki = (ni * lr - nr * li) / den;
        float pr = 1.f, pi = 0.f;
#pragma unroll
        for (int n = 0; n < 17; ++n) { PWr[p * 17 + n] = pr; PWi[p * 17 + n] = pi; if (n == 16) { LB16[idx * 2] = pr; LB16[idx * 2 + 1] = pi; } const float t = pr * lbr - pi * lbi; pi = pr * lbi + pi * lbr; pr = t; }
        LBT[idx * 2] = lbr; LBT[idx * 2 + 1] = lbi;
#pragma unroll
        for (int c = 0; c < 16; ++c) { const float br = b_re[(size_t)idx * 16 + c], bi = b_im[(size_t)idx * 16 + c]; const float xr = kr * br - ki * bi, xi = kr * bi + ki * br;
            BBr[p * 16 + c] = xr; BBi[p * 16 + c] = xi; BBART[((size_t)idx * 16 + c) * 2] = xr; BBART[((size_t)idx * 16 + c) * 2 + 1] = xi; }
    }
#pragma unroll
    for (int i = 0; i < 2; ++i) { const int e = tid + 512 * i, ci_ = (e & 63) * 17 + (e >> 6); Cr[ci_] = c_re[(size_t)gh * 1024 + e]; Ci[ci_] = c_im[(size_t)gh * 1024 + e]; }
    __syncthreads();
    {
        const int lane = tid & 63, w = tid >> 6, ci16 = lane & 15, kq = lane >> 4;
#pragma unroll 1
        for (int dd = 0; dd < 2; ++dd) {
            const int dl = 2 * w + dd; f32x4 acc = (f32x4){0.f, 0.f, 0.f, 0.f};
#pragma unroll 8
            for (int sblk = 0; sblk < 32; ++sblk) {
                const int k = 4 * sblk + kq, p = k & 63; const bool im = k >= 64;
                const float a = im ? -Ci[p * 17 + ci16] : Cr[p * 17 + ci16];
                const float wr_ = PWr[p * 17 + dl], wi_ = PWi[p * 17 + dl], xr = BBr[p * 16 + ci16], xi = BBi[p * 16 + ci16];
                const float b = im ? (wr_ * xi + wi_ * xr) : (wr_ * xr - wi_ * xi);
                acc = __builtin_amdgcn_mfma_f32_16x16x4f32(a, b, acc, 0, 0, 0);
            }
#pragma unroll
            for (int jj = 0; jj < 4; ++jj) { const int c = 4 * kq + jj; float v = acc[jj]; if (dl == 0 && c == ci16) v += dvec[j * TOKW + h * 16 + c]; KM[dl * 256 + c * 16 + ci16] = v; }
        }
    }
    __syncthreads();
#pragma unroll 1
    for (int it = 0; it < 24; ++it) {
        const int grp = tid + 512 * it, row = grp / 48, cg = grp % 48, tau = row >> 4, c = row & 15; float v[8];
        if (cg < 32) { const int sg = cg >> 1, c0 = (cg & 1) * 8;
#pragma unroll
            for (int i = 0; i < 8; ++i) v[i] = sg <= tau ? KM[(tau - sg) * 256 + c * 16 + c0 + i] : 0.f; }
        else if (cg < 40) {
#pragma unroll
            for (int i = 0; i < 8; ++i) { const int p = (cg - 32) * 8 + i; v[i] = Cr[p * 17 + c] * PWr[p * 17 + tau + 1] - Ci[p * 17 + c] * PWi[p * 17 + tau + 1]; } }
        else {
#pragma unroll
            for (int i = 0; i < 8; ++i) { const int p = (cg - 40) * 8 + i; v[i] = -(Cr[p * 17 + c] * PWi[p * 17 + tau + 1] + Ci[p * 17 + c] * PWr[p * 17 + tau + 1]); } }
        v4u w; w.x = pk2(v[0], v[1]); w.y = pk2(v[2], v[3]); w.z = pk2(v[4], v[5]); w.w = pk2(v[6], v[7]);
        *(v4u*)(TB + ((size_t)gh * 256 + row) * KH + cg * 8) = w;
    }
#pragma unroll 1
    for (int it = 0; it < 8; ++it) {
        const int grp = tid + 512 * it, row = grp >> 5, cg = grp & 31, ri = row >> 6, p = row & 63, n = 15 - (cg >> 1), c0 = (cg & 1) * 8; float v[8];
        const float wr_ = PWr[p * 17 + n], wi_ = PWi[p * 17 + n];
#pragma unroll
        for (int i = 0; i < 8; ++i) { const float xr = BBr[p * 16 + c0 + i], xi = BBi[p * 16 + c0 + i]; v[i] = ri == 0 ? (wr_ * xr - wi_ * xi) : (wr_ * xi + wi_ * xr); }
        v4u w; w.x = pk2(v[0], v[1]); w.y = pk2(v[2], v[3]); w.z = pk2(v[4], v[5]); w.w = pk2(v[6], v[7]);
        *(v4u*)(BT2 + ((size_t)gh * 128 + row) * 256 + cg * 8) = w;
    }
    __syncthreads();
}

typedef short s4v __attribute__((ext_vector_type(4)));
constexpr int KS_LD = 136, VT_LD = 144, VT_OFF = 256 * KS_LD * 2;
__device__ __forceinline__ void attn_prompt_unit(LAS unsigned char* lds, const bf16* q, const bf16* mkv_l, bf16* mix, int unit, int tid) {
    const int b = unit >> 6, hd = (unit >> 4) & 3, qb = unit & 15, lane = tid & 63, w = tid >> 6, fr = lane & 15, fq = lane >> 4;
    LAS bf16* Ks = (LAS bf16*)lds; LAS bf16* Vt = (LAS bf16*)(lds + VT_OFF);
    const bf16* kvb = mkv_l + (size_t)(b * 256) * 1024 + hd * 128;
#pragma unroll
    for (int it = 0; it < 8; ++it) { const int id = tid + 512 * it, key = id >> 4, part = id & 15;
        const v4u kw = *(const v4u*)(kvb + (size_t)key * 1024 + part * 8); *(LAS v4u*)(Ks + key * KS_LD + part * 8) = kw;
        const v4u vw = *(const v4u*)(kvb + (size_t)key * 1024 + 512 + part * 8); *(LAS v4u*)(Vt + key * VT_LD + part * 8) = vw; }
    const int r = b * SEQ + qb * 128 + w * 16 + fr;
    bf16x8 qf[4];
#pragma unroll
    for (int ks = 0; ks < 4; ++ks) qf[ks] = *(const bf16x8*)(q + (size_t)r * XAW + hd * 128 + ks * 32 + fq * 8);
    __syncthreads();
    f32x4 s[16];
#pragma unroll
    for (int t = 0; t < 16; ++t) { s[t] = (f32x4){0.f, 0.f, 0.f, 0.f};
#pragma unroll
        for (int ks = 0; ks < 4; ++ks) { const bf16x8 kf = *(const LAS bf16x8*)(Ks + (t * 16 + fr) * KS_LD + ks * 32 + fq * 8); s[t] = __builtin_amdgcn_mfma_f32_16x16x32_bf16(kf, qf[ks], s[t], 0, 0, 0); } }
    float mx = -3.0e38f;
#pragma unroll
    for (int t = 0; t < 16; ++t) mx = fmaxf(fmaxf(fmaxf(s[t][0], s[t][1]), fmaxf(s[t][2], s[t][3])), mx);
    mx = fmaxf(mx, __shfl_xor(mx, 16)); mx = fmaxf(mx, __shfl_xor(mx, 32));
    const float sc = 0.08838834764831845f * 1.4426950408889634f; float sum = 0.f;
#pragma unroll
    for (int t = 0; t < 16; ++t) {
#pragma unroll
        for (int jj = 0; jj < 4; ++jj) { const float p = __builtin_amdgcn_exp2f((s[t][jj] - mx) * sc); s[t][jj] = p; sum += p; } }
    sum += __shfl_xor(sum, 16); sum += __shfl_xor(sum, 32);
    f32x4 o[8];
#pragma unroll
    for (int dt = 0; dt < 8; ++dt) o[dt] = (f32x4){0.f, 0.f, 0.f, 0.f};
#pragma unroll
    for (int kk = 0; kk < 8; ++kk) {
        v4u pw; pw.x = pk2(s[2 * kk][0], s[2 * kk][1]); pw.y = pk2(s[2 * kk][2], s[2 * kk][3]); pw.z = pk2(s[2 * kk + 1][0], s[2 * kk + 1][1]); pw.w = pk2(s[2 * kk + 1][2], s[2 * kk + 1][3]);
        const bf16x8 pf = __builtin_bit_cast(bf16x8, pw);
#pragma unroll
        for (int dt = 0; dt < 8; ++dt) { const LAS bf16* vp = Vt + (kk * 32 + fq * 4 + (fr >> 2)) * VT_LD + dt * 16 + (fr & 3) * 4;
            const v2u lo2 = __builtin_bit_cast(v2u, __builtin_amdgcn_ds_read_tr16_b64_v4i16((LAS s4v*)vp));
            const v2u hi2 = __builtin_bit_cast(v2u, __builtin_amdgcn_ds_read_tr16_b64_v4i16((LAS s4v*)(vp + 16 * VT_LD)));
            v4u vw; vw.x = lo2.x; vw.y = lo2.y; vw.z = hi2.x; vw.w = hi2.y;
            o[dt] = __builtin_amdgcn_mfma_f32_16x16x32_bf16(__builtin_bit_cast(bf16x8, vw), pf, o[dt], 0, 0, 0); } }
    const float inv = 1.f / sum;
#pragma unroll
    for (int dt = 0; dt < 8; ++dt) { v2u w2; w2.x = pk2(o[dt][0] * inv, o[dt][1] * inv); w2.y = pk2(o[dt][2] * inv, o[dt][3] * inv);
        *(v2u*)(mix + (size_t)r * D + TOKW + hd * 128 + dt * 16 + fq * 4) = w2; }
    __syncthreads();
}
template <int N> __device__ __forceinline__ float dpp_ror(float v) { return __builtin_bit_cast(float, __builtin_amdgcn_update_dpp(0, __builtin_bit_cast(int, v), 0x120 + N, 0xf, 0xf, false)); }
__device__ __forceinline__ float row16_sum(float d) { d += dpp_ror<8>(d); d += dpp_ror<4>(d); d += dpp_ror<2>(d); d += dpp_ror<1>(d); return d; }
__device__ __forceinline__ void attn_sample_unit(LAS unsigned char* lds, const bf16* q, const float* ck, const float* cv, bf16* mix, int li, int unit, int tid) {
    const int b = unit >> 1, hp = unit & 1, lane = tid & 63, w = tid >> 6, hd = 2 * hp + (w >> 2), kq = (w & 3) * 64, dd = lane & 15, kg = lane >> 4;
    LAS float* red = (LAS float*)lds;
    const v4u qw = *(const v4u*)(q + (size_t)(MP + b) * XAW + hd * 128 + dd * 8);
    const float qv[8] = {bflo(qw.x), bfhi(qw.x), bflo(qw.y), bfhi(qw.y), bflo(qw.z), bfhi(qw.z), bflo(qw.w), bfhi(qw.w)};
    const size_t base = ((size_t)(li * MS + b) * 256) * 512 + hd * 128 + dd * 8 + (size_t)(kq + kg) * 512;
    const float* kp = ck + base; const float* vp = cv + base;
    f32x4 kr[16][2];
#pragma unroll
    for (int it = 0; it < 16; ++it) { kr[it][0] = __builtin_nontemporal_load((const f32x4*)(kp + (size_t)it * 2048)); kr[it][1] = __builtin_nontemporal_load((const f32x4*)(kp + (size_t)it * 2048 + 4)); }
    __builtin_amdgcn_sched_barrier(0);
    float sc[16];
#pragma unroll
    for (int it = 0; it < 16; ++it) { const f32x4 k0 = kr[it][0], k1 = kr[it][1];
        sc[it] = row16_sum(qv[0] * k0[0] + qv[1] * k0[1] + qv[2] * k0[2] + qv[3] * k0[3] + qv[4] * k1[0] + qv[5] * k1[1] + qv[6] * k1[2] + qv[7] * k1[3]); }
    __builtin_amdgcn_sched_barrier(0);
    f32x4 vr[16][2];
#pragma unroll
    for (int it = 0; it < 16; ++it) { vr[it][0] = __builtin_nontemporal_load((const f32x4*)(vp + (size_t)it * 2048)); vr[it][1] = __builtin_nontemporal_load((const f32x4*)(vp + (size_t)it * 2048 + 4)); }
    __builtin_amdgcn_sched_barrier(0);
    float mx = sc[0];
#pragma unroll
    for (int it = 1; it < 16; ++it) mx = fmaxf(mx, sc[it]);
    mx = fmaxf(mx, __shfl_xor(mx, 16)); mx = fmaxf(mx, __shfl_xor(mx, 32));
    if (lane == 0) red[w] = mx;
    __syncthreads();
    const int w0 = w & 4; mx = fmaxf(fmaxf(red[w0], red[w0 + 1]), fmaxf(red[w0 + 2], red[w0 + 3]));
    const float scl = 0.08838834764831845f * 1.4426950408889634f; float sum = 0.f;
    float oacc[8] = {0.f, 0.f, 0.f, 0.f, 0.f, 0.f, 0.f, 0.f};
#pragma unroll
    for (int it = 0; it < 16; ++it) { const float p = __builtin_amdgcn_exp2f((sc[it] - mx) * scl); sum += p; const f32x4 v0 = vr[it][0], v1 = vr[it][1];
        oacc[0] += p * v0[0]; oacc[1] += p * v0[1]; oacc[2] += p * v0[2]; oacc[3] += p * v0[3]; oacc[4] += p * v1[0]; oacc[5] += p * v1[1]; oacc[6] += p * v1[2]; oacc[7] += p * v1[3]; }
    sum += __shfl_xor(sum, 16); sum += __shfl_xor(sum, 32);
#pragma unroll
    for (int i = 0; i < 8; ++i) { oacc[i] += __shfl_xor(oacc[i], 16); oacc[i] += __shfl_xor(oacc[i], 32); }
    if (lane == 0) red[8 + w] = sum;
    if (lane < 16) {
#pragma unroll
        for (int i = 0; i < 8; ++i) red[16 + w * 128 + dd * 8 + i] = oacc[i]; }
    __syncthreads();
    if ((w & 3) == 0 && lane < 16) {
        const float tot = (red[8 + w] + red[9 + w]) + (red[10 + w] + red[11 + w]), inv = 1.f / tot; float o[8];
#pragma unroll
        for (int i = 0; i < 8; ++i) o[i] = ((red[16 + w * 128 + dd * 8 + i] + red[16 + (w + 1) * 128 + dd * 8 + i]) + (red[16 + (w + 2) * 128 + dd * 8 + i] + red[16 + (w + 3) * 128 + dd * 8 + i])) * inv;
        v4u ow; ow.x = pk2(o[0], o[1]); ow.y = pk2(o[2], o[3]); ow.z = pk2(o[4], o[5]); ow.w = pk2(o[6], o[7]);
        *(v4u*)(mix + (size_t)(MP + b) * D + TOKW + hd * 128 + dd * 8) = ow;
    }
    __syncthreads();
}

constexpr int SG_LD = 136;
__device__ __forceinline__ void sg_unit(LAS unsigned char* lds, const bf16* zu, const bf16* zv, const ssq_t* ssv, const float* g_v, const bf16* wsb, const float* b_s, bf16* mix, int unit, int tid) {
    const int ch = unit / 12, g = unit % 12, row0 = ch * 128, lane = tid & 63, w = tid >> 6, fr = lane & 15, fq = lane >> 4;
    LAS bf16* Vt = (LAS bf16*)lds;
    { const int s = tid & 127, dq = tid >> 7; const float rsv = rstd_of(ssv[row0 + s], 1.f / 1536.f);
#pragma unroll
      for (int it = 0; it < 4; ++it) { const int d0 = (dq + 4 * it) * 8; const v4u vw = *(const v4u*)(zv + (size_t)(row0 + s) * TOKW + g * 128 + d0);
          const f32x4 g0 = *(const f32x4*)(g_v + g * 128 + d0), g1 = *(const f32x4*)(g_v + g * 128 + d0 + 4);
          const unsigned a = pk2(bflo(vw.x) * rsv * g0[0], bfhi(vw.x) * rsv * g0[1]), b2 = pk2(bflo(vw.y) * rsv * g0[2], bfhi(vw.y) * rsv * g0[3]),
                         c2 = pk2(bflo(vw.z) * rsv * g1[0], bfhi(vw.z) * rsv * g1[1]), e2 = pk2(bflo(vw.w) * rsv * g1[2], bfhi(vw.w) * rsv * g1[3]);
          LAS bf16* vp = Vt + d0 * SG_LD + s;
          vp[0] = (bf16)(a & 0xffff); vp[SG_LD] = (bf16)(a >> 16); vp[2 * SG_LD] = (bf16)(b2 & 0xffff); vp[3 * SG_LD] = (bf16)(b2 >> 16);
          vp[4 * SG_LD] = (bf16)(c2 & 0xffff); vp[5 * SG_LD] = (bf16)(c2 >> 16); vp[6 * SG_LD] = (bf16)(e2 & 0xffff); vp[7 * SG_LD] = (bf16)(e2 >> 16); } }
    const int nks = (w >> 1) + 1;
    bf16x8 wf[4];
#pragma unroll
    for (int ks = 0; ks < 4; ++ks) wf[ks] = *(const bf16x8*)(wsb + ((size_t)g * 128 + w * 16 + fr) * 128 + ks * 32 + fq * 8);
    __syncthreads();
    f32x4 acc[8];
#pragma unroll
    for (int dt = 0; dt < 8; ++dt) { acc[dt] = (f32x4){0.f, 0.f, 0.f, 0.f};
#pragma unroll
        for (int ks = 0; ks < 4; ++ks) if (ks < nks) { const bf16x8 vf = *(const LAS bf16x8*)(Vt + (dt * 16 + fr) * SG_LD + ks * 32 + fq * 8); acc[dt] = __builtin_amdgcn_mfma_f32_16x16x32_bf16(vf, wf[ks], acc[dt], 0, 0, 0); } }
    const int t = w * 16 + fr, r = row0 + t; const float bias = b_s[g * 128 + t];
#pragma unroll
    for (int dt = 0; dt < 8; ++dt) { const int c = g * 128 + dt * 16 + fq * 4; const v2u uw = *(const v2u*)(zu + (size_t)r * TOKW + c);
        v2u ow; ow.x = pk2(bflo(uw.x) * (acc[dt][0] + bias), bfhi(uw.x) * (acc[dt][1] + bias)); ow.y = pk2(bflo(uw.y) * (acc[dt][2] + bias), bfhi(uw.y) * (acc[dt][3] + bias));
        *(v2u*)(mix + (size_t)r * D + c) = ow; }
    __syncthreads();
}

__device__ __forceinline__ void s5_state_task(LAS unsigned char* lds, bf16* uh, const bf16* bt2_l, const float* lb16_l, float* out, int j, int task, int tid) {
    const int b = task / NGRP, h = task % NGRP, lane = tid & 63, w = tid >> 6, fr = lane & 15, fq = lane >> 4;
    LAS float* S = (LAS float*)lds;
    bf16x8 af[8];
    const bf16* ap = uh + ((size_t)(h * 512 + b * 128 + w * 16 + fr)) * KH + fq * 8;
#pragma unroll
    for (int ks = 0; ks < 8; ++ks) af[ks] = *(const bf16x8*)(ap + ks * 32);
#pragma unroll
    for (int nt = 0; nt < 8; ++nt) { f32x4 acc = (f32x4){0.f, 0.f, 0.f, 0.f}; const bf16* bp = bt2_l + ((size_t)(h * 128 + nt * 16 + fr)) * 256 + fq * 8;
#pragma unroll
        for (int ks = 0; ks < 8; ++ks) { const bf16x8 bf = *(const bf16x8*)(bp + ks * 32); acc = __builtin_amdgcn_mfma_f32_16x16x32_bf16(af[ks], bf, acc, 0, 0, 0); }
#pragma unroll
        for (int jj = 0; jj < 4; ++jj) S[(w * 16 + fq * 4 + jj) * 129 + nt * 16 + fr] = acc[jj]; }
    __syncthreads();
    {
        const int p = lane; const float lr = lb16_l[(h * 64 + p) * 2], li = lb16_l[(h * 64 + p) * 2 + 1];
        LAS float* Tb = S + 128 * 129;
        float tr = 0.f, ti = 0.f;
#pragma unroll
        for (int k = 0; k < 16; ++k) { const int m = w * 16 + k; const float sr = S[m * 129 + p], si = S[m * 129 + 64 + p]; const float t = lr * tr - li * ti + sr; ti = lr * ti + li * tr + si; tr = t; }
        Tb[w * 128 + p] = tr; Tb[w * 128 + 64 + p] = ti;
        float Lr = lr, Li = li;
#pragma unroll
        for (int q = 0; q < 4; ++q) { const float t = Lr * Lr - Li * Li; Li = 2.f * Lr * Li; Lr = t; }
        __syncthreads();
        float hr = 0.f, hi = 0.f;
        for (int w2 = 0; w2 < w; ++w2) { const float t = Lr * hr - Li * hi + Tb[w2 * 128 + p]; hi = Lr * hi + Li * hr + Tb[w2 * 128 + 64 + p]; hr = t; }
        bf16* up = uh + ((size_t)(h * 512 + b * 128 + w * 16)) * KH + 256 + p;
#pragma unroll
        for (int k = 0; k < 16; ++k) { const int m = w * 16 + k; up[(size_t)k * KH] = (bf16)(pk2(hr, 0.f) & 0xffff); up[(size_t)k * KH + 64] = (bf16)(pk2(hi, 0.f) & 0xffff);
            const float sr = S[m * 129 + p], si = S[m * 129 + 64 + p]; const float t = lr * hr - li * hi + sr; hi = lr * hi + li * hr + si; hr = t; }
        if (w == 7) { out[OFF_SRP + ((size_t)(j * 4 + b) * NGRP + h) * 64 + p] = hr; out[OFF_SIP + ((size_t)(j * 4 + b) * NGRP + h) * 64 + p] = hi; }
    }
    __syncthreads();
}
__device__ __forceinline__ void s5_sample_task(const float* us, const float* st_re, const float* st_im, const float* lbt_l, const float* bbar_l, const float* c_re_l, const float* c_im_l, const float* d_l,
                                               float* out, bf16* yb, int j, int task, int lane) {
    const int h = task >> 4, b0 = (task & 15) * 8, p = lane, co = lane >> 2;
    float bbr[16], bbi[16], cr[16], ci[16];
    const float* bb = bbar_l + ((size_t)(h * 64 + p)) * 32;
#pragma unroll
    for (int c2 = 0; c2 < 8; ++c2) { const f32x4 t = *(const f32x4*)(bb + c2 * 4); bbr[2 * c2] = t[0]; bbi[2 * c2] = t[1]; bbr[2 * c2 + 1] = t[2]; bbi[2 * c2 + 1] = t[3]; }
#pragma unroll
    for (int c = 0; c < 16; ++c) { cr[c] = c_re_l[((size_t)(h * 16 + c)) * 64 + p]; ci[c] = c_im_l[((size_t)(h * 16 + c)) * 64 + p]; }
    const float lr = lbt_l[(h * 64 + p) * 2], li = lbt_l[(h * 64 + p) * 2 + 1], dd = d_l[h * 16 + co];
    const bool b5 = (lane & 32) != 0, b4 = (lane & 16) != 0, b3 = (lane & 8) != 0, b2 = (lane & 4) != 0;
#pragma unroll 1
    for (int bi_ = 0; bi_ < 8; ++bi_) {
        const int b = b0 + bi_; float u[16];
#pragma unroll
        for (int c4 = 0; c4 < 4; ++c4) { const f32x4 t = *(const f32x4*)(us + (size_t)b * TOKW + h * 16 + c4 * 4); u[c4 * 4] = t[0]; u[c4 * 4 + 1] = t[1]; u[c4 * 4 + 2] = t[2]; u[c4 * 4 + 3] = t[3]; }
        const float uco = us[(size_t)b * TOKW + h * 16 + co];
        float xr = 0.f, xi = 0.f;
#pragma unroll
        for (int c = 0; c < 16; ++c) { xr += bbr[c] * u[c]; xi += bbi[c] * u[c]; }
        const size_t si_ = ((size_t)(j * MS + b) * NGRP + h) * 64 + p; const float s0r = st_re[si_], s0i = st_im[si_];
        const float hr = lr * s0r - li * s0i + xr, hi = lr * s0i + li * s0r + xi;
        out[OFF_SRS + si_] = hr; out[OFF_SIS + si_] = hi;
        float w8[8], w4[4], w2[2], w1;
#pragma unroll
        for (int i = 0; i < 8; ++i) { const float va = cr[i] * hr - ci[i] * hi, vb = cr[i + 8] * hr - ci[i + 8] * hi; w8[i] = (b5 ? vb : va) + __shfl_xor(b5 ? va : vb, 32); }
#pragma unroll
        for (int i = 0; i < 4; ++i) w4[i] = (b4 ? w8[i + 4] : w8[i]) + __shfl_xor(b4 ? w8[i] : w8[i + 4], 16);
#pragma unroll
        for (int i = 0; i < 2; ++i) w2[i] = (b3 ? w4[i + 2] : w4[i]) + __shfl_xor(b3 ? w4[i] : w4[i + 2], 8);
        w1 = (b2 ? w2[1] : w2[0]) + __shfl_xor(b2 ? w2[0] : w2[1], 4);
        w1 += __shfl_xor(w1, 2); w1 += __shfl_xor(w1, 1);
        const float yv = w1 + dd * uco;
        if ((lane & 3) == 0) yb[(size_t)(MP + b) * TOKW + h * 16 + co] = (bf16)(pk2(gelu_t(yv), 0.f) & 0xffff);
    }
}

struct SEpiRes {
    bf16* xb; ssq_t* ssn;
    __device__ __forceinline__ void operator()(f32x4 v, int m, int c) const {
        const int r = MP + m; bf16* bp = xb + (size_t)r * D + c; const v2u xw = *(const v2u*)bp; const f32x4 o = (f32x4){bflo(xw.x), bfhi(xw.x), bflo(xw.y), bfhi(xw.y)} + v;
        v2u w; w.x = pk2(o[0], o[1]); w.y = pk2(o[2], o[3]); *(v2u*)bp = w;
        float sq = dot4(o); sq += __shfl_xor(sq, 1); sq += __shfl_xor(sq, 2); sq += __shfl_xor(sq, 4); if ((tid_now() & 7) == 0) fadd_atomic(ssn + r, sq);
    }
};
struct SEpiSsmIn {
    const ssq_t* ss; float* us; bf16* q;
    __device__ __forceinline__ void operator()(f32x4 v, int m, int c) const {
        const int r = MP + m; v = v * rstd_of(ss[r], 1.f / 2048.f);
        if (c < TOKW) *(f32x4*)(us + (size_t)m * TOKW + c) = v;
        else { v2u w; w.x = pk2(v[0], v[1]); w.y = pk2(v[2], v[3]); *(v2u*)(q + (size_t)r * XAW + (c - TOKW)) = w; }
    }
};
template <class SEpi>
__device__ __forceinline__ void skinny_sample(LAS unsigned char* lds, const bf16* As, const bf16* Bt, int K, const SEpi& E, int blk, int tid) {
    if (blk >= 256) return;
    const int lane = tid & 63, w = __builtin_amdgcn_readfirstlane(tid >> 6), fr = lane & 15, fq = lane >> 4, m0 = (blk & 3) * 32, n0 = (blk >> 2) * 32;
    f32x4 acc[2][2];
#pragma unroll
    for (int a = 0; a < 2; ++a)
#pragma unroll
        for (int b = 0; b < 2; ++b) acc[a][b] = (f32x4){0.f, 0.f, 0.f, 0.f};
    const int nks = K >> 5; const bf16* bp = Bt + (size_t)(n0 + fr) * K + fq * 8; const bf16* ap = As + (size_t)(m0 + fr) * K + fq * 8; const size_t r16 = (size_t)16 * K;
#pragma unroll 8
    for (int ks = w; ks < nks; ks += 8) {
        const bf16x8 b0 = *(const bf16x8*)(bp + ks * 32), b1 = *(const bf16x8*)(bp + r16 + ks * 32), a0 = *(const bf16x8*)(ap + ks * 32), a1 = *(const bf16x8*)(ap + r16 + ks * 32);
        acc[0][0] = __builtin_amdgcn_mfma_f32_16x16x32_bf16(b0, a0, acc[0][0], 0, 0, 0); acc[0][1] = __builtin_amdgcn_mfma_f32_16x16x32_bf16(b1, a0, acc[0][1], 0, 0, 0);
        acc[1][0] = __builtin_amdgcn_mfma_f32_16x16x32_bf16(b0, a1, acc[1][0], 0, 0, 0); acc[1][1] = __builtin_amdgcn_mfma_f32_16x16x32_bf16(b1, a1, acc[1][1], 0, 0, 0);
    }
    LAS float* red = (LAS float*)lds;
#pragma unroll
    for (int a = 0; a < 2; ++a)
#pragma unroll
        for (int b = 0; b < 2; ++b) *(LAS f32x4*)(red + ((w * 32 + a * 16 + fr) * 32 + b * 16 + fq * 4)) = acc[a][b];
    __syncthreads();
    if (tid < 256) {
        const int m = tid >> 3, nq = (tid & 7) * 4; f32x4 sum = *(const LAS f32x4*)(red + (m * 32 + nq));
#pragma unroll
        for (int w2 = 1; w2 < 8; ++w2) sum += *(const LAS f32x4*)(red + ((w2 * 32 + m) * 32 + nq));
        E(sum, m0 + m, n0 + nq);
    }
    __syncthreads();
}

#define RLX_AGENT __ATOMIC_RELAXED, __HIP_MEMORY_SCOPE_AGENT
struct Args { const float* in[34]; float* out; unsigned char* ws; int lo, hi; };
__global__ void __launch_bounds__(NTHR, 2) trunk_fwd(Args args) {
    extern __shared__ __attribute__((aligned(16))) unsigned char lds_raw[];
    LAS unsigned char* lds = (LAS unsigned char*)lds_raw;
    volatile LAS unsigned* MISC = (volatile LAS unsigned*)(lds + MISC_OFF);
    const int G = gridDim.x, blk = blockIdx.x;
    const Args* ap = &args;
#define ws (ap->ws)
#define out (ap->out)
#define x_prompt (ap->in[0])
#define x_sample (ap->in[1])
#define mem_prompt (ap->in[2])
#define cache_k (ap->in[3])
#define cache_v (ap->in[4])
#define st_re (ap->in[5])
#define st_im (ap->in[6])
#define st_conv (ap->in[7])
#define g_mix (ap->in[8])
#define g_ffn (ap->in[9])
#define g_mem (ap->in[10])
#define g_final (ap->in[11])
#define w_mem_kv (ap->in[12])
#define sg_w_in (ap->in[13])
#define sg_w_out (ap->in[14])
#define sg_g_v (ap->in[15])
#define sg_w_s (ap->in[16])
#define sg_b_s (ap->in[17])
#define ssm_w_in (ap->in[18])
#define ssm_w_out (ap->in[19])
#define lam_re (ap->in[20])
#define lam_im (ap->in[21])
#define log_dt (ap->in[22])
#define b_re (ap->in[23])
#define b_im (ap->in[24])
#define c_re (ap->in[25])
#define c_im (ap->in[26])
#define ssm_d (ap->in[27])
#define w_glu (ap->in[28])
#define b_glu (ap->in[29])
#define w_up (ap->in[30])
#define conv_w (ap->in[31])
#define conv_b (ap->in[32])
#define w_down (ap->in[33])
#define ctl ((unsigned*)(ws + WS_CTL))
#define SSX ((ssq_t*)(ws + CTL_SSX))
#define ss_mix (SSX + (size_t)(2 * li) * MT)
#define ss_ffn (SSX + (size_t)(2 * li + 1) * MT)
#define ss_next (SSX + (size_t)(2 * li + 2) * MT)
#define mkv_l (MKV + (size_t)li * 1024 * 1024)
#define SSV ((ssq_t*)(ws + CTL_SSV))
#define SSMEM ((ssq_t*)(ws + CTL_SSMEM))
#define W_SGIN ((bf16*)(ws + WS_WSGIN))
#define W_SSMIN ((bf16*)(ws + WS_WSSMIN))
#define W_SGOUT ((bf16*)(ws + WS_WSGOUT))
#define W_SSMOUT ((bf16*)(ws + WS_WSSMOUT))
#define W_GLU ((bf16*)(ws + WS_WGLU))
#define W_UP ((bf16*)(ws + WS_WUP))
#define W_DOWN ((bf16*)(ws + WS_WDOWN))
#define W_MEM ((bf16*)(ws + WS_WMEM))
#define WSB ((bf16*)(ws + WS_WSB))
#define TB ((bf16*)(ws + WS_TB))
#define BT2 ((bf16*)(ws + WS_BT2))
#define LBT ((float*)(ws + WS_LBT))
#define LB16 ((float*)(ws + WS_LB16))
#define BBART ((float*)(ws + WS_BBAR))
#define XRES ((float*)(ws + WS_XRES))
#define XB ((bf16*)(ws + WS_XB))
#define MEMB ((bf16*)(ws + WS_MEMB))
#define MKV ((bf16*)(ws + WS_MKV))
#define ZU ((bf16*)(ws + WS_ZU))
#define ZV ((bf16*)(ws + WS_ZV))
#define QB ((bf16*)(ws + WS_Q))
#define MIX ((bf16*)(ws + WS_MIX))
#define AG ((bf16*)(ws + WS_AG))
#define YF ((bf16*)(ws + WS_Y))
#define UH ((bf16*)(ws + WS_UH))
#define YB ((bf16*)(ws + WS_YB))
#define US ((float*)(ws + WS_US))
#define FXA ((float*)(ws + WS_FXA))
#define FXG ((float*)(ws + WS_FXG))
    for (int u = threadIdx.x; u < 128; u += NTHR) MISC[u] = 0u;
    __syncthreads();
    XcdBarrier bar = xcd_barrier_post(ctl + CW_BAR, MISC + 8);
    const int lo = args.lo, hi = args.hi; int ph = 0;
#ifndef PHM
#define PHM 0xFFFFFFFFu
#endif
#ifndef DUPM
#define DUPM 0u
#endif
#ifndef DUPX
#define DUPX 0u
#endif
#ifndef DUPSUB
#define DUPSUB 0u
#endif
#define SUBREP(k) for (int srep_ = 0; srep_ < (((DUPSUB >> (k)) & 1u) ? 2 : 1); ++srep_)
#define PH_BEGIN(k) if (((PHM >> (k)) & 1u) && ph >= lo && ph < hi) for (int rep_ = 0; rep_ < (((DUPM >> (k)) & 1u) ? 2 : 1); ++rep_) { unsigned z_; asm volatile("s_mov_b32 %0, 0" : "=s"(z_)); const Args* ap = (const Args*)((const char*)&args + z_); int blk_l_ = blockIdx.x; asm volatile("" : "+s"(blk_l_)); const int blk = blk_l_; int tid = threadIdx.x; asm volatile("" : "+v"(tid)); const int lane = tid & 63, wave = __builtin_amdgcn_readfirstlane(tid >> 6); const int gw = blk * NWAVES + wave, NGW = G * NWAVES, gtid = blk * NTHR + tid, NT = G * NTHR; (void)lane; (void)gw; (void)NGW; (void)gtid; (void)NT;
#ifdef PROBE_K1
    unsigned long long tprev_ = __builtin_amdgcn_s_memrealtime(), d1_ = 0ull, d2_ = 0ull;
#define PH_END do { if (ph >= lo && ph + 1 < hi) xcd_barrier(bar); { const unsigned long long tn_ = __builtin_amdgcn_s_memrealtime(); if (ph == PROBE_K1) d1_ = tn_ - tprev_; if (ph == PROBE_K2) d2_ = tn_ - tprev_; tprev_ = tn_; } ++ph; } while (0)
#else
#define PH_END do { if (ph >= lo && ph + 1 < hi) xcd_barrier(bar); ++ph; } while (0)
#endif

    PH_BEGIN(0)
        {
            LAS bf16* T0 = (LAS bf16*)lds; LAS bf16* T1 = (LAS bf16*)(lds + 128 * P0_TLD * 2); LAS bf16* T2 = (LAS bf16*)(lds + 2 * 128 * P0_TLD * 2);
            f32x4 v0[8], v1[8], v2[8]; float g0_[8], g1_[8], g2_[8]; int t = blk; P0Desc d0, d1, d2, e0, e1, e2;
            d0 = p0_decode(p0_remap_now(t < P0_NOW ? t : 0), ap->in, ws); d1 = p0_decode(p0_remap_now(t + G < P0_NOW ? t + G : 0), ap->in, ws); d2 = p0_decode(p0_remap_now(t + 2 * G < P0_NOW ? t + 2 * G : 0), ap->in, ws);
            if (t < P0_NOW) p0_load(d0, v0, g0_, tid);
            if (t + G < P0_NOW) p0_load(d1, v1, g1_, tid);
            if (t + 2 * G < P0_NOW) p0_load(d2, v2, g2_, tid);
#pragma unroll 1
            while (t < P0_NOW) {
                const bool has1 = t + G < P0_NOW, has2 = t + 2 * G < P0_NOW; const int tn = t + 3 * G; e0 = d0; e1 = d1; e2 = d2;
                p0_to_lds(d0, v0, g0_, T0, tid);
                __syncthreads();
                if (tn < P0_NOW) { e0 = p0_decode(p0_remap_now(tn), ap->in, ws); p0_load(e0, v0, g0_, tid); }
                p0_store(d0, T0, tid);
                if (has1) p0_to_lds(d1, v1, g1_, T1, tid);
                __syncthreads();
                if (tn + G < P0_NOW) { e1 = p0_decode(p0_remap_now(tn + G), ap->in, ws); p0_load(e1, v1, g1_, tid); }
                if (has1) p0_store(d1, T1, tid);
                if (has2) p0_to_lds(d2, v2, g2_, T2, tid);
                __syncthreads();
                if (tn + 2 * G < P0_NOW) { e2 = p0_decode(p0_remap_now(tn + 2 * G), ap->in, ws); p0_load(e2, v2, g2_, tid); }
                if (has2) p0_store(d2, T2, tid);
                t = tn; d0 = e0; d1 = e1; d2 = e2;
            }
            __syncthreads();
        }
        {
            auto rsrc = [&](int r) -> const float* { return r < MP ? x_prompt + (size_t)r * D : (r < MREAL ? x_sample + (size_t)(r - MP) * D : (r < MT ? x_prompt : mem_prompt + (size_t)(r - MT) * D)); };
            int r = gw; f32x4 rv[8];
            p0_row_load(rsrc(r < MT + MMEM ? r : 0), rv, lane);
#pragma unroll 1
            while (r < MT + MMEM) {
                const int rn = r + NGW; f32x4 rvn[8];
                p0_row_load(rsrc(rn < MT + MMEM ? rn : 0), rvn, lane);
                if (r < MT) p0_row_finish(rv, r >= MREAL, XB + (size_t)r * D, SSX + r, lane);
                else p0_row_finish(rv, false, MEMB + (size_t)(r - MT) * D, SSMEM + (r - MT), lane);
#pragma unroll
                for (int j = 0; j < 8; ++j) rv[j] = rvn[j];
                r = rn;
            }
        }
        for (int e = gtid; e < 2 * 12 * 128 * 128 / 4; e += NT) { const int e4 = e * 4, s = e4 & 127, t = (e4 >> 7) & 127; const f32x4 wv = *(const f32x4*)(sg_w_s + e4);
            v2u o; o.x = pk2(s <= t ? wv[0] : 0.f, s + 1 <= t ? wv[1] : 0.f); o.y = pk2(s + 2 <= t ? wv[2] : 0.f, s + 3 <= t ? wv[3] : 0.f); *(v2u*)(WSB + e4) = o; }
    }
    PH_END;
#pragma unroll 1
    for (int li = 0; li < 4; ++li) {
        const int j = li >> 1;
        if ((li & 1) == 0) {
            PH_BEGIN(2)
                pg8::Gemm g{XB, W_SGIN + (size_t)j * SGN * D, MT, SGN, D}; SgOrder S; S.base.init(MP, SGN, G, blk); S.G = G; S.c = blk;
                EpiSgIn E{ss_mix, ZU, ZV, QB, SSV + (size_t)j * MT, ctl + CW_ADONE + 64 * j};
                pg8::gemm_phase<EpiSgIn, SgOrder, true, true>(lds, g, S, E);
                if (li == 0) {
                    const int first = (MT / 256) * (SGN / 256) % G;
                    pg8::Gemm gm{MEMB, W_MEM, MMEM, 4096, D}; MemOrder MO{G, blk, first, 16, 0}; EpiMem EM{SSMEM, out, MKV};
                    pg8::gemm_phase<EpiMem, MemOrder, true, true>(lds, gm, MO, EM);
                    const int r_ = (blk - (first + 16) % G + G) % G;
                    for (int un = 2 * r_; un < 68; un += 2 * G) for (int k2 = 0; k2 < 2 && un + k2 < 68; ++k2) { const int t_ = un + k2;
                        s5_tables((LAS float*)lds, t_ / NGRP, t_ % NGRP, lam_re, lam_im, log_dt, b_re, b_im, c_re, c_im, ssm_d, TB, BT2, LBT, LB16, BBART, tid); }
                }
                {
                    unsigned* sd = ctl + CW_ADONE + 64 * j; unsigned* aq = ctl + CW_AQUEUE + 64 * j; volatile LAS unsigned* qw = MISC + 20;
                    if (tid == 0) { unsigned sp = 0;
                        while (__hip_atomic_load(sd, __ATOMIC_RELAXED, __HIP_MEMORY_SCOPE_AGENT) < (unsigned)(SGN / 256)) { __builtin_amdgcn_s_sleep(2); if (++sp > (1u << 22)) break; }
                        __builtin_amdgcn_fence(__ATOMIC_ACQUIRE, "agent"); asm volatile("s_waitcnt vmcnt(0)" ::: "memory"); }
                    __syncthreads();
#pragma unroll 1
                    for (;;) {
                        if (tid == 0) qw[0] = __hip_atomic_fetch_add(aq, 1u, __ATOMIC_RELAXED, __HIP_MEMORY_SCOPE_AGENT);
                        __syncthreads();
                        const unsigned un = qw[0];
                        __syncthreads();
                        if (un >= 256u) break;
                        attn_sample_unit(lds, QB, cache_k, cache_v, MIX, li, (int)un, tid);
                    }
                }
            }
            PH_END;
            PH_BEGIN(3)
                const ssq_t* ssv = SSV + (size_t)j * MT; const float* gv = sg_g_v + j * TOKW;
                SUBREP(0)
#pragma unroll 1
                for (int un = blk; un < 768; un += G) sg_unit(lds, ZU, ZV, ssv, gv, WSB + (size_t)j * 12 * 128 * 128, sg_b_s + j * 12 * 128, MIX, un, tid);
                SUBREP(1)
#pragma unroll 1
                for (int un = blk; un < 256; un += G) attn_prompt_unit(lds, QB, mkv_l, MIX, un, tid);
                {
                    unsigned* aq = ctl + CW_AQUEUE + 64 * j; volatile LAS unsigned* qw = MISC + 20;
#pragma unroll 1
                    for (;;) {
                        if (tid == 0) qw[0] = __hip_atomic_fetch_add(aq, 1u, __ATOMIC_RELAXED, __HIP_MEMORY_SCOPE_AGENT);
                        __syncthreads();
                        const unsigned un = qw[0];
                        __syncthreads();
                        if (un >= 256u) break;
                        attn_sample_unit(lds, QB, cache_k, cache_v, MIX, li, (int)un, tid);
                    }
                }
                for (int e = gtid; e < MS * TOKW / 8; e += NT) { const int b = e / 192, c = (e % 192) * 8, g = c >> 7, r = MP + b;
                    const float rsv = rstd_of(ssv[r], 1.f / 1536.f); const v4u vw = *(const v4u*)(ZV + (size_t)r * TOKW + c), uw = *(const v4u*)(ZU + (size_t)r * TOKW + c);
                    const f32x4 g0 = *(const f32x4*)(gv + c), g1 = *(const f32x4*)(gv + c + 4);
                    const f32x4 n0 = (f32x4){bflo(vw.x) * rsv * g0[0], bfhi(vw.x) * rsv * g0[1], bflo(vw.y) * rsv * g0[2], bfhi(vw.y) * rsv * g0[3]};
                    const f32x4 n1 = (f32x4){bflo(vw.z) * rsv * g1[0], bfhi(vw.z) * rsv * g1[1], bflo(vw.w) * rsv * g1[2], bfhi(vw.w) * rsv * g1[3]};
                    float* so = out + OFF_SGV + (size_t)(j * MS + b) * TOKW + c; *(f32x4*)so = n0; *(f32x4*)(so + 4) = n1;
                    const float w00 = sg_w_s[((size_t)(j * 12 + g) * 128) * 128], bs = sg_b_s[(j * 12 + g) * 128];
                    const f32x4 t0 = (f32x4){bflo(uw.x), bfhi(uw.x), bflo(uw.y), bfhi(uw.y)} * (n0 * w00 + bs), t1 = (f32x4){bflo(uw.z), bfhi(uw.z), bflo(uw.w), bfhi(uw.w)} * (n1 * w00 + bs);
                    *(v4u*)(MIX + (size_t)r * D + c) = pack8(t0, t1); }
            }
            PH_END;
        } else {
            PH_BEGIN(4)
                pg8::Gemm g{XB, W_SSMIN + (size_t)j * D * D, MP, D, D}; pg8::StaticOrder S; S.init(MP, D, G, blk);
                EpiSsmIn E{ss_mix, UH, US, QB};
                const bool sk_first = ((blk >> 3) & 1) != 0; SEpiSsmIn SE{ss_mix, US, QB};
                if (sk_first) skinny_sample(lds, XB + (size_t)MP * D, W_SSMIN + (size_t)j * D * D, D, SE, blk, tid);
                pg8::gemm_phase<EpiSsmIn, pg8::StaticOrder, true, true>(lds, g, S, E);
                if (!sk_first) skinny_sample(lds, XB + (size_t)MP * D, W_SSMIN + (size_t)j * D * D, D, SE, blk, tid);
            }
            PH_END;
            PH_BEGIN(5)
                if (blk < 2 * NGRP) {
                    const int h = blk >> 1, mh = blk & 1;
                    s5_state_task(lds, UH, BT2 + (size_t)j * NGRP * 128 * 256, LB16 + (size_t)j * NGRP * 64 * 2, out, j, (2 * mh) * NGRP + h, tid);
                    s5_state_task(lds, UH, BT2 + (size_t)j * NGRP * 128 * 256, LB16 + (size_t)j * NGRP * 64 * 2, out, j, (2 * mh + 1) * NGRP + h, tid);
                    asm volatile("s_waitcnt vmcnt(0)" ::: "memory"); __syncthreads();
                }
                {
                    int kh = KH; asm volatile("" : "+s"(kh)); pg8::Gemm g{UH, TB + (size_t)j * NGRP * 256 * KH, NGRP * 512, NGRP * 256, kh}; ToepOrder S{G, blk};
                    EpiToep E{YB};
                    pg8::gemm_phase<EpiToep, ToepOrder, true, true>(lds, g, S, E);
                }
#pragma unroll 1
                for (int tk = gw; tk < NGRP * 16; tk += NGW)
                    s5_sample_task(US, st_re, st_im, LBT + (size_t)j * NGRP * 64 * 2, BBART + (size_t)j * NGRP * 64 * 32, c_re + (size_t)j * NGRP * 1024, c_im + (size_t)j * NGRP * 1024, ssm_d + j * TOKW, out, YB, j, tk, lane);
                {
                    unsigned* aq = ctl + CW_SQUEUE + 64 * (4 + j); volatile LAS unsigned* qw = MISC + 17;
#pragma unroll 1
                    for (;;) {
                        if (tid == 0) qw[0] = __hip_atomic_fetch_add(aq, 1u, __ATOMIC_RELAXED, __HIP_MEMORY_SCOPE_AGENT);
                        __syncthreads();
                        const unsigned un = qw[0];
                        __syncthreads();
                        if (un >= 512u) break;
                        if (un < 256u) attn_sample_unit(lds, QB, cache_k, cache_v, MIX, li, (int)un, tid); else attn_prompt_unit(lds, QB, mkv_l, MIX, (int)un - 256, tid);
                    }
                }
            }
            PH_END;
            PH_BEGIN(7)
                pg8::Gemm g{YB, W_GLU + (size_t)j * TOKW * TOKW, MT, TOKW, TOKW}; pg8::StaticOrder S; S.init(MT, TOKW, G, blk);
                EpiGlu E{YB, b_glu + j * TOKW, MIX};
                pg8::gemm_phase<EpiGlu, pg8::StaticOrder, true, true>(lds, g, S, E);
            }
            PH_END;
        }
        PH_BEGIN(8)
            const bf16* wo = (li & 1) ? W_SSMOUT + (size_t)j * D * D : W_SGOUT + (size_t)j * D * D;
            pg8::Gemm g{MIX, wo, MP, D, D}; pg8::StaticOrder S; S.init(MP, D, G, blk);
            if (DUPX & 2u) { EpiRes E0{AG, SSX + (size_t)8 * MT}; pg8::gemm_phase<EpiRes, pg8::StaticOrder, true, true>(lds, g, S, E0); }
            EpiRes E{XB, ss_ffn};
            const bool sk_first = ((blk >> 3) & 1) != 0; SEpiRes SE{XB, ss_ffn};
            if (sk_first) skinny_sample(lds, MIX + (size_t)MP * D, wo, D, SE, blk, tid);
            pg8::gemm_phase<EpiRes, pg8::StaticOrder, true, true>(lds, g, S, E);
            if (!sk_first) skinny_sample(lds, MIX + (size_t)MP * D, wo, D, SE, blk, tid);
        }
        PH_END;
        PH_BEGIN(9)
            pg8::Gemm g{XB, W_UP + (size_t)li * NUP * D, MT, NUP, D}; UpOrder S; S.base.init(MP, NUP, G, blk); S.G = G; S.c = blk;
            EpiUp E{ss_ffn, YF, out, st_conv + (size_t)li * MS * 2 * DFF, conv_w + (size_t)li * 3 * DFF, conv_b + (size_t)li * DFF, FXA, (LAS float*)(lds + HALO_OFF), li, ctl + CW_SDONE + 64 * li};
            pg8::gemm_phase<EpiUp, UpOrder, true, true>(lds, g, S, E);
            if (li == 0) {
                const int first = (MT / 256) * (NUP / 256) % G;
                pg8::Gemm gm{MEMB, W_MEM, MMEM, 4096, D}; MemOrder MO{G, blk, first, 48, 16}; EpiMem EM{SSMEM, out, MKV};
                pg8::gemm_phase<EpiMem, MemOrder, true, true>(lds, gm, MO, EM);
                const int r_ = (blk - (first + 48) % G + G) % G;
                for (int un = 68 + 2 * r_; un < 2 * NGRP; un += 2 * G) for (int k2 = 0; k2 < 2 && un + k2 < 2 * NGRP; ++k2) { const int t_ = un + k2;
                    s5_tables((LAS float*)lds, t_ / NGRP, t_ % NGRP, lam_re, lam_im, log_dt, b_re, b_im, c_re, c_im, ssm_d, TB, BT2, LBT, LB16, BBART, tid); }
            }
            {
                unsigned* sd = ctl + CW_SDONE + 64 * li; unsigned* sq = ctl + CW_SQUEUE + 64 * li; volatile LAS unsigned* qw = MISC + 16;
                if (tid == 0) { unsigned sp = 0;
                    while (__hip_atomic_load(sd, __ATOMIC_RELAXED, __HIP_MEMORY_SCOPE_AGENT) < (unsigned)(NUP / 256)) { __builtin_amdgcn_s_sleep(2); if (++sp > (1u << 22)) break; }
                    __builtin_amdgcn_fence(__ATOMIC_ACQUIRE, "agent"); asm volatile("s_waitcnt vmcnt(0)" ::: "memory"); }
                __syncthreads();
                SEpiRes SE{XB, ss_next};
#pragma unroll 1
                for (;;) {
                    if (tid == 0) qw[0] = __hip_atomic_fetch_add(sq, 1u, __ATOMIC_RELAXED, __HIP_MEMORY_SCOPE_AGENT);
                    __syncthreads();
                    const unsigned tile = qw[0];
                    __syncthreads();
                    if (tile >= 256u) break;
                    skinny_sample(lds, YF + (size_t)MP * DFF, W_DOWN + (size_t)li * D * DFF, DFF, SE, (int)tile, tid);
                }
            }
            if (li == 1 || li == 2)
                p0_queue(lds, MISC + 22, ctl + CW_WQUEUE + 64 * li, li + 1, li == 1 ? P0_DEF2 : P0_DEF3, ap->in, ws, tid);
        }
        PH_END;
        PH_BEGIN(11)
            pg8::Gemm g{YF, W_DOWN + (size_t)li * D * DFF, MP, D, DFF}; pg8::StaticOrder S; S.init(MP, D, G, blk);
            {
                pg8::Unit u0;
                if (S.next(0, u0) && (u0.pm & 7) != 0) {
                    const int pm = u0.pm; const float* cw = conv_w + (size_t)li * 3 * DFF; const float* cb = conv_b + (size_t)li * DFF;
                    for (int e = tid; e < DFF / 4; e += NTHR) { const int c = e * 4;
                        const f32x4 am2 = *(const f32x4*)(FXA + ((size_t)((pm - 1) * 4 + 2)) * DFF + c), am1 = *(const f32x4*)(FXA + ((size_t)((pm - 1) * 4 + 3)) * DFF + c);
                        const f32x4 a0 = *(const f32x4*)(FXA + ((size_t)(pm * 4)) * DFF + c), a1 = *(const f32x4*)(FXA + ((size_t)(pm * 4 + 1)) * DFF + c);
                        const f32x4 g0 = *(const f32x4*)(FXG + ((size_t)(pm * 2)) * DFF + c), g1 = *(const f32x4*)(FXG + ((size_t)(pm * 2 + 1)) * DFF + c);
                        const f32x4 k0 = *(const f32x4*)(cw + c), k1 = *(const f32x4*)(cw + DFF + c), k2 = *(const f32x4*)(cw + 2 * DFF + c), kb = *(const f32x4*)(cb + c);
                        f32x4 y0, y1;
#pragma unroll
                        for (int i = 0; i < 4; ++i) { const float c0_ = kb[i] + k0[i] * am2[i] + k1[i] * am1[i] + k2[i] * a0[i], c1_ = kb[i] + k0[i] * am1[i] + k1[i] * a0[i] + k2[i] * a1[i];
                            y0[i] = c0_ * sigmoid_f(c0_) * g0[i]; y1[i] = c1_ * sigmoid_f(c1_) * g1[i]; }
                        v2u w0, w1; w0.x = pk2(y0[0], y0[1]); w0.y = pk2(y0[2], y0[3]); w1.x = pk2(y1[0], y1[1]); w1.y = pk2(y1[2], y1[3]);
                        *(v2u*)(YF + (size_t)(pm * 256) * DFF + c) = w0; *(v2u*)(YF + (size_t)(pm * 256 + 1) * DFF + c) = w1; }
                }
                asm volatile("s_waitcnt vmcnt(0)" ::: "memory"); __syncthreads();
            }
            if (DUPX & 4u) { EpiRes E0{AG, SSX + (size_t)8 * MT}; pg8::gemm_phase<EpiRes, pg8::StaticOrder, true, true>(lds, g, S, E0); }
            if (li == 3 && G == 256) {
                if (wave == 0 && blk < MS) {
                    const int r = MP + blk; const v2u* xr = (const v2u*)(XB + (size_t)r * D); f32x4 v[8]; float s_ = 0.f;
#pragma unroll
                    for (int jj = 0; jj < 8; ++jj) { const v2u xw = xr[lane + 64 * jj]; v[jj] = (f32x4){bflo(xw.x), bfhi(xw.x), bflo(xw.y), bfhi(xw.y)}; s_ += dot4(v[jj]); }
                    const float rs = rsqrtf(wave_sum(s_) * (1.f / 2048.f) + EPS); f32x4* o = (f32x4*)(out + OFF_YS + (size_t)blk * D);
#pragma unroll
                    for (int jj = 0; jj < 8; ++jj) o[lane + 64 * jj] = v[jj] * rs * ((const f32x4*)g_final)[lane + 64 * jj];
                }
                EpiResFinal EF{XB, ss_next, out, g_final, ctl + CW_PCNT};
                pg8::gemm_phase<EpiResFinal, pg8::StaticOrder, true, true>(lds, g, S, EF);
            } else {
            EpiRes E{XB, ss_next};
            pg8::gemm_phase<EpiRes, pg8::StaticOrder, true, true>(lds, g, S, E);
            }

        }
        PH_END;
    }
    PH_BEGIN(12)
#pragma unroll 1
        for (int r = gw; r < MREAL; r += NGW) {
            const v2u* xr = (const v2u*)(XB + (size_t)r * D); f32x4 v[8]; float s = 0.f;
#pragma unroll
            for (int jj = 0; jj < 8; ++jj) { const v2u xw = xr[lane + 64 * jj]; v[jj] = (f32x4){bflo(xw.x), bfhi(xw.x), bflo(xw.y), bfhi(xw.y)}; s += dot4(v[jj]); }
            const float rs = rsqrtf(wave_sum(s) * (1.f / 2048.f) + EPS);
            f32x4* o = (f32x4*)(out + (r < MP ? OFF_YP + (size_t)r * D : OFF_YS + (size_t)(r - MP) * D));
#pragma unroll
            for (int jj = 0; jj < 8; ++jj) o[lane + 64 * jj] = v[jj] * rs * ((const f32x4*)g_final)[lane + 64 * jj];
        }
    }
    PH_END;
#ifdef PROBE_K1
    xcd_barrier(bar);
    if (blockIdx.x == 0) { const unsigned n = (unsigned)((d1_ * 262144ull) / 100000ull); for (unsigned e = threadIdx.x; e < n && e < 262144u; e += NTHR) (out + OFF_YS)[e] = 0.f;
        if (threadIdx.x == 0) (out + OFF_YP)[0] += (float)d2_ * 0.01f; }
#endif
#undef PH_BEGIN
#undef PH_END
}
#undef x_prompt
#undef x_sample
#undef mem_prompt
#undef cache_k
#undef cache_v
#undef st_re
#undef st_im
#undef st_conv
#undef g_mix
#undef g_ffn
#undef g_mem
#undef g_final
#undef w_mem_kv
#undef sg_w_in
#undef sg_w_out
#undef sg_g_v
#undef sg_w_s
#undef sg_b_s
#undef ssm_w_in
#undef ssm_w_out
#undef lam_re
#undef lam_im
#undef log_dt
#undef b_re
#undef b_im
#undef c_re
#undef c_im
#undef ssm_d
#undef w_glu
#undef b_glu
#undef w_up
#undef conv_w
#undef conv_b
#undef w_down
#undef ctl
#undef SSX
#undef ss_mix
#undef ss_ffn
#undef ss_next
#undef mkv_l
#undef SSV
#undef SSMEM
#undef W_SGIN
#undef W_SSMIN
#undef W_SGOUT
#undef W_SSMOUT
#undef W_GLU
#undef W_UP
#undef W_DOWN
#undef W_MEM
#undef WSB
#undef TB
#undef BT2
#undef LBT
#undef LB16
#undef BBART
#undef XRES
#undef XB
#undef MEMB
#undef MKV
#undef ZU
#undef ZV
#undef QB
#undef MIX
#undef AG
#undef YF
#undef UH
#undef YB
#undef US
#undef FXA
#undef FXG
#undef ws
#undef out

#ifndef MK_ONE_LAUNCH
#define MK_ONE_LAUNCH 1
#endif
extern "C" void kernel_launch(void* const* d_in, const int* in_sizes, int n_in, void* d_out, int out_size, void* d_ws, size_t ws_size, hipStream_t stream) {
    static int grid = 0;
    if (grid == 0) {
        if (n_in != 34 || (size_t)out_size != OUT_TOTAL || ws_size < WS_END) { fprintf(stderr, "kernel_launch: unexpected shapes (n_in %d, out %d, ws %zu)\n", n_in, out_size, ws_size); grid = -1; return; }
        int dev = 0, cus = 0;
        if (hipGetDevice(&dev) != hipSuccess || hipDeviceGetAttribute(&cus, hipDeviceAttributeMultiprocessorCount, dev) != hipSuccess) { grid = -1; return; }
        if (hipFuncSetAttribute((const void*)trunk_fwd, hipFuncAttributeMaxDynamicSharedMemorySize, LDS_BYTES) != hipSuccess) { fprintf(stderr, "kernel_launch: hipFuncSetAttribute failed\n"); grid = -1; return; }
        int per_cu = 0;
        if (hipOccupancyMaxActiveBlocksPerMultiprocessor(&per_cu, (const void*)trunk_fwd, NTHR, LDS_BYTES) != hipSuccess || per_cu < 1) fprintf(stderr, "kernel_launch: occupancy query says %d\n", per_cu);
        (void)hipGetLastError();
        grid = cus;
    }
    if (grid < 0) return;
    if (hipMemsetAsync((char*)d_ws + WS_CTL, 0, CTL_ZERO_BYTES, stream) != hipSuccess) return;
    Args a{};
    for (int i = 0; i < 34; ++i) a.in[i] = (const float*)d_in[i];
    a.out = (float*)d_out; a.ws = (unsigned char*)d_ws;
#if MK_ONE_LAUNCH
    a.lo = 0; a.hi = (grid == 256) ? NPHASE - 1 : NPHASE;
    hipLaunchKernelGGL(trunk_fwd, dim3(grid), dim3(NTHR), LDS_BYTES, stream, a);
#else
    for (int p = 0; p < NPHASE; ++p) { a.lo = p; a.hi = p + 1; hipLaunchKernelGGL(trunk_fwd, dim3(grid), dim3(NTHR), LDS_BYTES, stream, a); }
#endif
#ifdef OUTMASK
    {
        const size_t offs[12] = {OFF_YP, OFF_YS, OFF_MK, OFF_MV, OFF_SRP, OFF_SIP, OFF_CONVP, OFF_SRS, OFF_SIS, OFF_CONVS, OFF_SGV, OUT_TOTAL};
        for (int i = 0; i < 11; ++i) if (!((OUTMASK >> i) & 1)) (void)hipMemsetAsync((float*)d_out + offs[i], 0, (offs[i + 1] - offs[i]) * 4, stream);
    }
#endif
}
```
